# Optimizing an MI355X kernel written in HIP

```python
import jax, jax.numpy as jnp
from jax import lax
import numpy as np

D_MODEL = 1024
BATCH = 8
SEQ = 4096
DEPTH = 1
DEC_BATCH = 32
DEC_SEQ = 16
PAST_LEN = 1024

CHUNK = 64
HEAD_DIM = 64
N_FOX = 6
N_RWKV = 6
N_MEM = 4
W_FOX = N_FOX * HEAD_DIM
W_RWKV = N_RWKV * HEAD_DIM
W_MEM = N_MEM * HEAD_DIM
D_MIX = W_FOX + W_RWKV + W_MEM
N_MEM_TOK = 256
LORA_W = 32
LORA_A = 32
Q_BLOCK = 128
NORM_EPS = 1e-6
GN_EPS = 64e-5

FOX_COLS = 4 * W_FOX + N_FOX
RWKV_COLS = 4 * W_RWKV + LORA_W + LORA_A
MEM_COLS = 2 * W_MEM
N_IN = FOX_COLS + RWKV_COLS + MEM_COLS

kernel_name = "fox_rwkv7_memxattn_streaming_step"


def rms_norm(x, g, eps=NORM_EPS):
    xf = x.astype(jnp.float32)
    y = xf * lax.rsqrt(jnp.mean(xf * xf, axis=-1, keepdims=True) + eps)
    return (y * g.astype(jnp.float32)).astype(x.dtype)


def fox_prep(cols, q_g, k_g, b_f):
    B, T, _ = cols.shape
    q, k, v, f, g = jnp.split(cols, [W_FOX, 2 * W_FOX, 3 * W_FOX, 3 * W_FOX + N_FOX], axis=-1)
    q = rms_norm(q.reshape(B, T, N_FOX, HEAD_DIM), q_g)
    k = rms_norm(k.reshape(B, T, N_FOX, HEAD_DIM), k_g)
    v = v.reshape(B, T, N_FOX, HEAD_DIM)
    logf = jax.nn.log_sigmoid((f + b_f).astype(jnp.float32))
    return q, k, v, logf, g


def fox_attend_block(q, cq, qpos, k, v, ck, kpos):
    s = jnp.einsum('bqhd,bkhd->bhqk', q, k, preferred_element_type=jnp.float32) * (HEAD_DIM ** -0.5)
    s = s + jnp.transpose(cq, (0, 2, 1))[..., :, None] - jnp.transpose(ck, (0, 2, 1))[..., None, :]
    mask = kpos[None, :] <= qpos[:, None]
    s = jnp.where(mask, s, jnp.finfo(jnp.float32).min)
    p = jax.nn.softmax(s, axis=-1)
    return jnp.einsum('bhqk,bkhd->bqhd', p.astype(v.dtype), v)


def fox_prompt(q, k, v, logf):
    B, T = q.shape[:2]
    c = jnp.cumsum(logf, axis=1)
    kpos = jnp.arange(T)

    def block(i):
        s0 = i * Q_BLOCK
        qb = lax.dynamic_slice_in_dim(q, s0, Q_BLOCK, axis=1)
        cb = lax.dynamic_slice_in_dim(c, s0, Q_BLOCK, axis=1)
        return fox_attend_block(qb, cb, s0 + jnp.arange(Q_BLOCK), k, v, c, kpos)

    o = lax.map(block, jnp.arange(T // Q_BLOCK))
    return jnp.transpose(o, (1, 0, 2, 3, 4)).reshape(B, T, W_FOX)


def fox_sample(q, k, v, logf, k_past, v_past, logf_past):
    B, S = q.shape[:2]
    P = k_past.shape[1]
    keys = jnp.concatenate([k_past.astype(k.dtype), k], axis=1)
    vals = jnp.concatenate([v_past.astype(v.dtype), v], axis=1)
    c = jnp.cumsum(jnp.concatenate([logf_past.astype(jnp.float32), logf], axis=1), axis=1)
    o = fox_attend_block(q, c[:, P:], P + jnp.arange(S), keys, vals, c, jnp.arange(P + S))
    return o.reshape(B, S, W_FOX)


def token_shift(cols, prev, mu):
    shifted = jnp.concatenate([prev.astype(cols.dtype), cols[:, :-1]], axis=1)
    return cols + (shifted - cols) * mu


def rwkv_scan(s0, r, w, k, v, kk, a):
    def step(S, inp):
        r_t, w_t, k_t, v_t, kk_t, a_t = inp
        sa = jnp.einsum('bhvk,bhk->bhv', S, -kk_t)
        S = S * w_t[:, :, None, :] + sa[..., :, None] * (kk_t * a_t)[:, :, None, :] \
            + v_t[..., :, None] * k_t[:, :, None, :]
        y = jnp.einsum('bhvk,bhk->bhv', S, r_t)
        return S, y

    xs = tuple(jnp.moveaxis(t, 1, 0) for t in (r, w, k, v, kk, a))
    S, ys = lax.scan(step, s0.astype(jnp.float32), xs)
    return S, jnp.moveaxis(ys, 0, 1)


def rwkv_branch(xs, s0, w0, w_up, a0, a_up, k_k, k_a, r_k, gn_w, gn_b):
    B, T, _ = xs.shape
    f32 = jnp.float32
    r, k, v, wd, ad, g = jnp.split(
        xs, [W_RWKV, 2 * W_RWKV, 3 * W_RWKV, 3 * W_RWKV + LORA_W, 3 * W_RWKV + LORA_W + LORA_A], axis=-1)
    w_raw = -jax.nn.softplus(-(w0 + jnp.tanh(wd) @ w_up).astype(f32)) - 0.5
    decay = jnp.exp(-jnp.exp(w_raw))
    a = jax.nn.sigmoid((a0 + ad @ a_up).astype(f32))

    def hd(t):
        return t.reshape(B, T, N_RWKV, HEAD_DIM).astype(f32)

    def ph(t):
        return t.reshape(N_RWKV, HEAD_DIM).astype(f32)

    r, k, v, decay, a = hd(r), hd(k), hd(v), hd(decay), hd(a)
    kk = k * ph(k_k)
    kk = kk * lax.rsqrt(jnp.maximum(jnp.sum(kk * kk, axis=-1, keepdims=True), 1e-24))
    k = k * (1.0 + (a - 1.0) * ph(k_a))
    S, y = rwkv_scan(s0, r, decay, k, v, kk, a)
    mu = jnp.mean(y, axis=-1, keepdims=True)
    var = jnp.mean(jnp.square(y - mu), axis=-1, keepdims=True)
    yn = (y - mu) * lax.rsqrt(var + GN_EPS) * ph(gn_w) + ph(gn_b)
    bonus = jnp.sum(r * k * ph(r_k), axis=-1, keepdims=True) * v
    out = (yn + bonus).reshape(B, T, W_RWKV).astype(xs.dtype)
    return out, S, g


def mem_kv(mem, mem_norm_g, w_mem_kv, mem_k_g):
    B, M, _ = mem.shape
    kv = rms_norm(mem, mem_norm_g) @ w_mem_kv
    k, v = jnp.split(kv, [W_MEM], axis=-1)
    k = rms_norm(k.reshape(B, M, N_MEM, HEAD_DIM), mem_k_g)
    return k, v.reshape(B, M, N_MEM, HEAD_DIM)


def mem_attend(q_cols, mem_q_g, mk, mv):
    B, T, _ = q_cols.shape
    q = rms_norm(q_cols.reshape(B, T, N_MEM, HEAD_DIM), mem_q_g)
    s = jnp.einsum('bthd,bmhd->bhtm', q, mk.astype(q.dtype), preferred_element_type=jnp.float32) * (HEAD_DIM ** -0.5)
    p = jax.nn.softmax(s, axis=-1)
    o = jnp.einsum('bhtm,bmhd->bthd', p.astype(q.dtype), mv.astype(q.dtype))
    return o.reshape(B, T, W_MEM)


def mixer_layer(x, mk, mv, shift_prev, rwkv_s0, fox_past, p):
    (norm_g, w_in, fox_q_g, fox_k_g, fox_b_f, rwkv_mu, rwkv_w0, rwkv_w_up, rwkv_a0, rwkv_a_up,
     rwkv_k_k, rwkv_k_a, rwkv_r_k, rwkv_gn_w, rwkv_gn_b, mem_q_g, w_out) = p
    h = rms_norm(x, norm_g) @ w_in
    fox_cols, rwkv_cols, mem_cols = jnp.split(h, [FOX_COLS, FOX_COLS + RWKV_COLS], axis=-1)
    q, k, v, logf, g_f = fox_prep(fox_cols, fox_q_g, fox_k_g, fox_b_f)
    if fox_past is None:
        o_f = fox_prompt(q, k, v, logf)
    else:
        o_f = fox_sample(q, k, v, logf, *fox_past)
    xs = token_shift(rwkv_cols, shift_prev, rwkv_mu)
    o_r, s_new, g_r = rwkv_branch(xs, rwkv_s0, rwkv_w0, rwkv_w_up, rwkv_a0, rwkv_a_up,
                                  rwkv_k_k, rwkv_k_a, rwkv_r_k, rwkv_gn_w, rwkv_gn_b)
    mq, g_m = jnp.split(mem_cols, [W_MEM], axis=-1)
    o_m = mem_attend(mq, mem_q_g, mk, mv)
    o = jnp.concatenate([o_f.astype(x.dtype) * jax.nn.silu(g_f),
                         o_r * jax.nn.silu(g_r),
                         o_m * jax.nn.silu(g_m)], axis=-1)
    y = x + o @ w_out
    return y, k, v, logf, s_new, rwkv_cols[:, -1:]


def setup_inputs(seed: int = 0) -> dict:
    key = jax.random.key(seed)
    ks = iter(jax.random.split(key, 48))

    def nrm(shape, s=1.0):
        return s * jax.random.normal(next(ks), shape, jnp.float32)

    def gain(shape):
        return 1.0 + 0.05 * nrm(shape)

    return {
        "x_prompt": nrm((BATCH, SEQ, D_MODEL)),
        "x_sample": nrm((DEC_BATCH, DEC_SEQ, D_MODEL)),
        "mem_prompt": nrm((BATCH, N_MEM_TOK, D_MODEL)),
        "cache_fox_k": nrm((DEPTH, DEC_BATCH, PAST_LEN, N_FOX, HEAD_DIM)),
        "cache_fox_v": nrm((DEPTH, DEC_BATCH, PAST_LEN, N_FOX, HEAD_DIM)),
        "cache_fox_logf": jax.nn.log_sigmoid(2.0 + nrm((DEPTH, DEC_BATCH, PAST_LEN, N_FOX))),
        "cache_mem_k": nrm((DEPTH, DEC_BATCH, N_MEM_TOK, N_MEM, HEAD_DIM)),
        "cache_mem_v": nrm((DEPTH, DEC_BATCH, N_MEM_TOK, N_MEM, HEAD_DIM)),
        "state_rwkv": nrm((DEPTH, DEC_BATCH, N_RWKV, HEAD_DIM, HEAD_DIM), 0.3),
        "state_rwkv_shift": nrm((DEPTH, DEC_BATCH, 1, RWKV_COLS)),
        "norm_g": gain((DEPTH, D_MODEL)),
        "w_in": nrm((DEPTH, D_MODEL, N_IN), D_MODEL ** -0.5),
        "fox_q_g": gain((DEPTH, HEAD_DIM)),
        "fox_k_g": gain((DEPTH, HEAD_DIM)),
        "fox_b_f": 2.0 + 0.1 * nrm((DEPTH, N_FOX)),
        "rwkv_mu": jax.random.uniform(next(ks), (DEPTH, RWKV_COLS), jnp.float32, 0.1, 0.9),
        "rwkv_w0": -0.5 + 0.5 * nrm((DEPTH, W_RWKV)),
        "rwkv_w_up": nrm((DEPTH, LORA_W, W_RWKV), 0.3 * LORA_W ** -0.5),
        "rwkv_a0": 0.1 * nrm((DEPTH, W_RWKV)),
        "rwkv_a_up": nrm((DEPTH, LORA_A, W_RWKV), 0.5 * LORA_A ** -0.5),
        "rwkv_k_k": 0.85 + 0.05 * nrm((DEPTH, W_RWKV)),
        "rwkv_k_a": gain((DEPTH, W_RWKV)),
        "rwkv_r_k": 0.1 * nrm((DEPTH, W_RWKV)),
        "rwkv_gn_w": gain((DEPTH, W_RWKV)),
        "rwkv_gn_b": 0.01 * nrm((DEPTH, W_RWKV)),
        "mem_norm_g": gain((DEPTH, D_MODEL)),
        "w_mem_kv": nrm((DEPTH, D_MODEL, 2 * W_MEM), D_MODEL ** -0.5),
        "mem_q_g": gain((DEPTH, HEAD_DIM)),
        "mem_k_g": gain((DEPTH, HEAD_DIM)),
        "w_out": nrm((DEPTH, D_MIX, D_MODEL), D_MIX ** -0.5),
    }


def reference(x_prompt, x_sample, mem_prompt, cache_fox_k, cache_fox_v, cache_fox_logf,
              cache_mem_k, cache_mem_v, state_rwkv, state_rwkv_shift,
              norm_g, w_in, fox_q_g, fox_k_g, fox_b_f, rwkv_mu, rwkv_w0, rwkv_w_up, rwkv_a0,
              rwkv_a_up, rwkv_k_k, rwkv_k_a, rwkv_r_k, rwkv_gn_w, rwkv_gn_b,
              mem_norm_g, w_mem_kv, mem_q_g, mem_k_g, w_out):
    B = x_prompt.shape[0]
    yp, ys = x_prompt, x_sample
    fkp, fvp, flp, mkp, mvp, rsp, rhp = [], [], [], [], [], [], []
    fks, fvs, fls, rss, rhs = [], [], [], [], []
    for l in range(DEPTH):
        p = (norm_g[l], w_in[l], fox_q_g[l], fox_k_g[l], fox_b_f[l], rwkv_mu[l], rwkv_w0[l],
             rwkv_w_up[l], rwkv_a0[l], rwkv_a_up[l], rwkv_k_k[l], rwkv_k_a[l], rwkv_r_k[l],
             rwkv_gn_w[l], rwkv_gn_b[l], mem_q_g[l], w_out[l])
        mk, mv = mem_kv(mem_prompt, mem_norm_g[l], w_mem_kv[l], mem_k_g[l])
        shift0 = jnp.zeros((B, 1, RWKV_COLS), x_prompt.dtype)
        s0 = jnp.zeros((B, N_RWKV, HEAD_DIM, HEAD_DIM), jnp.float32)
        yp, k, v, lf, s_new, sh_new = mixer_layer(yp, mk, mv, shift0, s0, None, p)
        fkp.append(k); fvp.append(v); flp.append(lf); mkp.append(mk); mvp.append(mv)
        rsp.append(s_new); rhp.append(sh_new)
        ys, k, v, lf, s_new, sh_new = mixer_layer(
            ys, cache_mem_k[l], cache_mem_v[l], state_rwkv_shift[l], state_rwkv[l],
            (cache_fox_k[l], cache_fox_v[l], cache_fox_logf[l]), p)
        fks.append(k); fvs.append(v); fls.append(lf); rss.append(s_new); rhs.append(sh_new)
    return (yp, ys,
            jnp.stack(fkp), jnp.stack(fvp), jnp.stack(flp), jnp.stack(mkp), jnp.stack(mvp),
            jnp.stack(rsp), jnp.stack(rhp),
            jnp.stack(fks), jnp.stack(fvs), jnp.stack(fls), jnp.stack(rss), jnp.stack(rhs))
```

```cpp
#include <hip/hip_runtime.h>
#include <cstdio>
#include <cstdint>
#include <cmath>
namespace pg8 {
#define PG8_LAS __attribute__((address_space(3)))
typedef unsigned short bf16_t;
typedef short bf16x8 __attribute__((ext_vector_type(8)));
typedef float f32x4 __attribute__((ext_vector_type(4)));
typedef unsigned u32x4 __attribute__((ext_vector_type(4)));
constexpr int BM = 256, BK = 64, HALF = 128, HTB = HALF * BK * 2  , STAGE_BYTES = 8 * HTB, NXCD = 8, WGM = 8;

__host__ __device__ __forceinline__ int lds_byte(int r, int c) { const int st = (r >> 4) * 2 + (c >> 5), rr = r & 15, cc = c & 31, ob = rr * 64 + cc * 2; return st * 1024 + (ob ^ (((ob >> 9) & 1) << 5)); }
__host__ __device__ __forceinline__ void stage_rc(int b, int& R, int& C) { const int st = b / 1024, sb = b % 1024, swz = sb ^ (((sb >> 9) & 1) << 5); R = (st >> 1) * 16 + swz / 64; C = (st & 1) * 32 + (swz % 64) / 2; }
__host__ __device__ __forceinline__ int perm32(int rho) { const int n = rho >> 4, i = rho & 15; return 8 * (i >> 2) + 4 * n + (i & 3); }

struct Unit { int pm, pn; };
struct Gemm { const bf16_t* A; const bf16_t* Bt; int M, N, K; };

struct StaticOrder {
    int nM, nN, nwg, G, c;
    __host__ __device__ void init(int M, int N, int G_, int c_) { nM = M / BM; nN = N / BM; nwg = nM * nN; G = G_; c = c_; }
    __host__ __device__ bool next(int i, Unit& u) const {
        const long L = (long)i * G + c; if (L >= nwg) return false;
        int wgid = (int)L; { const int q = nwg / NXCD, r = nwg % NXCD, xcd = wgid % NXCD, off = wgid / NXCD; wgid = (xcd < r ? xcd * (q + 1) : r * (q + 1) + (xcd - r) * q) + off; }
        const int nig = WGM * nN, gid = wgid / nig, fm = gid * WGM, gsz = (nM - fm) < WGM ? (nM - fm) : WGM;
        u.pm = fm + ((wgid % nig) % gsz); u.pn = (wgid % nig) / gsz; return true;
    }
    __device__ __forceinline__ void a_ready(const Unit&) const {}
    __device__ __forceinline__ void done(const Unit&) const {}
};

__device__ __forceinline__ unsigned cvt_pk_bf16(float lo, float hi) { unsigned r; asm volatile("v_cvt_pk_bf16_f32 %0, %1, %2" : "=v"(r) : "v"(lo), "v"(hi)); return r; }
typedef float f32x2 __attribute__((ext_vector_type(2)));
__device__ __forceinline__ f32x2 gelu_pk(f32x2 v) {
    const f32x2 av = __builtin_elementwise_abs(v), d = av * 0.2316418882f + 1.0f;
    f32x2 t; t.x = __builtin_amdgcn_rcpf(d.x); t.y = __builtin_amdgcn_rcpf(d.y);
    f32x2 q = t * 0.5307027145f + (-0.7265760135f); q = q * t + 0.7107068705f; q = q * t + (-0.142248368f); q = q * t + 0.127414796f; q = q * t;
    const f32x2 s = (v * v) * (-0.72134752044f);
    f32x2 e; e.x = __builtin_amdgcn_exp2f(s.x); e.y = __builtin_amdgcn_exp2f(s.y);
    const f32x2 m = v * (q * e), r = v - m;
    f32x2 o; o.x = v.x < 0.f ? m.x : r.x; o.y = v.y < 0.f ? m.y : r.y; return o;
}

template <int ACT  > struct EpiBf16 {
    static constexpr bool PERM = true, AFTER_DRAIN = false; static_assert(ACT == 0 || ACT == 1, "EpiBf16: ACT is 0 (none) or 1 (gelu_pk)");
    bf16_t* O; int ldc; const float* bias; int split_cols; size_t split_stride; float scale0;
    __device__ __forceinline__ void operator()(const f32x4 (&acc)[2][2][4][2], const Unit& u, int wr, int wc, int fr, int fq) const {
        const int row0 = u.pm * BM + wr * 64 + fr; int colt = u.pn * BM; bf16_t* base = O;
        float sc = 1.f; if (split_cols) { const int t = colt / split_cols; base += (size_t)t * split_stride; colt -= t * split_cols; if (t == 0) sc = scale0; }
        const int col0 = colt + wc * 32 + 8 * fq, bcol0 = u.pn * BM + wc * 32 + 8 * fq;
        f32x4 bv[2][2];
#pragma unroll
        for (int bj = 0; bj < 2; ++bj)
#pragma unroll
            for (int n = 0; n < 2; ++n) bv[bj][n] = bias ? *(const f32x4*)(bias + bcol0 + bj * HALF + 4 * n) : (f32x4){0.f, 0.f, 0.f, 0.f};
#pragma unroll
        for (int ai = 0; ai < 2; ++ai)
#pragma unroll
            for (int m = 0; m < 4; ++m) { bf16_t* rowp = base + (size_t)(row0 + ai * HALF + m * 16) * ldc + col0;
#pragma unroll
                for (int bj = 0; bj < 2; ++bj) { f32x4 v0 = acc[ai][bj][m][0] + bv[bj][0], v1 = acc[ai][bj][m][1] + bv[bj][1];
                    if (ACT == 1) { f32x2 a = gelu_pk((f32x2){v0[0], v0[1]}), b = gelu_pk((f32x2){v0[2], v0[3]}), c = gelu_pk((f32x2){v1[0], v1[1]}), d = gelu_pk((f32x2){v1[2], v1[3]});
                        v0 = (f32x4){a.x, a.y, b.x, b.y}; v1 = (f32x4){c.x, c.y, d.x, d.y}; }
                    v0 = v0 * sc; v1 = v1 * sc; u32x4 w; w.x = cvt_pk_bf16(v0[0], v0[1]); w.y = cvt_pk_bf16(v0[2], v0[3]); w.z = cvt_pk_bf16(v1[0], v1[1]); w.w = cvt_pk_bf16(v1[2], v1[3]);
                    *(u32x4*)(rowp + bj * HALF) = w; } }
    }
};


template <class Epi, class Sched, bool ALIGN_EPI = false, bool SP2 = false>
__device__ __forceinline__ void gemm_phase(PG8_LAS unsigned char* lds, const Gemm g, const Sched& S, const Epi& E) {
    const int tid = threadIdx.x, wid = __builtin_amdgcn_readfirstlane(tid >> 6), lane = tid & 63, wr = wid >> 2, wc = wid & 3, fr = lane & 15, fq = lane >> 4;
    const int K = g.K, nt = K / BK;
    unsigned voffA[2], voffB[2];
#pragma unroll
    for (int i = 0; i < 2; ++i) { int R, C; stage_rc(tid * 16 + i * 8192, R, C); const int Rb = Epi::PERM ? ((R & ~31) + perm32(R & 31)) : R;
        voffA[i] = (unsigned)(R * K + C) * 2u; voffB[i] = (unsigned)(Rb * K + C) * 2u; }
    const size_t kstep = (size_t)(BK * 2);
    const size_t hstep = (size_t)HALF * K * 2;
    const size_t tstep = 2 * hstep;
    const unsigned ldsw = (unsigned)wid * 1024u;
    const int aoff = lds_byte(wr * 64 + fr, fq * 8), boff = lds_byte(wc * 32 + fr, fq * 8);
#define PG8_SA(b, h) (((b) * 2 + (h)) * HTB)
#define PG8_SB(b, h) ((4 + (b) * 2 + (h)) * HTB)
#define PG8_STAGE(bufoff, gbase, voff) do { _Pragma("unroll") for (int _i = 0; _i < 2; ++_i) \
        __builtin_amdgcn_global_load_lds((const unsigned*)((const char*)(gbase) + (voff)[_i]), (PG8_LAS unsigned*)(lds + (bufoff) + ldsw + _i * 8192), 16, 0, 0); } while (0)
#define PG8_LDA(dst, b, h) do { _Pragma("unroll") for (int m = 0; m < 4; ++m) _Pragma("unroll") for (int k = 0; k < 2; ++k) dst[m][k] = *(const PG8_LAS bf16x8*)(lds + PG8_SA(b, h) + aoff + m * 2048 + k * 1024); } while (0)
#define PG8_LDB(dst, b, h) do { _Pragma("unroll") for (int n = 0; n < 2; ++n) _Pragma("unroll") for (int k = 0; k < 2; ++k) dst[n][k] = *(const PG8_LAS bf16x8*)(lds + PG8_SB(b, h) + boff + n * 2048 + k * 1024); } while (0)
#define PG8_MMA(ai, bj, At, Bt) do { __builtin_amdgcn_s_setprio(1); _Pragma("unroll") for (int m = 0; m < 4; ++m) _Pragma("unroll") for (int n = 0; n < 2; ++n) _Pragma("unroll") for (int k = 0; k < 2; ++k) \
        acc[ai][bj][m][n] = __builtin_amdgcn_mfma_f32_16x16x32_bf16(Bt[n][k], At[m][k], acc[ai][bj][m][n], 0, 0, 0); __builtin_amdgcn_s_setprio(0); } while (0)
#define PG8_WAIT_V(n) asm volatile("s_waitcnt vmcnt(" #n ")" ::: "memory")
#define PG8_WAIT_L(n) asm volatile("s_waitcnt lgkmcnt(" #n ")" ::: "memory")
#define PG8_BAR __builtin_amdgcn_s_barrier()
#define PG8_SCHED __builtin_amdgcn_sched_barrier(0)
    Unit cur, nxt; int ui = 0;
    if (!S.next(0, cur)) return;
    f32x4 acc[2][2][4][2];
#pragma unroll
    for (int a = 0; a < 2; ++a)
#pragma unroll
        for (int b = 0; b < 2; ++b)
#pragma unroll
            for (int m = 0; m < 4; ++m)
#pragma unroll
                for (int n = 0; n < 2; ++n) acc[a][b][m][n] = (f32x4){0.f, 0.f, 0.f, 0.f};
    bf16x8 At[4][2], B0[2][2], B1[2][2];
    const char* cA = (const char*)g.A + (size_t)cur.pm * tstep; const char* cB = (const char*)g.Bt + (size_t)cur.pn * tstep;
    S.a_ready(cur);
    if constexpr (SP2) {
        PG8_STAGE(PG8_SB(0, 0), cB, voffB); PG8_STAGE(PG8_SB(0, 1), cB + hstep, voffB); PG8_STAGE(PG8_SA(0, 0), cA, voffA); PG8_STAGE(PG8_SA(0, 1), cA + hstep, voffA);
        if (wr == 1) PG8_BAR;
        PG8_WAIT_V(2); PG8_BAR;
        PG8_STAGE(PG8_SB(1, 0), cB + kstep, voffB); PG8_STAGE(PG8_SA(1, 0), cA + kstep, voffA); PG8_STAGE(PG8_SB(1, 1), cB + hstep + kstep, voffB);
        PG8_WAIT_V(6); PG8_BAR;
    } else {
        PG8_STAGE(PG8_SB(0, 0), cB, voffB); PG8_STAGE(PG8_SA(0, 0), cA, voffA); PG8_STAGE(PG8_SB(0, 1), cB + hstep, voffB); PG8_STAGE(PG8_SA(0, 1), cA + hstep, voffA);
        if (wr == 1) PG8_BAR;
        PG8_WAIT_V(4); PG8_BAR;
        PG8_STAGE(PG8_SB(1, 0), cB + kstep, voffB); PG8_STAGE(PG8_SA(1, 0), cA + kstep, voffA); PG8_STAGE(PG8_SB(1, 1), cB + hstep + kstep, voffB);
        PG8_WAIT_V(6); PG8_BAR;
    }
    for (;;) {
        const bool has_next = S.next(ui + 1, nxt);
        const char* nA = has_next ? (const char*)g.A + (size_t)nxt.pm * tstep : cA; const char* nB = has_next ? (const char*)g.Bt + (size_t)nxt.pn * tstep : cB;
        for (int t = 0; t < nt; t += 2) {
            const bool last = (t == nt - 2);
            const char* a1 = cA + (size_t)(t + 1) * kstep;
            const char* a2 = last ? nA : cA + (size_t)(t + 2) * kstep; const char* b2 = last ? nB : cB + (size_t)(t + 2) * kstep;
            const char* a3 = a2 + kstep; const char* b3 = b2 + kstep;
            if (last && has_next) S.a_ready(nxt);
            if constexpr (SP2) {
            PG8_LDB(B0, 0, 0); PG8_LDB(B1, 0, 1); PG8_SCHED; PG8_LDA(At, 0, 0); PG8_STAGE(PG8_SA(1, 1), a1 + hstep, voffA);
            PG8_WAIT_V(8); PG8_WAIT_L(0); PG8_BAR; PG8_MMA(0, 0, At, B0); PG8_MMA(0, 1, At, B1); PG8_BAR; PG8_SCHED;
            PG8_LDA(At, 0, 1); PG8_STAGE(PG8_SB(0, 0), b2, voffB); PG8_STAGE(PG8_SB(0, 1), b2 + hstep, voffB); PG8_STAGE(PG8_SA(0, 0), a2, voffA);
            PG8_WAIT_V(8); PG8_WAIT_L(0); PG8_BAR; PG8_MMA(1, 0, At, B0); PG8_MMA(1, 1, At, B1); PG8_BAR; PG8_SCHED;
            PG8_LDB(B0, 1, 0); PG8_LDB(B1, 1, 1); PG8_SCHED; PG8_LDA(At, 1, 0); PG8_STAGE(PG8_SA(0, 1), a2 + hstep, voffA);
            PG8_WAIT_V(8); PG8_WAIT_L(0); PG8_BAR; PG8_MMA(0, 0, At, B0); PG8_MMA(0, 1, At, B1); PG8_BAR; PG8_SCHED;
            PG8_LDA(At, 1, 1); PG8_STAGE(PG8_SB(1, 0), b3, voffB); PG8_STAGE(PG8_SB(1, 1), b3 + hstep, voffB); PG8_STAGE(PG8_SA(1, 0), a3, voffA);
            PG8_WAIT_V(8); PG8_WAIT_L(0); PG8_BAR; PG8_MMA(1, 0, At, B0); PG8_MMA(1, 1, At, B1); PG8_BAR; PG8_SCHED;
            } else {
            PG8_LDB(B0, 0, 0); PG8_SCHED; PG8_LDA(At, 0, 0); PG8_STAGE(PG8_SA(1, 1), a1 + hstep, voffA);
            PG8_WAIT_L(8); PG8_BAR; PG8_WAIT_L(0); PG8_MMA(0, 0, At, B0); PG8_BAR; PG8_SCHED;
            PG8_LDB(B1, 0, 1); PG8_STAGE(PG8_SB(0, 0), b2, voffB);
            PG8_BAR; PG8_WAIT_L(0); PG8_MMA(0, 1, At, B1); PG8_BAR;
            PG8_LDA(At, 0, 1); PG8_STAGE(PG8_SA(0, 0), a2, voffA);
            PG8_BAR; PG8_WAIT_L(0); PG8_MMA(1, 0, At, B0); PG8_BAR; PG8_SCHED;
            PG8_STAGE(PG8_SB(0, 1), b2 + hstep, voffB);
            PG8_WAIT_V(6); PG8_BAR; PG8_MMA(1, 1, At, B1); PG8_BAR;
            PG8_LDB(B0, 1, 0); PG8_SCHED; PG8_LDA(At, 1, 0); PG8_STAGE(PG8_SA(0, 1), a2 + hstep, voffA);
            PG8_WAIT_L(8); PG8_BAR; PG8_WAIT_L(0); PG8_MMA(0, 0, At, B0); PG8_BAR; PG8_SCHED;
            PG8_LDB(B1, 1, 1); PG8_STAGE(PG8_SB(1, 0), b3, voffB);
            PG8_BAR; PG8_WAIT_L(0); PG8_MMA(0, 1, At, B1); PG8_BAR;
            PG8_LDA(At, 1, 1); PG8_STAGE(PG8_SA(1, 0), a3, voffA);
            PG8_BAR; PG8_WAIT_L(0); PG8_MMA(1, 0, At, B0); PG8_BAR; PG8_SCHED;
            PG8_STAGE(PG8_SB(1, 1), b3 + hstep, voffB);
            PG8_WAIT_V(6); PG8_BAR; PG8_MMA(1, 1, At, B1); PG8_BAR;
            }
        }
        if constexpr (ALIGN_EPI) { if (wr == 0) PG8_BAR; }
        if constexpr (!Epi::AFTER_DRAIN) { E(acc, cur, wr, wc, fr, fq); S.done(cur); }
        if (!has_next) break;
#pragma unroll
        for (int a = 0; a < 2; ++a)
#pragma unroll
            for (int b = 0; b < 2; ++b)
#pragma unroll
                for (int m = 0; m < 4; ++m)
#pragma unroll
                    for (int n = 0; n < 2; ++n) acc[a][b][m][n] = (f32x4){0.f, 0.f, 0.f, 0.f};
        cur = nxt; cA = nA; cB = nB; ++ui;
        if constexpr (ALIGN_EPI) { if (wr == 1) PG8_BAR; }
    }
    PG8_WAIT_V(0);
    if constexpr (!ALIGN_EPI) { if (wr == 0) PG8_BAR; }
    PG8_BAR;
    if constexpr (Epi::AFTER_DRAIN) { E.fused(acc, cur, wr, wc, fr, fq, lds, wid, lane); S.done(cur); }
#undef PG8_SA
#undef PG8_SB
#undef PG8_STAGE
#undef PG8_LDA
#undef PG8_LDB
#undef PG8_MMA
#undef PG8_WAIT_V
#undef PG8_WAIT_L
#undef PG8_BAR
#undef PG8_SCHED
}
}
#ifndef PG8_SP2
#define PG8_SP2 true
#endif
#ifndef PG8_ALIGN
#define PG8_ALIGN true
#endif
#define GAS __attribute__((address_space(1)))
#define LAS __attribute__((address_space(3)))
typedef unsigned short bf16;
typedef unsigned v4u __attribute__((ext_vector_type(4)));
typedef float f32x4 __attribute__((ext_vector_type(4)));
typedef short bf16x8 __attribute__((ext_vector_type(8)));
typedef GAS unsigned gu32;
typedef GAS unsigned long long gu64;
#define RLX_AGENT __ATOMIC_RELAXED, __HIP_MEMORY_SCOPE_AGENT
#define LDS_WAIT() asm volatile("s_waitcnt lgkmcnt(0)" ::: "memory")
#define VM_WAIT() asm volatile("s_waitcnt vmcnt(0)" ::: "memory")
__device__ __forceinline__ unsigned long long rt() { return __builtin_amdgcn_s_memrealtime(); }
__device__ __forceinline__ unsigned f2bf(float f) { unsigned u = __builtin_bit_cast(unsigned, f); return (u + 0x7fffu + ((u >> 16) & 1u)) >> 16; }
__device__ __forceinline__ unsigned pk2(float lo, float hi) { return f2bf(lo) | (f2bf(hi) << 16); }

#define XB_TMO      128
#define XB_XCNT(j)  (256  + 64 * (j))
#define XB_XSUB(j)  (1280 + 64 * (j))
#define XB_XGEN(j)  (2304 + 64 * (j))
#define XB_TOP      3328
#define XB_TOPGEN   3392
#define XCD_BAR_WORDS 3456
#define XB_SPIN_CAP (1u << 18)

__device__ __forceinline__ unsigned xb_ld(unsigned* p)              { return __hip_atomic_load(p, __ATOMIC_RELAXED, __HIP_MEMORY_SCOPE_AGENT); }
__device__ __forceinline__ unsigned xb_add(unsigned* p, unsigned v) { return __hip_atomic_fetch_add(p, v, __ATOMIC_RELAXED, __HIP_MEMORY_SCOPE_AGENT); }
__device__ __forceinline__ unsigned xb_xcc_id() { return (unsigned)__builtin_amdgcn_s_getreg((3 << 11) | 20) & 0xFu; }
#define XB_SPIN(cond, bar) do { unsigned _sp = 0; while (cond) { __builtin_amdgcn_s_sleep(1); \
    if ((++_sp & 255u) == 0u) { if (xb_ld(&(bar)[XB_TMO])) break; if (_sp > XB_SPIN_CAP) { atomicAdd(&(bar)[XB_TMO], 1u); break; } } } } while (0)

struct XcdBarrier {
    unsigned* bar; unsigned x;
    volatile LAS unsigned* st;
};

__device__ __forceinline__ XcdBarrier xcd_barrier_post(unsigned* bar, volatile LAS unsigned* st) {
    XcdBarrier b; b.bar = bar; b.x = xb_xcc_id(); b.st = st;
    if (threadIdx.x == 0) (void)xb_add(&bar[XB_XCNT(b.x)], 1u);
    return b;
}
__device__ __forceinline__ void xcd_barrier_complete(unsigned* bar, unsigned x, unsigned& nloc, unsigned& nx) {
    const unsigned G = gridDim.x * gridDim.y * gridDim.z;
    unsigned sum, cnt, mine, sp = 0u;
    for (;;) {
        sum = 0u; cnt = 0u; mine = 0u;
#pragma unroll
        for (unsigned j = 0; j < 16; ++j) { const unsigned c = xb_ld(&bar[XB_XCNT(j)]); sum += c; cnt += (c > 0u) ? 1u : 0u; mine = (j == x) ? c : mine; }
        if (sum == G) break;
        __builtin_amdgcn_s_sleep(1);
        if ((++sp & 255u) == 0u) { if (xb_ld(&bar[XB_TMO])) break; if (sp > XB_SPIN_CAP) { atomicAdd(&bar[XB_TMO], 1u); break; } }
    }
    nloc = mine > 0u ? mine : 1u; nx = cnt > 0u ? cnt : 1u;
}

__device__ __forceinline__ void xcd_barrier(const XcdBarrier& b) {
    asm volatile("s_waitcnt vmcnt(0)" ::: "memory");
    __syncthreads();
    if (threadIdx.x == 0) {
        unsigned* bar = b.bar;
        __builtin_amdgcn_s_waitcnt(0);
        unsigned nloc = b.st[0], nx = b.st[1];
        if (nloc == 0u) { xcd_barrier_complete(bar, b.x, nloc, nx); b.st[0] = nloc; b.st[1] = nx; }
        const unsigned old = xb_add(&bar[XB_XSUB(b.x)], 1u);
        const unsigned gen = old / nloc;
        if (old + 1u == (gen + 1u) * nloc) {
            __builtin_amdgcn_fence(__ATOMIC_RELEASE, "agent");
            asm volatile("s_waitcnt vmcnt(0)" ::: "memory");
            const unsigned og = xb_add(&bar[XB_TOP], 1u);
            const unsigned tg = og / nx;
            if (og + 1u == (tg + 1u) * nx) xb_add(&bar[XB_TOPGEN], 1u);
            else XB_SPIN(xb_ld(&bar[XB_TOPGEN]) == tg, bar);
            __builtin_amdgcn_fence(__ATOMIC_ACQUIRE, "agent");
            xb_add(&bar[XB_XGEN(b.x)], 1u);
            asm volatile("s_waitcnt vmcnt(0)" ::: "memory");
        } else {
            XB_SPIN(xb_ld(&bar[XB_XGEN(b.x)]) == gen, bar);
            __builtin_amdgcn_fence(__ATOMIC_ACQUIRE, "agent");
            asm volatile("s_waitcnt vmcnt(0)" ::: "memory");
        }
    }
    __syncthreads();
}

constexpr int NWAVES = 8;
#ifndef DBG_MEMREF
#define DBG_MEMREF 0
#endif
#ifndef RWM
#define RWM 15
#endif
#ifndef MK_ONE_LAUNCH
#define MK_ONE_LAUNCH 0
#endif
constexpr int N_PHASES = 6;

constexpr int DM = 1024, BATCH = 8, SEQ = 4096, DECB = 32, DECS = 16, PAST = 1024, NMEM = 256;
constexpr int MP = BATCH * SEQ, MS = DECB * DECS, MT = MP + MS;
constexpr int NIN = 3654, NP = 3840;
constexpr int HC_FQ = 0, HC_FK = 384, HC_FV = 768, HC_FG = 1152, HC_RR = 1536, HC_RK = 1920, HC_RV = 2304, HC_RG = 2688,
              HC_MQ = 3072, HC_MG = 3328, HC_WD = 3584, HC_AD = 3616, HC_FF = 3648;
constexpr float NORM_EPS = 1e-6f, GN_EPS = 64e-5f, LOG2E = 1.4426950408889634f, C2 = 0.125f * 1.4426950408889634f;

constexpr size_t O_YP = 0, O_YS = O_YP + (size_t)MP * DM, O_FKP = O_YS + (size_t)MS * DM, O_FVP = O_FKP + (size_t)MP * 384, O_FLP = O_FVP + (size_t)MP * 384,
                 O_MKP = O_FLP + (size_t)MP * 6, O_MVP = O_MKP + (size_t)BATCH * NMEM * 256, O_RSP = O_MVP + (size_t)BATCH * NMEM * 256, O_RHP = O_RSP + (size_t)BATCH * 6 * 4096,
                 O_FKS = O_RHP + (size_t)BATCH * 1600, O_FVS = O_FKS + (size_t)MS * 384, O_FLS = O_FVS + (size_t)MS * 384, O_RSS = O_FLS + (size_t)MS * 6,
                 O_RHS = O_RSS + (size_t)DECB * 6 * 4096, O_END = O_RHS + (size_t)DECB * 1600;
static_assert(O_END == 61933056, "d_out map");

constexpr size_t MiB = 1u << 20;
constexpr size_t WS_CTL = 0, CTL_ZERO_BYTES = 1 * MiB;
constexpr size_t WS_WIN = 2 * MiB, WS_WOUT = 10 * MiB, WS_WMEM = 12 * MiB, WS_MEMN = 13 * MiB, WS_MKV = 17 * MiB, WS_NCKP = 19 * MiB, WS_NCKS = 20 * MiB;
constexpr size_t WS_XN = 24 * MiB;
constexpr size_t WS_H = 96 * MiB;
constexpr size_t WS_END = WS_H + (size_t)MT * NP * 2;
static_assert(WS_XN + (size_t)MT * DM * 2 <= WS_H && WS_END <= 400 * MiB, "d_ws map");
constexpr int CW_BAR = 4096, CW_Q = 64;

constexpr int RING_OFF = 0, RING_BYTES = 131072;
constexpr int LDSCTL_OFF = RING_BYTES, MISC_OFF = LDSCTL_OFF + 320;
constexpr int LDS_BYTES = 147456;

struct Args { const float* in[30]; float* out; unsigned char* ws; int ph_lo, ph_hi, li, pad; };
enum { I_XP = 0, I_XS, I_MEMP, I_CFK, I_CFV, I_CFL, I_CMK, I_CMV, I_SRW, I_SSH, I_NG, I_WIN, I_FQG, I_FKG, I_FBF, I_MU, I_W0, I_WUP, I_A0, I_AUP,
       I_KK, I_KA, I_RK, I_GNW, I_GNB, I_MNG, I_WMKV, I_MQG, I_MKG, I_WOUT };

struct Ctx { LAS unsigned char* lds; volatile LAS unsigned* MISC; gu32* ctl; int tid, lane, wave, vcu, G; };

__device__ __forceinline__ float bf2f(bf16 u) { return __uint_as_float((unsigned)u << 16); }
__device__ __forceinline__ float wave_sum(float v) {
#pragma unroll
    for (int o = 1; o < 64; o <<= 1) v += __shfl_xor(v, o);
    return v;
}
__device__ __forceinline__ float wave_max(float v) {
#pragma unroll
    for (int o = 1; o < 64; o <<= 1) v = fmaxf(v, __shfl_xor(v, o));
    return v;
}
__device__ __forceinline__ float sum8(float v) { v += __shfl_xor(v, 1); v += __shfl_xor(v, 2); v += __shfl_xor(v, 4); return v; }
__device__ __forceinline__ void unpack8(const v4u w, float (&f)[8]) {
    f[0] = __uint_as_float(w.x << 16); f[1] = __uint_as_float(w.x & 0xffff0000u); f[2] = __uint_as_float(w.y << 16); f[3] = __uint_as_float(w.y & 0xffff0000u);
    f[4] = __uint_as_float(w.z << 16); f[5] = __uint_as_float(w.z & 0xffff0000u); f[6] = __uint_as_float(w.w << 16); f[7] = __uint_as_float(w.w & 0xffff0000u); }
__device__ __forceinline__ void ld8(const float* p, float (&f)[8]) { const f32x4 a = *(const f32x4*)p, b = *(const f32x4*)(p + 4);
    f[0] = a.x; f[1] = a.y; f[2] = a.z; f[3] = a.w; f[4] = b.x; f[5] = b.y; f[6] = b.z; f[7] = b.w; }
__device__ __forceinline__ float siluf(float g) { return g / (1.f + __expf(-g)); }
__device__ __forceinline__ float softplusf(float z) { return fmaxf(z, 0.f) + log1pf(__expf(-fabsf(z))); }

__device__ __forceinline__ int colmap_in(int n) {
    if (n < 1152) return n;
    if (n < 1158) return HC_FF + (n - 1152);
    if (n < 1542) return HC_FG + (n - 1158);
    if (n < 3142) { const int m = n - 1542;
        if (m < 1152) return HC_RR + m;
        if (m < 1184) return HC_WD + (m - 1152);
        if (m < 1216) return HC_AD + (m - 1184);
        return HC_RG + (m - 1216); }
    return HC_MQ + (n - 3142);
}
template <int MODE>
__device__ __forceinline__ void transpose_item(const float* W, int K, int N, bf16* WT, LAS float* scr, int item, int lane) {
    const int nblk = (N + 31) / 32, kb = item / nblk, nb = item % nblk, k0 = 64 * kb, n0 = 32 * nb;
    const int nl0 = lane & 31; const bool okn = (n0 + nl0) < N;
#pragma unroll 8
    for (int i = 0; i < 32; ++i) { const int kk = 2 * i + (lane >> 5); scr[kk * 33 + nl0] = okn ? W[(size_t)(k0 + kk) * N + n0 + nl0] : 0.f; }
    LDS_WAIT(); asm volatile("" ::: "memory");
    const int c = lane & 7;
#pragma unroll
    for (int j = 0; j < 4; ++j) { const int nl = (lane >> 3) + 8 * j, n = n0 + nl; const LAS float* s = scr + (8 * c) * 33 + nl;
        v4u o; o.x = pk2(s[0 * 33], s[1 * 33]); o.y = pk2(s[2 * 33], s[3 * 33]); o.z = pk2(s[4 * 33], s[5 * 33]); o.w = pk2(s[6 * 33], s[7 * 33]);
        if (n < N) { const int row = (MODE == 0) ? colmap_in(n) : n; *(v4u*)(WT + (size_t)row * K + k0 + 8 * c) = o; } }
    LDS_WAIT(); asm volatile("" ::: "memory");
}
__device__ __forceinline__ void rms_row_to_bf16(const float* xrow, const float* g, bf16* orow, int lane) {
    const f32x4* xr = (const f32x4*)xrow + lane; const f32x4* gr = (const f32x4*)g + lane;
    f32x4 v[4]; float s = 0.f;
#pragma unroll
    for (int j = 0; j < 4; ++j) { v[j] = xr[64 * j]; s += (v[j].x * v[j].x + v[j].y * v[j].y) + (v[j].z * v[j].z + v[j].w * v[j].w); }
    const float rstd = 1.0f / sqrtf(wave_sum(s) * (1.f / DM) + NORM_EPS);
    unsigned long long* o8 = (unsigned long long*)orow + lane;
#pragma unroll
    for (int j = 0; j < 4; ++j) { const f32x4 gg = gr[64 * j]; const f32x4 y = v[j] * rstd * gg;
        o8[64 * j] = (unsigned long long)pk2(y.x, y.y) | ((unsigned long long)pk2(y.z, y.w) << 32); }
}
__device__ __forceinline__ void p0_prologue(const Ctx& F, const Args& a) {
    LAS float* scr = (LAS float*)(F.lds + RING_OFF + F.wave * 16384);
    const int gw = F.vcu * NWAVES + F.wave, NGW = F.G * NWAVES;
    bf16* WinT = (bf16*)(a.ws + WS_WIN); bf16* WoutT = (bf16*)(a.ws + WS_WOUT); bf16* WmemT = (bf16*)(a.ws + WS_WMEM);
    constexpr int I_IN = (DM / 64) * ((NIN + 31) / 32), I_OUT = (DM / 64) * (DM / 32), I_MEM = (DM / 64) * (512 / 32);
    for (int it = gw; it < I_IN + I_OUT + I_MEM; it += NGW) {
        int r = it;
        if (r < I_IN) { transpose_item<0>(a.in[I_WIN], DM, NIN, WinT, scr, r, F.lane); continue; } r -= I_IN;
        if (r < I_OUT) { transpose_item<1>(a.in[I_WOUT], DM, DM, WoutT, scr, r, F.lane); continue; } r -= I_OUT;
        transpose_item<1>(a.in[I_WMKV], DM, 512, WmemT, scr, r, F.lane);
    }
    for (int r = NIN + gw; r < NP; r += NGW) { v4u z = {0u, 0u, 0u, 0u}; v4u* p = (v4u*)(WinT + (size_t)r * DM); p[F.lane] = z; p[F.lane + 64] = z; }
    bf16* XN = (bf16*)(a.ws + WS_XN); bf16* MEMN = (bf16*)(a.ws + WS_MEMN);
    for (int m = gw; m < MT + BATCH * NMEM; m += NGW) {
        if (m < MP) rms_row_to_bf16(a.in[I_XP] + (size_t)m * DM, a.in[I_NG], XN + (size_t)m * DM, F.lane);
        else if (m < MT) rms_row_to_bf16(a.in[I_XS] + (size_t)(m - MP) * DM, a.in[I_NG], XN + (size_t)m * DM, F.lane);
        else rms_row_to_bf16(a.in[I_MEMP] + (size_t)(m - MT) * DM, a.in[I_MNG], MEMN + (size_t)(m - MT) * DM, F.lane);
    }
}

__device__ __forceinline__ void p2_prep(const Ctx& F, const Args& a) {
    const int gw = F.vcu * NWAVES + F.wave, NGW = F.G * NWAVES, l = F.lane;
    bf16* H = (bf16*)(a.ws + WS_H); bf16* MKV = (bf16*)(a.ws + WS_MKV); float* out = a.out;
    const float gq = a.in[I_FQG][l] * C2, gk = a.in[I_FKG][l], gmq = a.in[I_MQG][l] * C2, gmk = a.in[I_MKG][l];
    for (int m = gw; m < MT + BATCH * NMEM; m += NGW) {
        if (m < MT) {
            bf16* hr = H + (size_t)m * NP;
            float* ok = (m < MP) ? out + O_FKP + (size_t)m * 384 : out + O_FKS + (size_t)(m - MP) * 384;
            float* ov = (m < MP) ? out + O_FVP + (size_t)m * 384 : out + O_FVS + (size_t)(m - MP) * 384;
            float* ol = (m < MP) ? out + O_FLP + (size_t)m * 6 : out + O_FLS + (size_t)(m - MP) * 6;
#pragma unroll
            for (int h = 0; h < 6; ++h) {
                const float q = bf2f(hr[HC_FQ + h * 64 + l]), k = bf2f(hr[HC_FK + h * 64 + l]), v = bf2f(hr[HC_FV + h * 64 + l]);
                const float rq = 1.0f / sqrtf(wave_sum(q * q) * (1.f / 64.f) + NORM_EPS), rk = 1.0f / sqrtf(wave_sum(k * k) * (1.f / 64.f) + NORM_EPS);
                const float kn = k * rk * gk;
                hr[HC_FQ + h * 64 + l] = (bf16)f2bf(q * rq * gq); hr[HC_FK + h * 64 + l] = (bf16)f2bf(kn);
                ok[h * 64 + l] = kn; ov[h * 64 + l] = v;
            }
#pragma unroll
            for (int h = 0; h < 4; ++h) {
                const float q = bf2f(hr[HC_MQ + h * 64 + l]);
                const float rq = 1.0f / sqrtf(wave_sum(q * q) * (1.f / 64.f) + NORM_EPS);
                hr[HC_MQ + h * 64 + l] = (bf16)f2bf(q * rq * gmq);
            }
            if (l < 6) { const float z = bf2f(hr[HC_FF + l]) + a.in[I_FBF][l]; ol[l] = -softplusf(-z); }
        } else {
            const int mm = m - MT; bf16* kr = MKV + (size_t)mm * 512;
#pragma unroll
            for (int h = 0; h < 4; ++h) {
                const float k = bf2f(kr[h * 64 + l]), v = bf2f(kr[256 + h * 64 + l]);
                const float rk = 1.0f / sqrtf(wave_sum(k * k) * (1.f / 64.f) + NORM_EPS);
                const float kn = k * rk * gmk;
                kr[h * 64 + l] = (bf16)f2bf(kn);
                out[O_MKP + (size_t)mm * 256 + h * 64 + l] = kn; out[O_MVP + (size_t)mm * 256 + h * 64 + l] = v;
            }
        }
    }
}

__device__ __forceinline__ float wave_incl_scan(float v, int lane) {
#pragma unroll
    for (int o = 1; o < 64; o <<= 1) { const float n = __shfl_up(v, o); if (lane >= o) v += n; }
    return v;
}
__device__ __forceinline__ void p3_nck(const Ctx& F, const Args& a) {
    const int gw = F.vcu * NWAVES + F.wave, NGW = F.G * NWAVES, l = F.lane;
    float* NCKP = (float*)(a.ws + WS_NCKP); float* NCKS = (float*)(a.ws + WS_NCKS); const float* out = a.out;
    for (int it = gw; it < 48 + 192; it += NGW) {
        if (it < 48) { const int b = it / 6, h = it % 6; const float* lf = out + O_FLP + ((size_t)b * SEQ) * 6 + h;
            float s = 0.f; for (int i = 0; i < 64; ++i) s += lf[(size_t)(64 * l + i) * 6];
            const float incl = wave_incl_scan(s, l); float run = incl - s;
            float* dst = NCKP + (size_t)it * SEQ + 64 * l;
            for (int i = 0; i < 64; ++i) { run += lf[(size_t)(64 * l + i) * 6]; dst[i] = -run * LOG2E; }
        } else { const int bh = it - 48, b = bh / 6, h = bh % 6; const float* lf = a.in[I_CFL] + ((size_t)b * PAST) * 6 + h;
            float s = 0.f; for (int i = 0; i < 16; ++i) s += lf[(size_t)(16 * l + i) * 6];
            const float incl = wave_incl_scan(s, l); const float tot = __shfl(incl, 63);
            float run = tot - incl;
            float* dst = NCKS + (size_t)bh * 1040;
            for (int i = 15; i >= 0; --i) { dst[16 * l + i] = run * LOG2E; run += lf[(size_t)(16 * l + i) * 6]; }
            if (l == 0) { const float* ln = out + O_FLS + ((size_t)b * DECS) * 6 + h; float r2 = 0.f;
                for (int i = 0; i < 16; ++i) { r2 += ln[(size_t)i * 6]; dst[1024 + i] = -r2 * LOG2E; } }
        }
    }
}

typedef float f32x16 __attribute__((ext_vector_type(16)));
typedef unsigned u32x2 __attribute__((ext_vector_type(2)));
__device__ __forceinline__ int crow(int r, int hi) { return (r & 3) + 8 * (r >> 2) + 4 * hi; }

struct AttnP { const bf16* Q; int qpitch; const bf16* K; int kpitch; const bf16* V; int vpitch; const float* nck; const bf16* Gt; int gpitch; bf16* O; int opitch; int nt; int q0; int causal; };
constexpr int AT_KS = 0, AT_VT = 9216, AT_NK = 18432, AT_PS = 18688, AT_AL = AT_PS + 8 * 4608;
__device__ __forceinline__ void attn_unit(LAS unsigned char* lds, const AttnP& p, int tid, int lane, int wave) {
    const int r32 = lane & 31, hi = lane >> 5;
    LAS unsigned char* KS = lds + AT_KS; LAS unsigned char* VT = lds + AT_VT; LAS float* NK = (LAS float*)(lds + AT_NK);
    LAS unsigned char* PS = lds + AT_PS + wave * 4608; LAS float* AL = (LAS float*)(lds + AT_AL) + wave * 32;
    bf16x8 qr[4];
    { const bf16* qrow = p.Q + (size_t)(wave * 32 + r32) * p.qpitch;
#pragma unroll
      for (int d0 = 0; d0 < 4; ++d0) qr[d0] = *(const bf16x8*)(qrow + 16 * d0 + 8 * hi); }
    const int srow = tid >> 3, spc = tid & 7;
    v4u kreg = *(const v4u*)(p.K + (size_t)srow * p.kpitch + 8 * spc);
    const int vpr = tid >> 4, vc = tid & 15;
    u32x2 vra = *(const u32x2*)(p.V + (size_t)(2 * vpr) * p.vpitch + 4 * vc), vrb = *(const u32x2*)(p.V + (size_t)(2 * vpr + 1) * p.vpitch + 4 * vc);
    float nreg = (p.nck && tid < 64) ? p.nck[tid] : 0.f;
    f32x16 o0, o1;
#pragma unroll
    for (int r = 0; r < 16; ++r) { o0[r] = 0.f; o1[r] = 0.f; }
    float m_run = -INFINITY, l_run = 0.f;
    for (int t = 0; t < p.nt; ++t) {
        __syncthreads();
        *(LAS v4u*)(KS + srow * 144 + 16 * spc) = kreg;
        { LAS unsigned* vt = (LAS unsigned*)(VT + (4 * vc) * 144 + 4 * vpr);
          vt[0] = (vra.x & 0xffffu) | (vrb.x << 16); vt[36] = (vra.x >> 16) | (vrb.x & 0xffff0000u);
          vt[72] = (vra.y & 0xffffu) | (vrb.y << 16); vt[108] = (vra.y >> 16) | (vrb.y & 0xffff0000u); }
        if (tid < 64) NK[tid] = nreg;
        __syncthreads();
        if (t + 1 < p.nt) {
            kreg = *(const v4u*)(p.K + (size_t)((t + 1) * 64 + srow) * p.kpitch + 8 * spc);
            vra = *(const u32x2*)(p.V + (size_t)((t + 1) * 64 + 2 * vpr) * p.vpitch + 4 * vc); vrb = *(const u32x2*)(p.V + (size_t)((t + 1) * 64 + 2 * vpr + 1) * p.vpitch + 4 * vc);
            nreg = (p.nck && tid < 64) ? p.nck[(t + 1) * 64 + tid] : 0.f;
        }
        f32x16 c0, c1;
#pragma unroll
        for (int g = 0; g < 4; ++g) { const f32x4 a0 = *(const LAS f32x4*)(NK + 8 * g + 4 * hi), a1 = *(const LAS f32x4*)(NK + 32 + 8 * g + 4 * hi);
            c0[4 * g] = a0.x; c0[4 * g + 1] = a0.y; c0[4 * g + 2] = a0.z; c0[4 * g + 3] = a0.w;
            c1[4 * g] = a1.x; c1[4 * g + 1] = a1.y; c1[4 * g + 2] = a1.z; c1[4 * g + 3] = a1.w; }
#pragma unroll
        for (int d0 = 0; d0 < 4; ++d0) {
            const bf16x8 k0 = *(const LAS bf16x8*)(KS + r32 * 144 + 32 * d0 + 16 * hi);
            const bf16x8 k1 = *(const LAS bf16x8*)(KS + (32 + r32) * 144 + 32 * d0 + 16 * hi);
            c0 = __builtin_amdgcn_mfma_f32_32x32x16_bf16(k0, qr[d0], c0, 0, 0, 0);
            c1 = __builtin_amdgcn_mfma_f32_32x32x16_bf16(k1, qr[d0], c1, 0, 0, 0);
        }
        if (p.causal && (t * 64 + 63 > p.q0 + wave * 32)) {
            const int qg = p.q0 + wave * 32 + r32, kb = t * 64 + 4 * hi;
#pragma unroll
            for (int r = 0; r < 16; ++r) { const int kv = kb + (r & 3) + 8 * (r >> 2); if (kv > qg) c0[r] = -INFINITY; if (kv + 32 > qg) c1[r] = -INFINITY; }
        }
        float mx = fmaxf(c0[0], c1[0]);
#pragma unroll
        for (int r = 1; r < 16; ++r) mx = fmaxf(mx, fmaxf(c0[r], c1[r]));
        mx = fmaxf(mx, __shfl_xor(mx, 32));
        const float mn = fmaxf(m_run, mx);
        const float alpha = __builtin_amdgcn_exp2f(m_run - mn);
        m_run = mn;
        float sum = 0.f;
#pragma unroll
        for (int r = 0; r < 16; ++r) { c0[r] = __builtin_amdgcn_exp2f(c0[r] - mn); c1[r] = __builtin_amdgcn_exp2f(c1[r] - mn); sum += c0[r] + c1[r]; }
        l_run = l_run * alpha + sum;
#pragma unroll
        for (int g = 0; g < 4; ++g) {
            u32x2 w0, w1; w0.x = pk2(c0[4 * g], c0[4 * g + 1]); w0.y = pk2(c0[4 * g + 2], c0[4 * g + 3]);
            w1.x = pk2(c1[4 * g], c1[4 * g + 1]); w1.y = pk2(c1[4 * g + 2], c1[4 * g + 3]);
            *(LAS u32x2*)(PS + r32 * 144 + (8 * g + 4 * hi) * 2) = w0;
            *(LAS u32x2*)(PS + r32 * 144 + 64 + (8 * g + 4 * hi) * 2) = w1;
        }
        if (hi == 0) AL[r32] = alpha;
        asm volatile("s_waitcnt lgkmcnt(0)" ::: "memory"); __builtin_amdgcn_wave_barrier();
#pragma unroll
        for (int g = 0; g < 4; ++g) { const f32x4 al = *(const LAS f32x4*)(AL + 8 * g + 4 * hi);
            o0[4 * g] *= al.x; o0[4 * g + 1] *= al.y; o0[4 * g + 2] *= al.z; o0[4 * g + 3] *= al.w;
            o1[4 * g] *= al.x; o1[4 * g + 1] *= al.y; o1[4 * g + 2] *= al.z; o1[4 * g + 3] *= al.w; }
#pragma unroll
        for (int s = 0; s < 4; ++s) {
            const bf16x8 pa = *(const LAS bf16x8*)(PS + r32 * 144 + 32 * s + 16 * hi);
            const bf16x8 v0 = *(const LAS bf16x8*)(VT + r32 * 144 + 32 * s + 16 * hi);
            const bf16x8 v1 = *(const LAS bf16x8*)(VT + (32 + r32) * 144 + 32 * s + 16 * hi);
            o0 = __builtin_amdgcn_mfma_f32_32x32x16_bf16(pa, v0, o0, 0, 0, 0);
            o1 = __builtin_amdgcn_mfma_f32_32x32x16_bf16(pa, v1, o1, 0, 0, 0);
        }
    }
    l_run += __shfl_xor(l_run, 32);
    if (hi == 0) AL[r32] = 1.0f / l_run;
    asm volatile("s_waitcnt lgkmcnt(0)" ::: "memory"); __builtin_amdgcn_wave_barrier();
#pragma unroll
    for (int r = 0; r < 16; ++r) {
        const int q = wave * 32 + crow(r, hi); const float li = AL[crow(r, hi)];
        const float g0 = bf2f(p.Gt[(size_t)q * p.gpitch + r32]), g1 = bf2f(p.Gt[(size_t)q * p.gpitch + 32 + r32]);
        p.O[(size_t)q * p.opitch + r32] = (bf16)f2bf(o0[r] * li * siluf(g0));
        p.O[(size_t)q * p.opitch + 32 + r32] = (bf16)f2bf(o1[r] * li * siluf(g1));
    }
}


__device__ __forceinline__ void ref_attn_unit(LAS unsigned char* lds, const AttnP& p, int lane, int wave) {
    LAS float* QS = (LAS float*)lds + wave * 64; LAS float* SS = (LAS float*)(lds + 2048) + wave * 1056;
    const int nk = p.nt * 64;
    for (int qi = wave * 32; qi < wave * 32 + 32; ++qi) {
        QS[lane] = bf2f(p.Q[(size_t)qi * p.qpitch + lane]);
        float mx = -INFINITY;
        for (int j = lane; j < nk; j += 64) {
            float dot = 0.f; const bf16* kr = p.K + (size_t)j * p.kpitch;
            for (int d = 0; d < 64; ++d) dot += bf2f(kr[d]) * QS[d];
            SS[j] = dot; mx = fmaxf(mx, dot);
        }
        mx = wave_max(mx);
        float sum = 0.f;
        for (int j = lane; j < nk; j += 64) { const float e = __builtin_amdgcn_exp2f(SS[j] - mx); SS[j] = e; sum += e; }
        sum = wave_sum(sum);
        float acc = 0.f;
        for (int j = 0; j < nk; ++j) acc += SS[j] * bf2f(p.V[(size_t)j * p.vpitch + lane]);
        const float g = bf2f(p.Gt[(size_t)qi * p.gpitch + lane]);
        p.O[(size_t)qi * p.opitch + lane] = (bf16)f2bf(acc / sum * siluf(g));
    }
}

struct SmallP { const bf16* Q; int qpitch; const float* Kc; int kpitch; const float* Vc; int vpitch; int P; const float* nck; const bf16* Kn; const bf16* Vn; int npitch; const bf16* Gt; int gpitch; bf16* O; int opitch; };
__device__ __forceinline__ void small_attn(LAS unsigned char* lds, const SmallP& p, int lane, int wave) {
    LAS float* QS = (LAS float*)lds + wave * 64; LAS float* SS = (LAS float*)(lds + 2048) + wave * 1056;
    for (int qi = wave; qi < 16; qi += 8) {
        QS[lane] = bf2f(p.Q[(size_t)qi * p.qpitch + lane]);
        const int nk = p.P + (p.Kn ? qi + 1 : 0);
        float mx = -INFINITY;
        for (int j = lane; j < nk; j += 64) {
            float dot = 0.f;
            if (j < p.P) { const f32x4* kr = (const f32x4*)(p.Kc + (size_t)j * p.kpitch);
#pragma unroll
                for (int d = 0; d < 16; ++d) { const f32x4 kv = kr[d]; const f32x4 qv = *(const LAS f32x4*)(QS + 4 * d); dot += kv.x * qv.x + kv.y * qv.y + kv.z * qv.z + kv.w * qv.w; } }
            else { const bf16* kr = p.Kn + (size_t)(j - p.P) * p.npitch;
                for (int d = 0; d < 64; ++d) dot += bf2f(kr[d]) * QS[d]; }
            const float s = dot + (p.nck ? p.nck[j] : 0.f);
            SS[j] = s; mx = fmaxf(mx, s);
        }
        mx = wave_max(mx);
        float sum = 0.f;
        for (int j = lane; j < nk; j += 64) { const float e = __builtin_amdgcn_exp2f(SS[j] - mx); SS[j] = e; sum += e; }
        sum = wave_sum(sum);
        float acc = 0.f;
        for (int j = 0; j < nk; ++j) { const float v = (j < p.P) ? p.Vc[(size_t)j * p.vpitch + lane] : bf2f(p.Vn[(size_t)(j - p.P) * p.npitch + lane]); acc += SS[j] * v; }
        const float g = bf2f(p.Gt[(size_t)qi * p.gpitch + lane]);
        p.O[(size_t)qi * p.opitch + lane] = (bf16)f2bf(acc / sum * siluf(g));
    }
}

constexpr int RW_R = 0, RW_W = 16384, RW_KT = 32768, RW_V = 49152, RW_KK = 65536, RW_KA = 81920, RW_G = 98304, RW_X = 114688;
struct RwkvP { const bf16* Hs; bf16* Os; int T; int h; const float* s0; const float* prev0; float* s_out; float* sh_out; };
__device__ __forceinline__ void rwkv_task(LAS unsigned char* lds, const Args& a, const RwkvP& p, int tid) {
    LAS float* AR = (LAS float*)(lds + RW_R); LAS float* AW = (LAS float*)(lds + RW_W); LAS float* AKT = (LAS float*)(lds + RW_KT); LAS float* AV = (LAS float*)(lds + RW_V);
    LAS float* AKK = (LAS float*)(lds + RW_KK); LAS float* AKA = (LAS float*)(lds + RW_KA); LAS float* AG = (LAS float*)(lds + RW_G); LAS float* AX = (LAS float*)(lds + RW_X);
    const int tt = tid >> 3, e8 = (tid & 7) * 8, h = p.h;
    const float* mu = a.in[I_MU];
    float S[8];
    if (p.s0) {
#pragma unroll
        for (int e = 0; e < 8; ++e) S[e] = p.s0[tt * 64 + e8 + e];
    } else {
#pragma unroll
        for (int e = 0; e < 8; ++e) S[e] = 0.f;
    }
    for (int c0 = 0; c0 < p.T; c0 += 64) {
        const int n = (p.T - c0) < 64 ? (p.T - c0) : 64;
        const bool act = tt < n; const int trow = c0 + tt;
        const bf16* cur = p.Hs + (size_t)trow * NP; const bf16* prv = cur - NP; const bool first = (trow == 0);
        if (act && (RWM & 1)) {
#pragma unroll
            for (int e = 0; e < 8; ++e) { const int col = e8 + e; const float c = bf2f(cur[HC_WD + col]);
                const float pv = first ? (p.prev0 ? p.prev0[1152 + col] : 0.f) : bf2f(prv[HC_WD + col]);
                const float xs = c + (pv - c) * mu[1152 + col];
                AX[tt * 64 + col] = (col < 32) ? tanhf(xs) : xs; }
        }
        __syncthreads();
        if (act && (RWM & 2)) {
            float lw[8], la[8];
            { const f32x4 w0a = *(const f32x4*)(a.in[I_W0] + h * 64 + e8), w0b = *(const f32x4*)(a.in[I_W0] + h * 64 + e8 + 4);
              const f32x4 a0a = *(const f32x4*)(a.in[I_A0] + h * 64 + e8), a0b = *(const f32x4*)(a.in[I_A0] + h * 64 + e8 + 4);
              lw[0] = w0a.x; lw[1] = w0a.y; lw[2] = w0a.z; lw[3] = w0a.w; lw[4] = w0b.x; lw[5] = w0b.y; lw[6] = w0b.z; lw[7] = w0b.w;
              la[0] = a0a.x; la[1] = a0a.y; la[2] = a0a.z; la[3] = a0a.w; la[4] = a0b.x; la[5] = a0b.y; la[6] = a0b.z; la[7] = a0b.w; }
#pragma unroll 2
            for (int j = 0; j < 32; ++j) {
                const float tw = AX[tt * 64 + j], ta = AX[tt * 64 + 32 + j];
                const f32x4 u0 = *(const f32x4*)(a.in[I_WUP] + j * 384 + h * 64 + e8), u1 = *(const f32x4*)(a.in[I_WUP] + j * 384 + h * 64 + e8 + 4);
                const f32x4 p0 = *(const f32x4*)(a.in[I_AUP] + j * 384 + h * 64 + e8), p1 = *(const f32x4*)(a.in[I_AUP] + j * 384 + h * 64 + e8 + 4);
                lw[0] += tw * u0.x; lw[1] += tw * u0.y; lw[2] += tw * u0.z; lw[3] += tw * u0.w; lw[4] += tw * u1.x; lw[5] += tw * u1.y; lw[6] += tw * u1.z; lw[7] += tw * u1.w;
                la[0] += ta * p0.x; la[1] += ta * p0.y; la[2] += ta * p0.z; la[3] += ta * p0.w; la[4] += ta * p1.x; la[5] += ta * p1.y; la[6] += ta * p1.z; la[7] += ta * p1.w;
            }
            float kk[8], aa[8]; float ss = 0.f;
            const int c8 = h * 64 + e8;
            float rs[8], ks[8], vs[8], gs[8];
            { float cu[8], pv[8], mm[8];
#define RW_SHIFT(dst, HC, MUOFF) do { unpack8(*(const v4u*)(cur + (HC) + c8), cu); \
                if (first) { if (p.prev0) ld8(p.prev0 + (MUOFF) + c8, pv); else { _Pragma("unroll") for (int e = 0; e < 8; ++e) pv[e] = 0.f; } } \
                else unpack8(*(const v4u*)(prv + (HC) + c8), pv); \
                ld8(mu + (MUOFF) + c8, mm); \
                _Pragma("unroll") for (int e = 0; e < 8; ++e) dst[e] = cu[e] + (pv[e] - cu[e]) * mm[e]; } while (0)
              RW_SHIFT(rs, HC_RR, 0); RW_SHIFT(ks, HC_RK, 384); RW_SHIFT(vs, HC_RV, 768); RW_SHIFT(gs, HC_RG, 1216);
#undef RW_SHIFT
            }
            float kkw[8], kaw[8];
            ld8(a.in[I_KK] + c8, kkw); ld8(a.in[I_KA] + c8, kaw);
#pragma unroll
            for (int e = 0; e < 8; ++e) { const int d = e8 + e;
                const float wraw = -softplusf(-lw[e]) - 0.5f; const float dec = __expf(-__expf(wraw));
                const float av = 1.f / (1.f + __expf(-la[e]));
                kk[e] = ks[e] * kkw[e]; ss += kk[e] * kk[e]; aa[e] = av;
                AR[tt * 64 + d] = rs[e]; AW[tt * 64 + d] = dec; AKT[tt * 64 + d] = ks[e] * (1.f + (av - 1.f) * kaw[e]); AV[tt * 64 + d] = vs[e]; AG[tt * 64 + d] = gs[e];
            }
            ss = sum8(ss); const float rn = 1.0f / sqrtf(fmaxf(ss, 1e-24f));
#pragma unroll
            for (int e = 0; e < 8; ++e) { const float k2 = kk[e] * rn; AKK[tt * 64 + e8 + e] = k2; AKA[tt * 64 + e8 + e] = k2 * aa[e]; }
        }
        __syncthreads();
        if (RWM & 4) for (int t = 0; t < n; ++t) {
            const f32x4 k0 = *(const LAS f32x4*)(AKK + t * 64 + e8), k1 = *(const LAS f32x4*)(AKK + t * 64 + e8 + 4);
            const f32x4 w0 = *(const LAS f32x4*)(AW + t * 64 + e8), w1 = *(const LAS f32x4*)(AW + t * 64 + e8 + 4);
            const f32x4 b0 = *(const LAS f32x4*)(AKA + t * 64 + e8), b1 = *(const LAS f32x4*)(AKA + t * 64 + e8 + 4);
            const f32x4 x0 = *(const LAS f32x4*)(AKT + t * 64 + e8), x1 = *(const LAS f32x4*)(AKT + t * 64 + e8 + 4);
            const f32x4 r0 = *(const LAS f32x4*)(AR + t * 64 + e8), r1 = *(const LAS f32x4*)(AR + t * 64 + e8 + 4);
            const float vv = AV[t * 64 + tt];
            float sa = S[0] * k0.x + S[1] * k0.y + S[2] * k0.z + S[3] * k0.w + S[4] * k1.x + S[5] * k1.y + S[6] * k1.z + S[7] * k1.w;
            sa = -sum8(sa);
            S[0] = S[0] * w0.x + sa * b0.x + vv * x0.x; S[1] = S[1] * w0.y + sa * b0.y + vv * x0.y; S[2] = S[2] * w0.z + sa * b0.z + vv * x0.z; S[3] = S[3] * w0.w + sa * b0.w + vv * x0.w;
            S[4] = S[4] * w1.x + sa * b1.x + vv * x1.x; S[5] = S[5] * w1.y + sa * b1.y + vv * x1.y; S[6] = S[6] * w1.z + sa * b1.z + vv * x1.z; S[7] = S[7] * w1.w + sa * b1.w + vv * x1.w;
            float y = S[0] * r0.x + S[1] * r0.y + S[2] * r0.z + S[3] * r0.w + S[4] * r1.x + S[5] * r1.y + S[6] * r1.z + S[7] * r1.w;
            y = sum8(y);
            if ((tid & 7) == 0) AX[t * 64 + tt] = y;
        }
        __syncthreads();
        if (RWM & 8) {
            float y[8], sm = 0.f, bn = 0.f;
#pragma unroll
            for (int e = 0; e < 8; ++e) { y[e] = AX[tt * 64 + e8 + e]; sm += y[e]; bn += AR[tt * 64 + e8 + e] * AKT[tt * 64 + e8 + e] * a.in[I_RK][h * 64 + e8 + e]; }
            sm = sum8(sm) * (1.f / 64.f); bn = sum8(bn);
            float var = 0.f;
#pragma unroll
            for (int e = 0; e < 8; ++e) { const float d = y[e] - sm; var += d * d; }
            var = sum8(var) * (1.f / 64.f);
            const float rstd = 1.0f / sqrtf(var + GN_EPS);
            if (act) {
                v4u o; unsigned w[4];
#pragma unroll
                for (int e = 0; e < 8; e += 2) { const int c = h * 64 + e8 + e;
                    const float o0 = ((y[e] - sm) * rstd * a.in[I_GNW][c] + a.in[I_GNB][c] + bn * AV[tt * 64 + e8 + e]) * siluf(AG[tt * 64 + e8 + e]);
                    const float o1 = ((y[e + 1] - sm) * rstd * a.in[I_GNW][c + 1] + a.in[I_GNB][c + 1] + bn * AV[tt * 64 + e8 + e + 1]) * siluf(AG[tt * 64 + e8 + e + 1]);
                    w[e >> 1] = pk2(o0, o1); }
                o.x = w[0]; o.y = w[1]; o.z = w[2]; o.w = w[3];
                *(v4u*)(p.Os + (size_t)trow * DM + 384 + h * 64 + e8) = o;
            }
        }
        __syncthreads();
    }
#pragma unroll
    for (int e = 0; e < 8; ++e) p.s_out[tt * 64 + e8 + e] = S[e];
    if (p.sh_out) { const bf16* last = p.Hs + (size_t)(p.T - 1) * NP;
        for (int m = tid; m < 1600; m += 512) { const int c = (m < 1152) ? HC_RR + m : (m < 1184) ? HC_WD + (m - 1152) : (m < 1216) ? HC_AD + (m - 1184) : HC_RG + (m - 1216);
            p.sh_out[m] = bf2f(last[c]); } }
}

#ifndef RWM
#define RWM 15
#endif
#ifndef TKMASK
#define TKMASK 7
#endif
constexpr int NQ_RW = 48 + 192, NQ_AT = 768 + 512, NQ_SM = 192 + 128;
__device__ __forceinline__ int q_next(const Ctx& F, int qi) {
    __syncthreads();
    if (F.tid == 0) F.MISC[0] = __hip_atomic_fetch_add(F.ctl + CW_Q + 64 * qi, 1u, __ATOMIC_RELAXED, __HIP_MEMORY_SCOPE_AGENT);
    __syncthreads();
    return (int)F.MISC[0];
}
__device__ __forceinline__ void p4_mixer(const Ctx& F, const Args& a) {
    bf16* H = (bf16*)(a.ws + WS_H); bf16* Ob = (bf16*)(a.ws + WS_XN); bf16* MKV = (bf16*)(a.ws + WS_MKV);
    const float* NCKP = (const float*)(a.ws + WS_NCKP); const float* NCKS = (const float*)(a.ws + WS_NCKS);
    LAS unsigned char* lds = F.lds + RING_OFF;
    if (TKMASK & 1) for (;;) {
        const int tk = q_next(F, 0); if (tk >= NQ_RW) break;
        RwkvP p;
        if (tk < 48) { const int b = tk / 6, h = tk % 6;
            p = RwkvP{H + (size_t)b * SEQ * NP, Ob + (size_t)b * SEQ * DM, SEQ, h, nullptr, nullptr, a.out + O_RSP + (size_t)tk * 4096, (h == 0) ? a.out + O_RHP + (size_t)b * 1600 : nullptr};
        } else { const int u = tk - 48, b = u / 6, h = u % 6;
            p = RwkvP{H + (size_t)(MP + b * DECS) * NP, Ob + (size_t)(MP + b * DECS) * DM, DECS, h, a.in[I_SRW] + (size_t)u * 4096, a.in[I_SSH] + (size_t)b * 1600,
                      a.out + O_RSS + (size_t)u * 4096, (h == 0) ? a.out + O_RHS + (size_t)b * 1600 : nullptr}; }
        rwkv_task(lds, a, p, F.tid);
    }
    if (TKMASK & 2) for (;;) {
        const int tk = q_next(F, 1); if (tk >= NQ_AT) break;
        AttnP p;
        if (tk < 768) { const int u = tk, qb = 15 - u / 48, bh = u % 48, b = bh / 6, h = bh % 6; const size_t r0 = (size_t)b * SEQ + qb * 256;
            p = AttnP{H + r0 * NP + HC_FQ + h * 64, NP, H + (size_t)b * SEQ * NP + HC_FK + h * 64, NP, H + (size_t)b * SEQ * NP + HC_FV + h * 64, NP, NCKP + (size_t)bh * SEQ,
                      H + r0 * NP + HC_FG + h * 64, NP, Ob + r0 * DM + h * 64, DM, 4 * (qb + 1), qb * 256, 1};
        } else { const int u = tk - 768, b = u / 64, h = (u / 16) % 4, qb = u % 16; const size_t r0 = (size_t)b * SEQ + qb * 256;
            p = AttnP{H + r0 * NP + HC_MQ + h * 64, NP, MKV + (size_t)b * NMEM * 512 + h * 64, 512, MKV + (size_t)b * NMEM * 512 + 256 + h * 64, 512, nullptr,
                      H + r0 * NP + HC_MG + h * 64, NP, Ob + r0 * DM + 768 + h * 64, DM, 4, 0, 0}; }
#if DBG_MEMREF
        if (tk >= 768) ref_attn_unit(lds, p, F.lane, F.wave); else
#endif
        attn_unit(lds, p, F.tid, F.lane, F.wave);
    }
    if (TKMASK & 4) for (;;) {
        const int tk = q_next(F, 2); if (tk >= NQ_SM) break;
        SmallP p;
        if (tk < 192) { const int u = tk, b = u / 6, h = u % 6; const size_t r0 = (size_t)MP + b * DECS;
            p = SmallP{H + r0 * NP + HC_FQ + h * 64, NP, a.in[I_CFK] + ((size_t)b * PAST * 6 + h) * 64, 384, a.in[I_CFV] + ((size_t)b * PAST * 6 + h) * 64, 384, PAST, NCKS + (size_t)u * 1040,
                       H + r0 * NP + HC_FK + h * 64, H + r0 * NP + HC_FV + h * 64, NP, H + r0 * NP + HC_FG + h * 64, NP, Ob + r0 * DM + h * 64, DM};
        } else { const int u = tk - 192, b = u / 4, h = u % 4; const size_t r0 = (size_t)MP + b * DECS;
            p = SmallP{H + r0 * NP + HC_MQ + h * 64, NP, a.in[I_CMK] + ((size_t)b * NMEM * 4 + h) * 64, 256, a.in[I_CMV] + ((size_t)b * NMEM * 4 + h) * 64, 256, NMEM, nullptr,
                       nullptr, nullptr, NP, H + r0 * NP + HC_MG + h * 64, NP, Ob + r0 * DM + 768 + h * 64, DM}; }
        small_attn(lds, p, F.lane, F.wave);
    }
}

#ifndef DBG_BRMASK
#define DBG_BRMASK 7
#endif
#ifndef DBG_YSCALE
#define DBG_YSCALE 1.0f
#endif
struct EpiRes {
    static constexpr bool PERM = true, AFTER_DRAIN = false;
    const float* xp; const float* xs; float* yp; float* ys;
    __device__ __forceinline__ void operator()(const pg8::f32x4 (&acc)[2][2][4][2], const pg8::Unit& u, int wr, int wc, int fr, int fq) const {
        const int row0 = u.pm * 256 + wr * 64 + fr, col0 = u.pn * 256 + wc * 32 + 8 * fq;
        const bool samp = u.pm >= (MP / 256);
        const float* xb = samp ? xs - (size_t)MP * DM : xp; float* yb = samp ? ys - (size_t)MP * DM : yp;
#pragma unroll
        for (int ai = 0; ai < 2; ++ai)
#pragma unroll
            for (int m = 0; m < 4; ++m) { const size_t ro = (size_t)(row0 + ai * 128 + m * 16) * DM + col0;
#pragma unroll
                for (int bj = 0; bj < 2; ++bj) {
                    const pg8::f32x4 x0 = *(const pg8::f32x4*)(xb + ro + bj * 128), x1 = *(const pg8::f32x4*)(xb + ro + bj * 128 + 4);
                    *(pg8::f32x4*)(yb + ro + bj * 128) = acc[ai][bj][m][0] * DBG_YSCALE + x0; *(pg8::f32x4*)(yb + ro + bj * 128 + 4) = acc[ai][bj][m][1] * DBG_YSCALE + x1; } }
    }
};

__global__ void __launch_bounds__(NWAVES * 64, 2) fwd_kernel(Args args) {
    extern __shared__ __attribute__((aligned(16))) unsigned char lds[];
    Ctx F;
    F.lds = (LAS unsigned char*)lds;
    F.MISC = (volatile LAS unsigned*)(F.lds + MISC_OFF);
    F.tid = threadIdx.x; F.lane = F.tid & 63; F.wave = __builtin_amdgcn_readfirstlane(F.tid >> 6);
    F.G = gridDim.x; { const int bx = blockIdx.x; F.vcu = (F.G % 8 == 0) ? (bx % 8) * (F.G / 8) + bx / 8 : bx; }
    F.ctl = (gu32*)(args.ws + WS_CTL);
    for (int u = F.tid; u < (LDS_BYTES - LDSCTL_OFF) / 4; u += NWAVES * 64) ((LAS unsigned*)(F.lds + LDSCTL_OFF))[u] = 0u;
    __syncthreads();
    XcdBarrier bar; bar.bar = (unsigned*)(F.ctl + CW_BAR); bar.x = 0; bar.st = nullptr;
#if MK_ONE_LAUNCH
    bar = xcd_barrier_post((unsigned*)(F.ctl + CW_BAR), F.MISC + 8);
#define GRID_BAR() xcd_barrier(bar)
#else
#define GRID_BAR() do {} while (0)
#endif
    const int lo = args.ph_lo, hi = args.ph_hi;
#ifndef PHMASK
#define PHMASK 127
#endif
#define IN(k) (((PHMASK >> (k)) & 1) && lo <= (k) && (k) < hi)
#define BOTH(k) (IN(k) && IN((k) + 1))
    bf16* H = (bf16*)(args.ws + WS_H);
    if (IN(0)) { p0_prologue(F, args); if (BOTH(0)) GRID_BAR(); }
    if (IN(1)) {
        { pg8::Gemm g{(const bf16*)(args.ws + WS_XN), (const bf16*)(args.ws + WS_WIN), MT, NP, DM}; pg8::StaticOrder S; S.init(MT, NP, F.G, (int)blockIdx.x);
          pg8::EpiBf16<0> E{H, NP, nullptr, 0, 0, 1.f};
          pg8::gemm_phase<pg8::EpiBf16<0>, pg8::StaticOrder, PG8_ALIGN, PG8_SP2>(F.lds + RING_OFF, g, S, E); }
        { pg8::Gemm g{(const bf16*)(args.ws + WS_MEMN), (const bf16*)(args.ws + WS_WMEM), BATCH * NMEM, 512, DM}; pg8::StaticOrder S; S.init(BATCH * NMEM, 512, F.G, (int)blockIdx.x);
          pg8::EpiBf16<0> E{(bf16*)(args.ws + WS_MKV), 512, nullptr, 0, 0, 1.f};
          pg8::gemm_phase<pg8::EpiBf16<0>, pg8::StaticOrder, PG8_ALIGN, PG8_SP2>(F.lds + RING_OFF, g, S, E); }
        if (BOTH(1)) GRID_BAR();
    }
    if (IN(2)) { p2_prep(F, args); if (BOTH(2)) GRID_BAR(); }
    if (IN(3)) { p3_nck(F, args); if (BOTH(3)) GRID_BAR(); }
    if (IN(4)) { p4_mixer(F, args); if (BOTH(4)) GRID_BAR(); }
#if DBG_BRMASK != 7
    if (IN(6)) {
        bf16* Ob = (bf16*)(args.ws + WS_XN); const int gw = F.vcu * NWAVES + F.wave, NGW = F.G * NWAVES;
        for (int m = gw; m < MT; m += NGW) { bf16* r = Ob + (size_t)m * DM;
            for (int c = F.lane; c < DM; c += 64) { const int br = c < 384 ? 0 : (c < 768 ? 1 : 2); if (!((DBG_BRMASK >> br) & 1)) r[c] = 0; } }
    }
#endif
    if (IN(5)) {
        pg8::Gemm g{(const bf16*)(args.ws + WS_XN), (const bf16*)(args.ws + WS_WOUT), MT, DM, DM}; pg8::StaticOrder S; S.init(MT, DM, F.G, (int)blockIdx.x);
        EpiRes E{args.in[I_XP], args.in[I_XS], args.out + O_YP, args.out + O_YS};
        pg8::gemm_phase<EpiRes, pg8::StaticOrder, PG8_ALIGN, PG8_SP2>(F.lds + RING_OFF, g, S, E);
    }
#undef IN
#undef BOTH
}

extern "C" void kernel_launch(void* const* d_in, const int* in_sizes, int n_in, void* d_out, int out_size, void* d_ws, size_t ws_size, hipStream_t stream) {
    static int grid = 0;
    if (grid == 0) {
        if (n_in != 30 || out_size != (int)O_END || ws_size < WS_END) { fprintf(stderr, "kernel_launch: unexpected shapes (n_in %d out %d ws %zu)\n", n_in, out_size, ws_size); grid = -1; return; }
        int dev = 0, cus = 0;
        if (hipGetDevice(&dev) != hipSuccess || hipDeviceGetAttribute(&cus, hipDeviceAttributeMultiprocessorCount, dev) != hipSuccess) { grid = -1; return; }
        if (hipFuncSetAttribute((const void*)fwd_kernel, hipFuncAttributeMaxDynamicSharedMemorySize, LDS_BYTES) != hipSuccess) { fprintf(stderr, "kernel_launch: hipFuncSetAttribute failed\n"); grid = -1; return; }
        (void)hipGetLastError();
        grid = cus;
    }
    if (grid < 0) return;
    (void)hipMemsetAsync((char*)d_ws + WS_CTL, 0, CTL_ZERO_BYTES, stream);
    Args a{};
    for (int i = 0; i < 30; ++i) a.in[i] = (const float*)d_in[i];
    a.out = (float*)d_out; a.ws = (unsigned char*)d_ws;
#if MK_ONE_LAUNCH
    a.ph_lo = 0; a.ph_hi = N_PHASES; a.li = 0;
    hipLaunchKernelGGL(fwd_kernel, dim3(grid), dim3(NWAVES * 64), LDS_BYTES, stream, a);
#else
    for (int li = 0; li < N_PHASES; ++li) { a.ph_lo = li; a.ph_hi = li + 1; a.li = li;
#if DBG_BRMASK != 7
        if (li == 5) { a.ph_lo = 6; a.ph_hi = 7; hipLaunchKernelGGL(fwd_kernel, dim3(grid), dim3(NWAVES * 64), LDS_BYTES, stream, a); a.ph_lo = 5; a.ph_hi = 6; }
#endif
        hipLaunchKernelGGL(fwd_kernel, dim3(grid), dim3(NWAVES * 64), LDS_BYTES, stream, a); }
#endif
}
```

```cpp
#include <hip/hip_runtime.h>
#include <cstdio>
#include <cstdint>
#include <cmath>

#define PROBE_PAD 0
namespace pg8 {
#define PG8_LAS __attribute__((address_space(3)))
typedef unsigned short bf16_t;
typedef short bf16x8 __attribute__((ext_vector_type(8)));
typedef float f32x4 __attribute__((ext_vector_type(4)));
typedef unsigned u32x4 __attribute__((ext_vector_type(4)));
constexpr int BM = 256, BK = 64, HALF = 128, HTB = HALF * BK * 2  , STAGE_BYTES = 8 * HTB, NXCD = 8, WGM = 8;

__host__ __device__ __forceinline__ int lds_byte(int r, int c) { const int st = (r >> 4) * 2 + (c >> 5), rr = r & 15, cc = c & 31, ob = rr * 64 + cc * 2; return st * 1024 + (ob ^ (((ob >> 9) & 1) << 5)); }
__host__ __device__ __forceinline__ void stage_rc(int b, int& R, int& C) { const int st = b / 1024, sb = b % 1024, swz = sb ^ (((sb >> 9) & 1) << 5); R = (st >> 1) * 16 + swz / 64; C = (st & 1) * 32 + (swz % 64) / 2; }
__host__ __device__ __forceinline__ int perm32(int rho) { const int n = rho >> 4, i = rho & 15; return 8 * (i >> 2) + 4 * n + (i & 3); }

struct Unit { int pm, pn; };
struct Gemm { const bf16_t* A; const bf16_t* Bt; int M, N, K; };

struct StaticOrder {
    int nM, nN, nwg, G, c;
    __host__ __device__ void init(int M, int N, int G_, int c_) { nM = M / BM; nN = N / BM; nwg = nM * nN; G = G_; c = c_; }
    __host__ __device__ bool next(int i, Unit& u) const {
        const long L = (long)i * G + c; if (L >= nwg) return false;
        int wgid = (int)L; { const int q = nwg / NXCD, r = nwg % NXCD, xcd = wgid % NXCD, off = wgid / NXCD; wgid = (xcd < r ? xcd * (q + 1) : r * (q + 1) + (xcd - r) * q) + off; }
        const int nig = WGM * nN, gid = wgid / nig, fm = gid * WGM, gsz = (nM - fm) < WGM ? (nM - fm) : WGM;
        u.pm = fm + ((wgid % nig) % gsz); u.pn = (wgid % nig) / gsz; return true;
    }
    __device__ __forceinline__ void a_ready(const Unit&) const {}
    __device__ __forceinline__ void done(const Unit&) const {}
};

__device__ __forceinline__ unsigned cvt_pk_bf16(float lo, float hi) { unsigned r; asm volatile("v_cvt_pk_bf16_f32 %0, %1, %2" : "=v"(r) : "v"(lo), "v"(hi)); return r; }
typedef float f32x2 __attribute__((ext_vector_type(2)));
__device__ __forceinline__ f32x2 gelu_pk(f32x2 v) {
    const f32x2 av = __builtin_elementwise_abs(v), d = av * 0.2316418882f + 1.0f;
    f32x2 t; t.x = __builtin_amdgcn_rcpf(d.x); t.y = __builtin_amdgcn_rcpf(d.y);
    f32x2 q = t * 0.5307027145f + (-0.7265760135f); q = q * t + 0.7107068705f; q = q * t + (-0.142248368f); q = q * t + 0.127414796f; q = q * t;
    const f32x2 s = (v * v) * (-0.72134752044f);
    f32x2 e; e.x = __builtin_amdgcn_exp2f(s.x); e.y = __builtin_amdgcn_exp2f(s.y);
    const f32x2 m = v * (q * e), r = v - m;
    f32x2 o; o.x = v.x < 0.f ? m.x : r.x; o.y = v.y < 0.f ? m.y : r.y; return o;
}

template <int ACT  > struct EpiBf16 {
    static constexpr bool PERM = true, AFTER_DRAIN = false; static_assert(ACT == 0 || ACT == 1, "EpiBf16: ACT is 0 (none) or 1 (gelu_pk)");
    bf16_t* O; int ldc; const float* bias; int split_cols; size_t split_stride; float scale0;
    __device__ __forceinline__ void operator()(const f32x4 (&acc)[2][2][4][2], const Unit& u, int wr, int wc, int fr, int fq) const {
        const int row0 = u.pm * BM + wr * 64 + fr; int colt = u.pn * BM; bf16_t* base = O;
        float sc = 1.f; if (split_cols) { const int t = colt / split_cols; base += (size_t)t * split_stride; colt -= t * split_cols; if (t == 0) sc = scale0; }
        const int col0 = colt + wc * 32 + 8 * fq, bcol0 = u.pn * BM + wc * 32 + 8 * fq;
        f32x4 bv[2][2];
#pragma unroll
        for (int bj = 0; bj < 2; ++bj)
#pragma unroll
            for (int n = 0; n < 2; ++n) bv[bj][n] = bias ? *(const f32x4*)(bias + bcol0 + bj * HALF + 4 * n) : (f32x4){0.f, 0.f, 0.f, 0.f};
#pragma unroll
        for (int ai = 0; ai < 2; ++ai)
#pragma unroll
            for (int m = 0; m < 4; ++m) { bf16_t* rowp = base + (size_t)(row0 + ai * HALF + m * 16) * ldc + col0;
#pragma unroll
                for (int bj = 0; bj < 2; ++bj) { f32x4 v0 = acc[ai][bj][m][0] + bv[bj][0], v1 = acc[ai][bj][m][1] + bv[bj][1];
                    if (ACT == 1) { f32x2 a = gelu_pk((f32x2){v0[0], v0[1]}), b = gelu_pk((f32x2){v0[2], v0[3]}), c = gelu_pk((f32x2){v1[0], v1[1]}), d = gelu_pk((f32x2){v1[2], v1[3]});
                        v0 = (f32x4){a.x, a.y, b.x, b.y}; v1 = (f32x4){c.x, c.y, d.x, d.y}; }
                    v0 = v0 * sc; v1 = v1 * sc; u32x4 w; w.x = cvt_pk_bf16(v0[0], v0[1]); w.y = cvt_pk_bf16(v0[2], v0[3]); w.z = cvt_pk_bf16(v1[0], v1[1]); w.w = cvt_pk_bf16(v1[2], v1[3]);
                    *(u32x4*)(rowp + bj * HALF) = w; } }
    }
};


template <class Epi, class Sched, bool ALIGN_EPI = false, bool SP2 = false>
__device__ __forceinline__ void gemm_phase(PG8_LAS unsigned char* lds, const Gemm g, const Sched& S, const Epi& E) {
    const int tid = threadIdx.x, wid = __builtin_amdgcn_readfirstlane(tid >> 6), lane = tid & 63, wr = wid >> 2, wc = wid & 3, fr = lane & 15, fq = lane >> 4;
    const int K = g.K, nt = K / BK;
    unsigned voffA[2], voffB[2];
#pragma unroll
    for (int i = 0; i < 2; ++i) { int R, C; stage_rc(tid * 16 + i * 8192, R, C); const int Rb = Epi::PERM ? ((R & ~31) + perm32(R & 31)) : R;
        voffA[i] = (unsigned)(R * K + C) * 2u; voffB[i] = (unsigned)(Rb * K + C) * 2u; }
    const size_t kstep = (size_t)(BK * 2);
    const size_t hstep = (size_t)HALF * K * 2;
    const size_t tstep = 2 * hstep;
    const unsigned ldsw = (unsigned)wid * 1024u;
    const int aoff = lds_byte(wr * 64 + fr, fq * 8), boff = lds_byte(wc * 32 + fr, fq * 8);
#define PG8_SA(b, h) (((b) * 2 + (h)) * HTB)
#define PG8_SB(b, h) ((4 + (b) * 2 + (h)) * HTB)
#define PG8_STAGE(bufoff, gbase, voff) do { _Pragma("unroll") for (int _i = 0; _i < 2; ++_i) \
        __builtin_amdgcn_global_load_lds((const unsigned*)((const char*)(gbase) + (voff)[_i]), (PG8_LAS unsigned*)(lds + (bufoff) + ldsw + _i * 8192), 16, 0, 0); } while (0)
#define PG8_LDA(dst, b, h) do { _Pragma("unroll") for (int m = 0; m < 4; ++m) _Pragma("unroll") for (int k = 0; k < 2; ++k) dst[m][k] = *(const PG8_LAS bf16x8*)(lds + PG8_SA(b, h) + aoff + m * 2048 + k * 1024); } while (0)
#define PG8_LDB(dst, b, h) do { _Pragma("unroll") for (int n = 0; n < 2; ++n) _Pragma("unroll") for (int k = 0; k < 2; ++k) dst[n][k] = *(const PG8_LAS bf16x8*)(lds + PG8_SB(b, h) + boff + n * 2048 + k * 1024); } while (0)
#define PG8_MMA(ai, bj, At, Bt) do { __builtin_amdgcn_s_setprio(1); _Pragma("unroll") for (int m = 0; m < 4; ++m) _Pragma("unroll") for (int n = 0; n < 2; ++n) _Pragma("unroll") for (int k = 0; k < 2; ++k) \
        acc[ai][bj][m][n] = __builtin_amdgcn_mfma_f32_16x16x32_bf16(Bt[n][k], At[m][k], acc[ai][bj][m][n], 0, 0, 0); __builtin_amdgcn_s_setprio(0); } while (0)
#define PG8_WAIT_V(n) asm volatile("s_waitcnt vmcnt(" #n ")" ::: "memory")
#define PG8_WAIT_L(n) asm volatile("s_waitcnt lgkmcnt(" #n ")" ::: "memory")
#define PG8_BAR __builtin_amdgcn_s_barrier()
#define PG8_SCHED __builtin_amdgcn_sched_barrier(0)
    Unit cur, nxt; int ui = 0;
    if (!S.next(0, cur)) return;
    f32x4 acc[2][2][4][2];
#pragma unroll
    for (int a = 0; a < 2; ++a)
#pragma unroll
        for (int b = 0; b < 2; ++b)
#pragma unroll
            for (int m = 0; m < 4; ++m)
#pragma unroll
                for (int n = 0; n < 2; ++n) acc[a][b][m][n] = (f32x4){0.f, 0.f, 0.f, 0.f};
    bf16x8 At[4][2], B0[2][2], B1[2][2];
    const char* cA = (const char*)g.A + (size_t)cur.pm * tstep; const char* cB = (const char*)g.Bt + (size_t)cur.pn * tstep;
    S.a_ready(cur);
    if constexpr (SP2) {
        PG8_STAGE(PG8_SB(0, 0), cB, voffB); PG8_STAGE(PG8_SB(0, 1), cB + hstep, voffB); PG8_STAGE(PG8_SA(0, 0), cA, voffA); PG8_STAGE(PG8_SA(0, 1), cA + hstep, voffA);
        if (wr == 1) PG8_BAR;
        PG8_WAIT_V(2); PG8_BAR;
        PG8_STAGE(PG8_SB(1, 0), cB + kstep, voffB); PG8_STAGE(PG8_SA(1, 0), cA + kstep, voffA); PG8_STAGE(PG8_SB(1, 1), cB + hstep + kstep, voffB);
        PG8_WAIT_V(6); PG8_BAR;
    } else {
        PG8_STAGE(PG8_SB(0, 0), cB, voffB); PG8_STAGE(PG8_SA(0, 0), cA, voffA); PG8_STAGE(PG8_SB(0, 1), cB + hstep, voffB); PG8_STAGE(PG8_SA(0, 1), cA + hstep, voffA);
        if (wr == 1) PG8_BAR;
        PG8_WAIT_V(4); PG8_BAR;
        PG8_STAGE(PG8_SB(1, 0), cB + kstep, voffB); PG8_STAGE(PG8_SA(1, 0), cA + kstep, voffA); PG8_STAGE(PG8_SB(1, 1), cB + hstep + kstep, voffB);
        PG8_WAIT_V(6); PG8_BAR;
    }
    for (;;) {
        const bool has_next = S.next(ui + 1, nxt);
        const char* nA = has_next ? (const char*)g.A + (size_t)nxt.pm * tstep : cA; const char* nB = has_next ? (const char*)g.Bt + (size_t)nxt.pn * tstep : cB;
        for (int t = 0; t < nt; t += 2) {
            const bool last = (t == nt - 2);
            const char* a1 = cA + (size_t)(t + 1) * kstep;
            const char* a2 = last ? nA : cA + (size_t)(t + 2) * kstep; const char* b2 = last ? nB : cB + (size_t)(t + 2) * kstep;
            const char* a3 = a2 + kstep; const char* b3 = b2 + kstep;
            if (last && has_next) S.a_ready(nxt);
            if constexpr (SP2) {
            PG8_LDB(B0, 0, 0); PG8_LDB(B1, 0, 1); PG8_SCHED; PG8_LDA(At, 0, 0); PG8_STAGE(PG8_SA(1, 1), a1 + hstep, voffA);
            PG8_WAIT_V(8); PG8_WAIT_L(0); PG8_BAR; PG8_MMA(0, 0, At, B0); PG8_MMA(0, 1, At, B1); PG8_BAR; PG8_SCHED;
            PG8_LDA(At, 0, 1); PG8_STAGE(PG8_SB(0, 0), b2, voffB); PG8_STAGE(PG8_SB(0, 1), b2 + hstep, voffB); PG8_STAGE(PG8_SA(0, 0), a2, voffA);
            PG8_WAIT_V(8); PG8_WAIT_L(0); PG8_BAR; PG8_MMA(1, 0, At, B0); PG8_MMA(1, 1, At, B1); PG8_BAR; PG8_SCHED;
            PG8_LDB(B0, 1, 0); PG8_LDB(B1, 1, 1); PG8_SCHED; PG8_LDA(At, 1, 0); PG8_STAGE(PG8_SA(0, 1), a2 + hstep, voffA);
            PG8_WAIT_V(8); PG8_WAIT_L(0); PG8_BAR; PG8_MMA(0, 0, At, B0); PG8_MMA(0, 1, At, B1); PG8_BAR; PG8_SCHED;
            PG8_LDA(At, 1, 1); PG8_STAGE(PG8_SB(1, 0), b3, voffB); PG8_STAGE(PG8_SB(1, 1), b3 + hstep, voffB); PG8_STAGE(PG8_SA(1, 0), a3, voffA);
            PG8_WAIT_V(8); PG8_WAIT_L(0); PG8_BAR; PG8_MMA(1, 0, At, B0); PG8_MMA(1, 1, At, B1); PG8_BAR; PG8_SCHED;
            } else {
            PG8_LDB(B0, 0, 0); PG8_SCHED; PG8_LDA(At, 0, 0); PG8_STAGE(PG8_SA(1, 1), a1 + hstep, voffA);
            PG8_WAIT_L(8); PG8_BAR; PG8_WAIT_L(0); PG8_MMA(0, 0, At, B0); PG8_BAR; PG8_SCHED;
            PG8_LDB(B1, 0, 1); PG8_STAGE(PG8_SB(0, 0), b2, voffB);
            PG8_BAR; PG8_WAIT_L(0); PG8_MMA(0, 1, At, B1); PG8_BAR;
            PG8_LDA(At, 0, 1); PG8_STAGE(PG8_SA(0, 0), a2, voffA);
            PG8_BAR; PG8_WAIT_L(0); PG8_MMA(1, 0, At, B0); PG8_BAR; PG8_SCHED;
            PG8_STAGE(PG8_SB(0, 1), b2 + hstep, voffB);
            PG8_WAIT_V(6); PG8_BAR; PG8_MMA(1, 1, At, B1); PG8_BAR;
            PG8_LDB(B0, 1, 0); PG8_SCHED; PG8_LDA(At, 1, 0); PG8_STAGE(PG8_SA(0, 1), a2 + hstep, voffA);
            PG8_WAIT_L(8); PG8_BAR; PG8_WAIT_L(0); PG8_MMA(0, 0, At, B0); PG8_BAR; PG8_SCHED;
            PG8_LDB(B1, 1, 1); PG8_STAGE(PG8_SB(1, 0), b3, voffB);
            PG8_BAR; PG8_WAIT_L(0); PG8_MMA(0, 1, At, B1); PG8_BAR;
            PG8_LDA(At, 1, 1); PG8_STAGE(PG8_SA(1, 0), a3, voffA);
            PG8_BAR; PG8_WAIT_L(0); PG8_MMA(1, 0, At, B0); PG8_BAR; PG8_SCHED;
            PG8_STAGE(PG8_SB(1, 1), b3 + hstep, voffB);
            PG8_WAIT_V(6); PG8_BAR; PG8_MMA(1, 1, At, B1); PG8_BAR;
            }
        }
        if constexpr (ALIGN_EPI) { if (wr == 0) PG8_BAR; }
        if constexpr (!Epi::AFTER_DRAIN) { E(acc, cur, wr, wc, fr, fq); S.done(cur); }
        if (!has_next) break;
#pragma unroll
        for (int a = 0; a < 2; ++a)
#pragma unroll
            for (int b = 0; b < 2; ++b)
#pragma unroll
                for (int m = 0; m < 4; ++m)
#pragma unroll
                    for (int n = 0; n < 2; ++n) acc[a][b][m][n] = (f32x4){0.f, 0.f, 0.f, 0.f};
        cur = nxt; cA = nA; cB = nB; ++ui;
        if constexpr (ALIGN_EPI) { if (wr == 1) PG8_BAR; }
    }
    PG8_WAIT_V(0);
    if constexpr (!ALIGN_EPI) { if (wr == 0) PG8_BAR; }
    PG8_BAR;
    if constexpr (Epi::AFTER_DRAIN) { E.fused(acc, cur, wr, wc, fr, fq, lds, wid, lane); S.done(cur); }
#undef PG8_SA
#undef PG8_SB
#undef PG8_STAGE
#undef PG8_LDA
#undef PG8_LDB
#undef PG8_MMA
#undef PG8_WAIT_V
#undef PG8_WAIT_L
#undef PG8_BAR
#undef PG8_SCHED
}
}
#ifndef PG8_SP2
#define PG8_SP2 true
#endif
#ifndef PG8_ALIGN
#define PG8_ALIGN true
#endif
#define GAS __attribute__((address_space(1)))
#define LAS __attribute__((address_space(3)))
typedef unsigned short bf16;
typedef unsigned v4u __attribute__((ext_vector_type(4)));
typedef float f32x4 __attribute__((ext_vector_type(4)));
typedef short bf16x8 __attribute__((ext_vector_type(8)));
typedef GAS unsigned gu32;
typedef GAS unsigned long long gu64;
#define RLX_AGENT __ATOMIC_RELAXED, __HIP_MEMORY_SCOPE_AGENT
#define LDS_WAIT() asm volatile("s_waitcnt lgkmcnt(0)" ::: "memory")
#define VM_WAIT() asm volatile("s_waitcnt vmcnt(0)" ::: "memory")
__device__ __forceinline__ unsigned long long rt() { return __builtin_amdgcn_s_memrealtime(); }
typedef float f32x2_t __attribute__((ext_vector_type(2))); typedef __bf16 bf16x2_t __attribute__((ext_vector_type(2)));
__device__ __forceinline__ unsigned pk2(float lo, float hi) { const f32x2_t v = {lo, hi}; const bf16x2_t b = __builtin_convertvector(v, bf16x2_t); return __builtin_bit_cast(unsigned, b); }
__device__ __forceinline__ unsigned f2bf(float f) { return pk2(f, 0.f) & 0xffffu; }

#define XB_TMO      128
#define XB_XCNT(j)  (256  + 64 * (j))
#define XB_XSUB(j)  (1280 + 64 * (j))
#define XB_XGEN(j)  (2304 + 64 * (j))
#define XB_TOP      3328
#define XB_TOPGEN   3392
#define XCD_BAR_WORDS 3456
#define XB_SPIN_CAP (1u << 18)

__device__ __forceinline__ unsigned xb_ld(unsigned* p)              { return __hip_atomic_load(p, __ATOMIC_RELAXED, __HIP_MEMORY_SCOPE_AGENT); }
__device__ __forceinline__ unsigned xb_add(unsigned* p, unsigned v) { return __hip_atomic_fetch_add(p, v, __ATOMIC_RELAXED, __HIP_MEMORY_SCOPE_AGENT); }
__device__ __forceinline__ unsigned xb_xcc_id() { return (unsigned)__builtin_amdgcn_s_getreg((3 << 11) | 20) & 0xFu; }
#define XB_SPIN(cond, bar) do { unsigned _sp = 0; while (cond) { __builtin_amdgcn_s_sleep(1); \
    if ((++_sp & 255u) == 0u) { if (xb_ld(&(bar)[XB_TMO])) break; if (_sp > XB_SPIN_CAP) { atomicAdd(&(bar)[XB_TMO], 1u); break; } } } } while (0)

struct XcdBarrier {
    unsigned* bar; unsigned x;
    volatile LAS unsigned* st;
};

__device__ __forceinline__ XcdBarrier xcd_barrier_post(unsigned* bar, volatile LAS unsigned* st) {
    XcdBarrier b; b.bar = bar; b.x = xb_xcc_id(); b.st = st;
    if (threadIdx.x == 0) (void)xb_add(&bar[XB_XCNT(b.x)], 1u);
    return b;
}
__device__ __forceinline__ void xcd_barrier_complete(unsigned* bar, unsigned x, unsigned& nloc, unsigned& nx) {
    const unsigned G = gridDim.x * gridDim.y * gridDim.z;
    unsigned sum, cnt, mine, sp = 0u;
    for (;;) {
        sum = 0u; cnt = 0u; mine = 0u;
#pragma unroll
        for (unsigned j = 0; j < 16; ++j) { const unsigned c = xb_ld(&bar[XB_XCNT(j)]); sum += c; cnt += (c > 0u) ? 1u : 0u; mine = (j == x) ? c : mine; }
        if (sum == G) break;
        __builtin_amdgcn_s_sleep(1);
        if ((++sp & 255u) == 0u) { if (xb_ld(&bar[XB_TMO])) break; if (sp > XB_SPIN_CAP) { atomicAdd(&bar[XB_TMO], 1u); break; } }
    }
    nloc = mine > 0u ? mine : 1u; nx = cnt > 0u ? cnt : 1u;
}

__device__ __forceinline__ void xcd_barrier(const XcdBarrier& b) {
    asm volatile("s_waitcnt vmcnt(0)" ::: "memory");
    __syncthreads();
    if (threadIdx.x == 0) {
        unsigned* bar = b.bar;
        __builtin_amdgcn_s_waitcnt(0);
        unsigned nloc = b.st[0], nx = b.st[1];
        if (nloc == 0u) { xcd_barrier_complete(bar, b.x, nloc, nx); b.st[0] = nloc; b.st[1] = nx; }
        const unsigned old = xb_add(&bar[XB_XSUB(b.x)], 1u);
        const unsigned gen = old / nloc;
        if (old + 1u == (gen + 1u) * nloc) {
            __builtin_amdgcn_fence(__ATOMIC_RELEASE, "agent");
            asm volatile("s_waitcnt vmcnt(0)" ::: "memory");
            const unsigned og = xb_add(&bar[XB_TOP], 1u);
            const unsigned tg = og / nx;
            if (og + 1u == (tg + 1u) * nx) xb_add(&bar[XB_TOPGEN], 1u);
            else XB_SPIN(xb_ld(&bar[XB_TOPGEN]) == tg, bar);
            __builtin_amdgcn_fence(__ATOMIC_ACQUIRE, "agent");
            xb_add(&bar[XB_XGEN(b.x)], 1u);
            asm volatile("s_waitcnt vmcnt(0)" ::: "memory");
        } else {
            XB_SPIN(xb_ld(&bar[XB_XGEN(b.x)]) == gen, bar);
            __builtin_amdgcn_fence(__ATOMIC_ACQUIRE, "agent");
            asm volatile("s_waitcnt vmcnt(0)" ::: "memory");
        }
    }
    __syncthreads();
}

constexpr int NWAVES = 8;
#ifndef FOX_SKIP
#define FOX_SKIP 1
#endif
#ifndef MK_ONE_LAUNCH
#define MK_ONE_LAUNCH 1
#endif
constexpr int N_PHASES = 7;

constexpr int DM = 1024, BATCH = 8, SEQ = 4096, DECB = 32, DECS = 16, PAST = 1024, NMEM = 256;
constexpr int MP = BATCH * SEQ, MS = DECB * DECS, MT = MP + MS;
constexpr int NIN = 3654, NP = 3840;
constexpr int HC_FQ = 0, HC_FK = 384, HC_FV = 768, HC_FG = 1152, HC_RR = 1536, HC_RK = 1920, HC_RV = 2304, HC_RG = 2688,
              HC_MQ = 3072, HC_MG = 3328, HC_WD = 3584, HC_AD = 3616, HC_FF = 3648;
constexpr float NORM_EPS = 1e-6f, GN_EPS = 64e-5f, LOG2E = 1.4426950408889634f, C2 = 0.125f * 1.4426950408889634f;

constexpr size_t O_YP = 0, O_YS = O_YP + (size_t)MP * DM, O_FKP = O_YS + (size_t)MS * DM, O_FVP = O_FKP + (size_t)MP * 384, O_FLP = O_FVP + (size_t)MP * 384,
                 O_MKP = O_FLP + (size_t)MP * 6, O_MVP = O_MKP + (size_t)BATCH * NMEM * 256, O_RSP = O_MVP + (size_t)BATCH * NMEM * 256, O_RHP = O_RSP + (size_t)BATCH * 6 * 4096,
                 O_FKS = O_RHP + (size_t)BATCH * 1600, O_FVS = O_FKS + (size_t)MS * 384, O_FLS = O_FVS + (size_t)MS * 384, O_RSS = O_FLS + (size_t)MS * 6,
                 O_RHS = O_RSS + (size_t)DECB * 6 * 4096, O_END = O_RHS + (size_t)DECB * 1600;
static_assert(O_END == 61933056, "d_out map");

constexpr size_t MiB = 1u << 20;
constexpr size_t WS_CTL = 0, CTL_ZERO_BYTES = 1 * MiB;
constexpr size_t WS_WIN = 2 * MiB, WS_WOUT = 10 * MiB, WS_WMEM = 12 * MiB, WS_MEMN = 13 * MiB, WS_MKV = 17 * MiB, WS_NCKP = 19 * MiB, WS_NCKS = 20 * MiB;
constexpr size_t WS_XN = 24 * MiB;
constexpr size_t WS_H = 96 * MiB;
constexpr size_t WS_END = WS_H + (size_t)MT * NP * 2;
static_assert(WS_XN + (size_t)MT * DM * 2 <= WS_H && WS_END <= 400 * MiB, "d_ws map");
constexpr int CW_BAR = 4096, CW_Q = 64;

constexpr int RING_OFF = 0, RING_BYTES = 131072;
constexpr int LDS_BYTES = 147456;
constexpr int LDSCTL_OFF = LDS_BYTES - 448, MISC_OFF = LDSCTL_OFF + 320;

struct Args { const float* in[30]; float* out; unsigned char* ws; int ph_lo, ph_hi, li, pad; };
enum { I_XP = 0, I_XS, I_MEMP, I_CFK, I_CFV, I_CFL, I_CMK, I_CMV, I_SRW, I_SSH, I_NG, I_WIN, I_FQG, I_FKG, I_FBF, I_MU, I_W0, I_WUP, I_A0, I_AUP,
       I_KK, I_KA, I_RK, I_GNW, I_GNB, I_MNG, I_WMKV, I_MQG, I_MKG, I_WOUT };

struct Ctx { LAS unsigned char* lds; volatile LAS unsigned* MISC; gu32* ctl; int tid, lane, wave, vcu, G; };

__device__ __forceinline__ float bf2f(bf16 u) { return __uint_as_float((unsigned)u << 16); }
__device__ __forceinline__ float wave_sum(float v) {
#pragma unroll
    for (int o = 1; o < 64; o <<= 1) v += __shfl_xor(v, o);
    return v;
}
__device__ __forceinline__ float wave_max(float v) {
#pragma unroll
    for (int o = 1; o < 64; o <<= 1) v = fmaxf(v, __shfl_xor(v, o));
    return v;
}
__device__ __forceinline__ float sum8(float v) { v += __shfl_xor(v, 1); v += __shfl_xor(v, 2); v += __shfl_xor(v, 4); return v; }
__device__ __forceinline__ void unpack8(const v4u w, float (&f)[8]) {
    f[0] = __uint_as_float(w.x << 16); f[1] = __uint_as_float(w.x & 0xffff0000u); f[2] = __uint_as_float(w.y << 16); f[3] = __uint_as_float(w.y & 0xffff0000u);
    f[4] = __uint_as_float(w.z << 16); f[5] = __uint_as_float(w.z & 0xffff0000u); f[6] = __uint_as_float(w.w << 16); f[7] = __uint_as_float(w.w & 0xffff0000u); }
__device__ __forceinline__ void ld8(const float* p, float (&f)[8]) { const f32x4 a = *(const f32x4*)p, b = *(const f32x4*)(p + 4);
    f[0] = a.x; f[1] = a.y; f[2] = a.z; f[3] = a.w; f[4] = b.x; f[5] = b.y; f[6] = b.z; f[7] = b.w; }
__device__ __forceinline__ float fexp(float x) { return __builtin_amdgcn_exp2f(x * LOG2E); }
__device__ __forceinline__ float frcp(float x) { return __builtin_amdgcn_rcpf(x); }
__device__ __forceinline__ float frsq(float x) { return __builtin_amdgcn_rsqf(x); }
__device__ __forceinline__ float flog(float x) { return __builtin_amdgcn_logf(x) * 0.6931471805599453f; }
__device__ __forceinline__ float siluf(float g) { return g * frcp(1.f + fexp(-g)); }
__device__ __forceinline__ float sigmf(float x) { return frcp(1.f + fexp(-x)); }
__device__ __forceinline__ float softplusf(float z) { return fmaxf(z, 0.f) + flog(1.f + fexp(-fabsf(z))); }
__device__ __forceinline__ float ftanh(float x) { return 1.f - 2.f * frcp(fexp(2.f * x) + 1.f); }

__device__ __forceinline__ int colmap_in(int n) {
    if (n < 1152) return n;
    if (n < 1158) return HC_FF + (n - 1152);
    if (n < 1542) return HC_FG + (n - 1158);
    if (n < 3142) { const int m = n - 1542;
        if (m < 1152) return HC_RR + m;
        if (m < 1184) return HC_WD + (m - 1152);
        if (m < 1216) return HC_AD + (m - 1184);
        return HC_RG + (m - 1216); }
    return HC_MQ + (n - 3142);
}
template <int MODE>
__device__ __forceinline__ void transpose_item(const float* W, int K, int N, bf16* WT, LAS float* scr, int item, int lane) {
    const int nblk = (N + 31) / 32, kb = item / nblk, nb = item % nblk, k0 = 64 * kb, n0 = 32 * nb;
    const int nl0 = lane & 31; const bool okn = (n0 + nl0) < N;
#pragma unroll 8
    for (int i = 0; i < 32; ++i) { const int kk = 2 * i + (lane >> 5); scr[kk * 33 + nl0] = okn ? W[(size_t)(k0 + kk) * N + n0 + nl0] : 0.f; }
    LDS_WAIT(); asm volatile("" ::: "memory");
    const int c = lane & 7;
#pragma unroll
    for (int j = 0; j < 4; ++j) { const int nl = (lane >> 3) + 8 * j, n = n0 + nl; const LAS float* s = scr + (8 * c) * 33 + nl;
        v4u o; o.x = pk2(s[0 * 33], s[1 * 33]); o.y = pk2(s[2 * 33], s[3 * 33]); o.z = pk2(s[4 * 33], s[5 * 33]); o.w = pk2(s[6 * 33], s[7 * 33]);
        if (n < N) { const int row = (MODE == 0) ? colmap_in(n) : n; *(v4u*)(WT + (size_t)row * K + k0 + 8 * c) = o; } }
    LDS_WAIT(); asm volatile("" ::: "memory");
}
__device__ __forceinline__ void rms_row_to_bf16(const float* xrow, const float* g, bf16* orow, int lane) {
    const f32x4* xr = (const f32x4*)xrow + lane; const f32x4* gr = (const f32x4*)g + lane;
    f32x4 v[4]; float s = 0.f;
#pragma unroll
    for (int j = 0; j < 4; ++j) { v[j] = xr[64 * j]; s += (v[j].x * v[j].x + v[j].y * v[j].y) + (v[j].z * v[j].z + v[j].w * v[j].w); }
    const float rstd = frsq(wave_sum(s) * (1.f / DM) + NORM_EPS);
    unsigned long long* o8 = (unsigned long long*)orow + lane;
#pragma unroll
    for (int j = 0; j < 4; ++j) { const f32x4 gg = gr[64 * j]; const f32x4 y = v[j] * rstd * gg;
        o8[64 * j] = (unsigned long long)pk2(y.x, y.y) | ((unsigned long long)pk2(y.z, y.w) << 32); }
}
__device__ __forceinline__ void p0_prologue(const Ctx& F, const Args& a) {
    LAS float* scr = (LAS float*)(F.lds + RING_OFF + F.wave * 16384);
    const int gw = F.vcu * NWAVES + F.wave, NGW = F.G * NWAVES;
    bf16* WinT = (bf16*)(a.ws + WS_WIN); bf16* WoutT = (bf16*)(a.ws + WS_WOUT); bf16* WmemT = (bf16*)(a.ws + WS_WMEM);
    constexpr int I_IN = (DM / 64) * ((NIN + 31) / 32), I_OUT = (DM / 64) * (DM / 32), I_MEM = (DM / 64) * (512 / 32);
    for (int it = gw; it < I_IN + I_OUT + I_MEM; it += NGW) {
        int r = it;
        if (r < I_IN) { transpose_item<0>(a.in[I_WIN], DM, NIN, WinT, scr, r, F.lane); continue; } r -= I_IN;
        if (r < I_OUT) { transpose_item<1>(a.in[I_WOUT], DM, DM, WoutT, scr, r, F.lane); continue; } r -= I_OUT;
        transpose_item<1>(a.in[I_WMKV], DM, 512, WmemT, scr, r, F.lane);
    }
    for (int r = NIN + gw; r < NP; r += NGW) { v4u z = {0u, 0u, 0u, 0u}; v4u* p = (v4u*)(WinT + (size_t)r * DM); p[F.lane] = z; p[F.lane + 64] = z; }
    bf16* XN = (bf16*)(a.ws + WS_XN); bf16* MEMN = (bf16*)(a.ws + WS_MEMN);
    for (int m0 = 2 * gw; m0 < MT + BATCH * NMEM; m0 += 2 * NGW) {
        const float* xr = (m0 < MP) ? a.in[I_XP] + (size_t)m0 * DM : (m0 < MT) ? a.in[I_XS] + (size_t)(m0 - MP) * DM : a.in[I_MEMP] + (size_t)(m0 - MT) * DM;
        const f32x4* gr = (const f32x4*)((m0 < MT) ? a.in[I_NG] : a.in[I_MNG]) + F.lane;
        unsigned long long* o8 = (unsigned long long*)((m0 < MT) ? XN + (size_t)m0 * DM : MEMN + (size_t)(m0 - MT) * DM) + F.lane;
        f32x4 v0[4], v1[4]; float s0 = 0.f, s1 = 0.f;
#pragma unroll
        for (int j = 0; j < 4; ++j) { v0[j] = ((const f32x4*)xr)[F.lane + 64 * j]; v1[j] = ((const f32x4*)xr)[256 + F.lane + 64 * j]; }
#pragma unroll
        for (int j = 0; j < 4; ++j) { s0 += (v0[j].x * v0[j].x + v0[j].y * v0[j].y) + (v0[j].z * v0[j].z + v0[j].w * v0[j].w); s1 += (v1[j].x * v1[j].x + v1[j].y * v1[j].y) + (v1[j].z * v1[j].z + v1[j].w * v1[j].w); }
#pragma unroll
        for (int o = 1; o < 64; o <<= 1) { s0 += __shfl_xor(s0, o); s1 += __shfl_xor(s1, o); }
        const float r0 = frsq(s0 * (1.f / DM) + NORM_EPS), r1 = frsq(s1 * (1.f / DM) + NORM_EPS);
#pragma unroll
        for (int j = 0; j < 4; ++j) { const f32x4 gg = gr[64 * j]; const f32x4 y0 = v0[j] * r0 * gg, y1 = v1[j] * r1 * gg;
            o8[64 * j] = (unsigned long long)pk2(y0.x, y0.y) | ((unsigned long long)pk2(y0.z, y0.w) << 32);
            o8[256 + 64 * j] = (unsigned long long)pk2(y1.x, y1.y) | ((unsigned long long)pk2(y1.z, y1.w) << 32); }
    }
}

__device__ __forceinline__ float wave_incl_scan(float v, int lane) {
#pragma unroll
    for (int o = 1; o < 64; o <<= 1) { const float n = __shfl_up(v, o); if (lane >= o) v += n; }
    return v;
}
constexpr int NBLK_PREP = MT / 64 + BATCH * NMEM / 64;
__device__ __forceinline__ void prep_block_task(LAS unsigned char* lds, const Args& a, int blk, int tid, int lane, int wave) {
    bf16* H = (bf16*)(a.ws + WS_H); bf16* MKV = (bf16*)(a.ws + WS_MKV); float* out = a.out;
    LAS float* LF = (LAS float*)lds;
    const int l8 = (lane & 7) * 8;
    __syncthreads();
    if (blk < MT / 64) {
        float gq[8], gk[8], gm[8];
        ld8(a.in[I_FQG] + l8, gq); ld8(a.in[I_FKG] + l8, gk); ld8(a.in[I_MQG] + l8, gm);
#pragma unroll
        for (int e = 0; e < 8; ++e) { gq[e] *= C2; gm[e] *= C2; }
        for (int i0 = 0; i0 < 8; i0 += 4) {
            v4u rq4[4], rk4[4], rv4[4], rm4[4]; float rf[4];
#pragma unroll
            for (int i = 0; i < 4; ++i) { const bf16* hr = H + (size_t)(blk * 64 + wave * 8 + i0 + i) * NP;
                if (lane < 48) { rq4[i] = *(const v4u*)(hr + HC_FQ + lane * 8); rk4[i] = *(const v4u*)(hr + HC_FK + lane * 8); rv4[i] = *(const v4u*)(hr + HC_FV + lane * 8); }
                if (lane < 32) rm4[i] = *(const v4u*)(hr + HC_MQ + lane * 8);
                rf[i] = (lane < 6) ? bf2f(hr[HC_FF + lane]) : 0.f; }
#pragma unroll
            for (int i = 0; i < 4; ++i) {
                const int rl = wave * 8 + i0 + i, m = blk * 64 + rl; bf16* hr = H + (size_t)m * NP;
                float* ok = (m < MP) ? out + O_FKP + (size_t)m * 384 : out + O_FKS + (size_t)(m - MP) * 384;
                float* ov = (m < MP) ? out + O_FVP + (size_t)m * 384 : out + O_FVS + (size_t)(m - MP) * 384;
                float* ol = (m < MP) ? out + O_FLP + (size_t)m * 6 : out + O_FLS + (size_t)(m - MP) * 6;
                if (lane < 48) {
                    float q[8], k[8], v[8];
                    unpack8(rq4[i], q); unpack8(rk4[i], k); unpack8(rv4[i], v);
                    float sq = 0.f, sk = 0.f;
#pragma unroll
                    for (int e = 0; e < 8; ++e) { sq += q[e] * q[e]; sk += k[e] * k[e]; }
                    sq = sum8(sq); sk = sum8(sk);
                    const float rq = frsq(sq * (1.f / 64.f) + NORM_EPS), rk = frsq(sk * (1.f / 64.f) + NORM_EPS);
#pragma unroll
                    for (int e = 0; e < 8; ++e) { q[e] = q[e] * rq * gq[e]; k[e] = k[e] * rk * gk[e]; }
                    v4u wq, wk; wq.x = pk2(q[0], q[1]); wq.y = pk2(q[2], q[3]); wq.z = pk2(q[4], q[5]); wq.w = pk2(q[6], q[7]);
                    wk.x = pk2(k[0], k[1]); wk.y = pk2(k[2], k[3]); wk.z = pk2(k[4], k[5]); wk.w = pk2(k[6], k[7]);
                    *(v4u*)(hr + HC_FQ + lane * 8) = wq; *(v4u*)(hr + HC_FK + lane * 8) = wk;
                    *(f32x4*)(ok + lane * 8) = (f32x4){k[0], k[1], k[2], k[3]}; *(f32x4*)(ok + lane * 8 + 4) = (f32x4){k[4], k[5], k[6], k[7]};
                    *(f32x4*)(ov + lane * 8) = (f32x4){v[0], v[1], v[2], v[3]}; *(f32x4*)(ov + lane * 8 + 4) = (f32x4){v[4], v[5], v[6], v[7]};
                }
                if (lane < 32) {
                    float q[8]; unpack8(rm4[i], q);
                    float sq = 0.f;
#pragma unroll
                    for (int e = 0; e < 8; ++e) sq += q[e] * q[e];
                    sq = sum8(sq); const float rq = frsq(sq * (1.f / 64.f) + NORM_EPS);
                    v4u wq; wq.x = pk2(q[0] * rq * gm[0], q[1] * rq * gm[1]); wq.y = pk2(q[2] * rq * gm[2], q[3] * rq * gm[3]); wq.z = pk2(q[4] * rq * gm[4], q[5] * rq * gm[5]); wq.w = pk2(q[6] * rq * gm[6], q[7] * rq * gm[7]);
                    *(v4u*)(hr + HC_MQ + lane * 8) = wq;
                }
                if (lane < 6) { const float z = rf[i] + a.in[I_FBF][lane]; const float lf = -softplusf(-z); ol[lane] = lf; LF[rl * 8 + lane] = lf; }
            }
        }
        __syncthreads();
        if (blk < MP / 64 && wave < 6) {
            const int b = blk / (SEQ / 64), kb = blk % (SEQ / 64);
            const float incl = wave_incl_scan(LF[lane * 8 + wave], lane);
            ((float*)(a.ws + WS_NCKP))[(size_t)(b * 6 + wave) * SEQ + kb * 64 + lane] = incl;
            if (lane == 63) ((float*)(a.ws + WS_NCKS))[(b * 6 + wave) * 64 + kb] = incl;
        }
    } else {
        float gk[8]; ld8(a.in[I_MKG] + l8, gk);
#pragma unroll 2
        for (int i = 0; i < 8; ++i) {
            const int mm = (blk - MT / 64) * 64 + wave * 8 + i; bf16* kr = MKV + (size_t)mm * 512;
            if (lane < 32) {
                float k[8], v[8]; unpack8(*(const v4u*)(kr + lane * 8), k); unpack8(*(const v4u*)(kr + 256 + lane * 8), v);
                float sk = 0.f;
#pragma unroll
                for (int e = 0; e < 8; ++e) sk += k[e] * k[e];
                sk = sum8(sk); const float rk = frsq(sk * (1.f / 64.f) + NORM_EPS);
#pragma unroll
                for (int e = 0; e < 8; ++e) k[e] = k[e] * rk * gk[e];
                v4u wk; wk.x = pk2(k[0], k[1]); wk.y = pk2(k[2], k[3]); wk.z = pk2(k[4], k[5]); wk.w = pk2(k[6], k[7]);
                *(v4u*)(kr + lane * 8) = wk;
                float* okm = out + O_MKP + (size_t)mm * 256 + lane * 8; float* ovm = out + O_MVP + (size_t)mm * 256 + lane * 8;
                *(f32x4*)okm = (f32x4){k[0], k[1], k[2], k[3]}; *(f32x4*)(okm + 4) = (f32x4){k[4], k[5], k[6], k[7]};
                *(f32x4*)ovm = (f32x4){v[0], v[1], v[2], v[3]}; *(f32x4*)(ovm + 4) = (f32x4){v[4], v[5], v[6], v[7]};
            }
        }
    }
}

typedef float f32x16 __attribute__((ext_vector_type(16)));
typedef unsigned u32x2 __attribute__((ext_vector_type(2)));
__device__ __forceinline__ int crow(int r, int hi) { return (r & 3) + 8 * (r >> 2) + 4 * hi; }

struct AttnP { const bf16* Q; int qpitch; const bf16* K; int kpitch; const bf16* V; int vpitch; const float* nck; const float* bt; const float* gq; const float* gk; const bf16* Gt; int gpitch; bf16* O; int opitch; int nt; int q0; int causal; };
constexpr int AT_KS = 0, AT_VT = 9216, AT_NK = 18432, AT_BUF = 18688, AT_PS = 2 * AT_BUF, AT_AL = AT_PS + 8 * 4608;
constexpr int NQ_AT = 768 + 512;
struct AttnPf { float btv, nq0; };
__device__ __forceinline__ void attn_prefetch(AttnPf& pf, const Args& a, int tk, int lane) {
    pf.btv = 0.f; pf.nq0 = 0.f;
    if (tk < 768) { const int qb = 15 - (tk & 15), bh = tk >> 4;
        pf.btv = (lane < 4 * (qb + 1)) ? ((const float*)(a.ws + WS_NCKS))[(size_t)bh * 64 + lane] : 0.f;
        pf.nq0 = ((const float*)(a.ws + WS_NCKP))[(size_t)bh * SEQ + qb * 256]; }
}
constexpr int A6_SLOTB = 8192, A6_K = 0, A6_V = 3 * A6_SLOTB, A6_WS = 6 * A6_SLOTB, A6_OST = A6_WS + 8 * 256, A6_NK = A6_OST + 8 * 8192, A6_END = A6_NK + 3 * 2048;
static_assert(A6_END <= RING_BYTES, "attention LDS map");
typedef short s16x4 __attribute__((ext_vector_type(4)));
typedef LAS const char* lds_cptr;
#define A6_SBAR() __builtin_amdgcn_sched_barrier(0)
#define A6_PIN(x) asm volatile("" : "+v"(x))
#define A6_MFMA(a, b, c) __builtin_amdgcn_mfma_f32_32x32x16_bf16(a, b, c, 0, 0, 0)
#define A6_WAIT_BAR(N) asm volatile("s_waitcnt vmcnt(" #N ") lgkmcnt(0)\n\ts_barrier" ::: "memory")
__device__ __forceinline__ void a6_glds16(const void* g, unsigned lds_base) {
    unsigned sv; asm volatile("s_mov_b32 %0, m0\n\ts_mov_b32 m0, %2\n\ts_nop 0\n\tglobal_load_lds_dwordx4 %1, off\n\ts_mov_b32 m0, %0" : "=&s"(sv) : "v"(g), "s"(lds_base) : "memory"); }
__device__ __forceinline__ void a6_glds4(const void* g, unsigned lds_base) {
    unsigned sv; asm volatile("s_mov_b32 %0, m0\n\ts_mov_b32 m0, %2\n\ts_nop 0\n\tglobal_load_lds_dword %1, off\n\ts_mov_b32 m0, %0" : "=&s"(sv) : "v"(g), "s"(lds_base) : "memory"); }
__device__ __forceinline__ void a6_kload2(bf16x8* kf, lds_cptr kp, int d0) { kf[2 * d0] = *(LAS const bf16x8*)(kp + d0 * 2048); kf[2 * d0 + 1] = *(LAS const bf16x8*)(kp + d0 * 2048 + 512); }
__device__ __forceinline__ s16x4 a6_vtr(lds_cptr p) { return __builtin_bit_cast(s16x4, __builtin_amdgcn_ds_read_tr16_b64_v4i16((LAS s16x4*)p)); }
#define A6_MX3(a, b, c) __builtin_fmaxf(__builtin_fmaxf((a), (b)), (c))
__device__ __forceinline__ float a6_rowmax(const f32x16& p0, const f32x16& p1) {
    float a = A6_MX3(p0[0], p0[1], p1[0]), b = A6_MX3(p0[2], p0[3], p1[1]); a = A6_MX3(a, p1[2], p1[3]);
#pragma unroll
    for (int r = 4; r < 16; r += 4) { a = A6_MX3(a, p0[r], p0[r + 1]); b = A6_MX3(b, p0[r + 2], p0[r + 3]); a = A6_MX3(a, p1[r], p1[r + 1]); b = A6_MX3(b, p1[r + 2], p1[r + 3]); }
    float m = __builtin_fmaxf(a, b); auto rr = __builtin_amdgcn_permlane32_swap(__float_as_uint(m), __float_as_uint(m), false, false);
    return __builtin_fmaxf(__uint_as_float(rr[0]), __uint_as_float(rr[1])); }
__device__ __forceinline__ void a6_cmask(f32x16& p0, f32x16& p1, int jb, int qrel, int hi) {
    const int qk = qrel - 64 * jb - 4 * hi;
#pragma unroll
    for (int r = 0; r < 16; ++r) { const int kc = (r & 3) + 8 * (r >> 2); if (kc > qk) p0[r] = -INFINITY; if (kc + 32 > qk) p1[r] = -INFINITY; } }

template <bool BIAS, bool CAUSAL>
__device__ __forceinline__ void attn64_unit(LAS unsigned char* lds, const bf16* Qw, int qpitch, const bf16* K, int kpitch, const bf16* V, int vpitch, const float* nck, float pre, int t0, float cq0, float mhat0,
                                            int NT, const bf16* Gw, int gpitch, bf16* Ow, int opitch, const Args& a, AttnPf& pfn, volatile LAS unsigned* nextw, int& nx, int tid, int lane, int wid) {
    asm volatile("" : "+v"(lane));
    const int r32 = lane & 31, hi = lane >> 5;
    const unsigned lds0 = (unsigned)(size_t)lds; LAS float* wsf = (LAS float*)(lds + A6_WS) + wid * 64; LAS float* wsfh = wsf + 4 * hi;
    const bf16* ksrc = K + (size_t)lane * kpitch + wid * 8;
    const bf16* vsrc = V + (size_t)(16 * (wid & 3) + (lane >> 2)) * vpitch + (wid >> 2) * 32 + (lane & 3) * 8;
    const float* nsrc = nck + lane;
    const unsigned kdst = lds0 + A6_K + wid * 1024, vdst = lds0 + A6_V + wid * 1024, ndst = lds0 + A6_NK + wid * 256;
#define DMA_K(t, slot) do { a6_glds16(ksrc + (size_t)(t) * 64 * kpitch, (unsigned)__builtin_amdgcn_readfirstlane(kdst + (slot))); \
                            if (BIAS) a6_glds4(nsrc + (t) * 64, (unsigned)__builtin_amdgcn_readfirstlane(ndst + ((slot) >> 2))); } while (0)
#define DMA_V(t, slot) a6_glds16(vsrc + (size_t)(t) * 64 * vpitch, (unsigned)__builtin_amdgcn_readfirstlane(vdst + (slot)))
    const lds_cptr vp0 = (lds_cptr)lds + A6_V + ((lane >> 4) & 1) * 32 + (lane & 3) * 8 + (4 * hi + ((lane & 15) >> 2)) * 64;
    const lds_cptr kp0 = (lds_cptr)lds + A6_K + hi * 1024 + r32 * 16;
    const lds_cptr np0 = (lds_cptr)lds + A6_NK + wid * 256 + hi * 16;
    bf16x8 qr[4];
#pragma unroll
    for (int d0 = 0; d0 < 4; ++d0) qr[d0] = *reinterpret_cast<const bf16x8*>(&Qw[(size_t)r32 * qpitch + d0 * 16 + hi * 8]);
    float mhat = mhat0, l_reg = 0.f; asm volatile("" : "+v"(mhat));
    DMA_K(0, 0); DMA_V(0, 0); DMA_K(1, A6_SLOTB); DMA_K(2, 2 * A6_SLOTB);
    f32x16 o[2]; o[0] = f32x16{}; o[1] = f32x16{};
    const int qrel = wid * 32 + r32; bool resc = false;
    f32x16 pA0, pA1, pB0, pB1; bf16x8 kf[8]; s16x4 vlo[8], vhi[8]; v4u pw0, pw1, pw2, pw3;
    int sl_prev = 0, sl_cur = 0, sl_next = A6_SLOTB;
#define ROT() do { sl_prev = sl_cur; sl_cur = sl_next; sl_next = (sl_next == 2 * A6_SLOTB) ? 0 : sl_next + A6_SLOTB; } while (0)
#define CTV(tt) (BIAS ? (cq0 - __int_as_float(__builtin_amdgcn_readlane(__float_as_int(pre), t0 + (tt)))) * LOG2E - mhat : -mhat)
#define BIASF(y, ct) (BIAS ? __builtin_fmaf((y), -LOG2E, (ct)) : (ct))
#define NKRD(P0, P1, slot) do { if (BIAS) { _Pragma("unroll") for (int g_ = 0; g_ < 4; ++g_) { const f32x4 a0_ = *(LAS const f32x4*)(np0 + ((slot) >> 2) + g_ * 32), a1_ = *(LAS const f32x4*)(np0 + ((slot) >> 2) + 128 + g_ * 32); \
        P0[4 * g_] = a0_.x; P0[4 * g_ + 1] = a0_.y; P0[4 * g_ + 2] = a0_.z; P0[4 * g_ + 3] = a0_.w; P1[4 * g_] = a1_.x; P1[4 * g_ + 1] = a1_.y; P1[4 * g_ + 2] = a1_.z; P1[4 * g_ + 3] = a1_.w; } } } while (0)
#define EX(v) __builtin_amdgcn_exp2f(v)
#define RESC() do { if (resc) { _Pragma("unroll") for (int d_ = 0; d_ < 2; ++d_) _Pragma("unroll") for (int r = 0; r < 16; ++r) o[d_][r] *= wsfh[(r & 3) + 8 * (r >> 2)]; } } while (0)
#define DECIDE(C0, C1, WITH_L) do { const float rm_ = a6_rowmax(C0, C1); resc = false; \
      if (__builtin_expect(__any(rm_ > 8.f), 0)) { const float dl_ = __builtin_fmaxf(rm_, 0.f); mhat += dl_; \
          _Pragma("unroll") for (int r = 0; r < 16; ++r) { C0[r] -= dl_; C1[r] -= dl_; } \
          if (WITH_L) { const float f_ = __builtin_amdgcn_exp2f(-dl_); l_reg *= f_; if (hi == 0) wsf[r32] = f_; resc = true; } } } while (0)
    if (BIAS) { A6_WAIT_BAR(5); } else { A6_WAIT_BAR(3); }
    nx = (int)*nextw; if (nx < NQ_AT) attn_prefetch(pfn, a, nx, lane);
    NKRD(pA0, pA1, 0);
    { const float ct = CTV(0);
#pragma unroll
      for (int r = 0; r < 16; ++r) { pA0[r] = BIASF(pA0[r], ct); pA1[r] = BIASF(pA1[r], ct); } }
    _Pragma("unroll") for (int d0 = 0; d0 < 4; ++d0) a6_kload2(kf, kp0, d0);
    pA0 = A6_MFMA(kf[0], qr[0], pA0); pA1 = A6_MFMA(kf[1], qr[0], pA1); pA0 = A6_MFMA(kf[2], qr[1], pA0); pA1 = A6_MFMA(kf[3], qr[1], pA1);
    pA0 = A6_MFMA(kf[4], qr[2], pA0); pA1 = A6_MFMA(kf[5], qr[2], pA1); pA0 = A6_MFMA(kf[6], qr[3], pA0); pA1 = A6_MFMA(kf[7], qr[3], pA1);
    if (CAUSAL && NT == 4) a6_cmask(pA0, pA1, 0, qrel, hi);
    DECIDE(pA0, pA1, false);
#pragma unroll
    for (int r = 0; r < 16; ++r) { pA0[r] = EX(pA0[r]); pA1[r] = EX(pA1[r]); }
    A6_WAIT_BAR(0);
    DMA_K(3, 0); DMA_V(1, A6_SLOTB); ROT();
    _Pragma("unroll") for (int d0 = 0; d0 < 4; ++d0) a6_kload2(kf, kp0 + sl_cur, d0);
    NKRD(pB0, pB1, sl_cur);
    { const float ct = CTV(1);
#pragma unroll
      for (int r = 0; r < 16; ++r) { pB0[r] = BIASF(pB0[r], ct); pB1[r] = BIASF(pB1[r], ct); } }
    if (BIAS) { A6_WAIT_BAR(3); } else { A6_WAIT_BAR(2); }
#define PKW(P, i) pk2(P[i], P[i + 1])
#define PAF(k) __builtin_bit_cast(bf16x8, pw##k)
#define VFR(i) (bf16x8){vlo[i][0], vlo[i][1], vlo[i][2], vlo[i][3], vhi[i][0], vhi[i][1], vhi[i][2], vhi[i][3]}
#define VRD(i) do { vlo[i] = a6_vtr(vp_ + (((i) >> 2) * 4096 + ((i) & 3) * 1024)); vhi[i] = a6_vtr(vp_ + (((i) >> 2) * 4096 + ((i) & 3) * 1024 + 512)); } while (0)
#define KRD(G, d0) do { if (G) { a6_kload2(kf, kp0 + sl_next, d0); A6_SBAR(); } } while (0)
#define GAPA(MF, a0, a1, a2, a3, W0, W1, PW) do { MF; sacc += a0; sacc += a1; sacc += a2; sacc += a3; W0; W1; A6_PIN(PW); A6_PIN(sacc); A6_SBAR(); } while (0)
#define GAPB(MF, X, i, G, Y) do { MF; X[i] = EX(X[i]); X[i + 1] = EX(X[i + 1]); X[i + 2] = EX(X[i + 2]); X[i + 3] = EX(X[i + 3]); \
        if (G) { Y[i] = BIASF(Y[i], ctn); Y[i + 1] = BIASF(Y[i + 1], ctn); Y[i + 2] = BIASF(Y[i + 2], ctn); Y[i + 3] = BIASF(Y[i + 3], ctn); A6_PIN(Y); } A6_PIN(X); A6_SBAR(); } while (0)
#define STEP(C0, C1, P0, P1, t, MASK, GK, GV, GL) do { A6_SBAR(); \
    const lds_cptr vp_ = vp0 + sl_prev; \
    VRD(0); A6_SBAR(); float sacc = P0[0] + P0[1]; \
                       GAPA(C0 = A6_MFMA(kf[0], qr[0], C0), P0[2], P0[3], P0[4], P0[5],     pw0[0] = PKW(P0, 0),  pw0[1] = PKW(P0, 2),  pw0); \
    VRD(4); A6_SBAR(); GAPA(C1 = A6_MFMA(kf[1], qr[0], C1), P0[6], P0[7], P0[8], P0[9],     pw0[2] = PKW(P0, 4),  pw0[3] = PKW(P0, 6),  pw0); \
    VRD(1); A6_SBAR(); GAPA(C0 = A6_MFMA(kf[2], qr[1], C0), P0[10], P0[11], P0[12], P0[13], pw1[0] = PKW(P0, 8),  pw1[1] = PKW(P0, 10), pw1); \
    VRD(5); A6_SBAR(); GAPA(C1 = A6_MFMA(kf[3], qr[1], C1), P0[14], P0[15], P1[0], P1[1],   pw1[2] = PKW(P0, 12), pw1[3] = PKW(P0, 14), pw1); \
    VRD(2); A6_SBAR(); GAPA(C0 = A6_MFMA(kf[4], qr[2], C0), P1[2], P1[3], P1[4], P1[5],     pw2[0] = PKW(P1, 0),  pw2[1] = PKW(P1, 2),  pw2); \
    VRD(6); A6_SBAR(); GAPA(C1 = A6_MFMA(kf[5], qr[2], C1), P1[6], P1[7], P1[8], P1[9],     pw2[2] = PKW(P1, 4),  pw2[3] = PKW(P1, 6),  pw2); \
    VRD(3); A6_SBAR(); GAPA(C0 = A6_MFMA(kf[6], qr[3], C0), P1[10], P1[11], P1[12], P1[13], pw3[0] = PKW(P1, 8),  pw3[1] = PKW(P1, 10), pw3); \
    VRD(7); A6_SBAR(); GAPA(C1 = A6_MFMA(kf[7], qr[3], C1), P1[14], P1[15], 0.f, 0.f,       pw3[2] = PKW(P1, 12), pw3[3] = PKW(P1, 14), pw3); \
    l_reg += sacc; \
    if (GK) DMA_K((t) + 3, sl_cur); if (GV) DMA_V((t) + 1, sl_next); \
    if (GL) NKRD(P0, P1, sl_next);                                                       \
    if (MASK && CAUSAL) a6_cmask(C0, C1, (t) - (NT - 4), qrel, hi); \
    DECIDE(C0, C1, true); \
    const float ctn = CTV((t) + 1); A6_SBAR(); \
    GAPB(o[0] = A6_MFMA(PAF(0), VFR(0), o[0]), C0, 0, GL, P0);              GAPB(o[1] = A6_MFMA(PAF(0), VFR(4), o[1]), C0, 4, GL, P0); \
    KRD(GL, 0); GAPB(o[0] = A6_MFMA(PAF(1), VFR(1), o[0]), C0, 8, GL, P0);  KRD(GL, 1); GAPB(o[1] = A6_MFMA(PAF(1), VFR(5), o[1]), C0, 12, GL, P0); \
    KRD(GL, 2); GAPB(o[0] = A6_MFMA(PAF(2), VFR(2), o[0]), C1, 0, GL, P1);  KRD(GL, 3); GAPB(o[1] = A6_MFMA(PAF(2), VFR(6), o[1]), C1, 4, GL, P1); \
    GAPB(o[0] = A6_MFMA(PAF(3), VFR(3), o[0]), C1, 8, GL, P1);              GAPB(o[1] = A6_MFMA(PAF(3), VFR(7), o[1]), C1, 12, GL, P1); \
    } while (0)
#define STEADYW() do { if (BIAS) { A6_WAIT_BAR(3); } else { A6_WAIT_BAR(2); } } while (0)
    int t = 1;
    for (; t + 5 < NT; t += 2) {
        STEP(pB0, pB1, pA0, pA1, t, false, true, true, true);     STEADYW(); RESC(); ROT();
        STEP(pA0, pA1, pB0, pB1, t + 1, false, true, true, true); STEADYW(); RESC(); ROT();
    }
#define ENDW(tt) do { if ((tt) + 3 < NT) { STEADYW(); } else if ((tt) + 2 < NT) { A6_WAIT_BAR(1); } else { A6_WAIT_BAR(0); } } while (0)
    for (; t + 1 < NT; t += 2) {
        STEP(pB0, pB1, pA0, pA1, t, true, (t + 3 < NT), (t + 1 < NT), (t + 1 < NT));         ENDW(t);     RESC(); ROT();
        STEP(pA0, pA1, pB0, pB1, t + 1, true, (t + 4 < NT), (t + 2 < NT), (t + 2 < NT));     ENDW(t + 1); RESC(); ROT();
    }
    const int erow = lane >> 3, ech = lane & 7;
    v4u gt[4];
#pragma unroll
    for (int i = 0; i < 4; ++i) gt[i] = *(const v4u*)(Gw + (size_t)(i * 8 + erow) * gpitch + ech * 8);
    STEP(pB0, pB1, pA0, pA1, NT - 1, true, false, false, false); RESC();
    { float sacc = pB0[0] + pB0[1];
#pragma unroll
      for (int r = 2; r < 16; ++r) sacc += pB0[r];
#pragma unroll
      for (int r = 0; r < 16; ++r) sacc += pB1[r];
      l_reg += sacc;
      pw0 = (v4u){PKW(pB0, 0), PKW(pB0, 2), PKW(pB0, 4), PKW(pB0, 6)}; pw1 = (v4u){PKW(pB0, 8), PKW(pB0, 10), PKW(pB0, 12), PKW(pB0, 14)};
      pw2 = (v4u){PKW(pB1, 0), PKW(pB1, 2), PKW(pB1, 4), PKW(pB1, 6)}; pw3 = (v4u){PKW(pB1, 8), PKW(pB1, 10), PKW(pB1, 12), PKW(pB1, 14)};
      const lds_cptr vp_ = vp0 + sl_cur; _Pragma("unroll") for (int i = 0; i < 8; ++i) VRD(i);
      o[0] = A6_MFMA(PAF(0), VFR(0), o[0]); o[1] = A6_MFMA(PAF(0), VFR(4), o[1]); o[0] = A6_MFMA(PAF(1), VFR(1), o[0]); o[1] = A6_MFMA(PAF(1), VFR(5), o[1]);
      o[0] = A6_MFMA(PAF(2), VFR(2), o[0]); o[1] = A6_MFMA(PAF(2), VFR(6), o[1]); o[0] = A6_MFMA(PAF(3), VFR(3), o[0]); o[1] = A6_MFMA(PAF(3), VFR(7), o[1]); }
    { auto rr = __builtin_amdgcn_permlane32_swap(__float_as_uint(l_reg), __float_as_uint(l_reg), false, false); l_reg = __uint_as_float(rr[0]) + __uint_as_float(rr[1]); }
    if (hi == 0) wsf[32 + r32] = l_reg;
    asm volatile("s_waitcnt lgkmcnt(0)" ::: "memory"); __builtin_amdgcn_wave_barrier();
    LAS float* stg = (LAS float*)(lds + A6_OST) + wid * 2048; LAS float* stgh = stg + 4 * hi * 64 + r32;
#pragma unroll
    for (int r = 0; r < 16; ++r) { const int oc = (r & 3) + 8 * (r >> 2); const float rl = __builtin_amdgcn_rcpf(wsfh[32 + oc]);
        stgh[oc * 64] = o[0][r] * rl; stgh[oc * 64 + 32] = o[1][r] * rl; }
    asm volatile("s_waitcnt lgkmcnt(0)" ::: "memory"); __builtin_amdgcn_wave_barrier();
#pragma unroll
    for (int i = 0; i < 4; ++i) { const int row = i * 8 + erow;
        const f32x4 x0 = *(LAS const f32x4*)(stg + row * 64 + ech * 8), x1 = *(LAS const f32x4*)(stg + row * 64 + ech * 8 + 4); const v4u g = gt[i]; v4u w;
        w.x = pk2(x0.x * siluf(__uint_as_float(g.x << 16)), x0.y * siluf(__uint_as_float(g.x & 0xffff0000u)));
        w.y = pk2(x0.z * siluf(__uint_as_float(g.y << 16)), x0.w * siluf(__uint_as_float(g.y & 0xffff0000u)));
        w.z = pk2(x1.x * siluf(__uint_as_float(g.z << 16)), x1.y * siluf(__uint_as_float(g.z & 0xffff0000u)));
        w.w = pk2(x1.z * siluf(__uint_as_float(g.w << 16)), x1.w * siluf(__uint_as_float(g.w & 0xffff0000u)));
        *(v4u*)(Ow + (size_t)row * opitch + ech * 8) = w; }
    asm volatile("s_waitcnt lgkmcnt(0)\n\ts_barrier" ::: "memory");
#undef DMA_K
#undef DMA_V
#undef ROT
#undef CTV
#undef BIASF
#undef NKRD
#undef EX
#undef RESC
#undef DECIDE
#undef PKW
#undef PAF
#undef VFR
#undef VRD
#undef KRD
#undef ENDW
#undef STEADYW
#undef GAPA
#undef GAPB
#undef STEP
}

template <bool FOX>
__device__ __forceinline__ void attn_unit(LAS unsigned char* lds, const AttnP& p, const Args& a, const AttnPf& pf, AttnPf& pfn, volatile LAS unsigned* nextw, int& nx, float Bb, float Bm, int tid, int lane, int wave) {
    const int r32 = lane & 31;
    const bf16* Qw = p.Q + (size_t)(wave * 32) * p.qpitch; const bf16* Gw = p.Gt + (size_t)(wave * 32) * p.gpitch; bf16* Ow = p.O + (size_t)(wave * 32) * p.opitch;
    if constexpr (FOX) {
        const float btv = pf.btv; const float incl = wave_incl_scan(btv, lane); const float pre = incl - btv;
        const float cq0 = __shfl(pre, p.q0 >> 6) + pf.nq0;
        int t0 = 0;
#if FOX_SKIP
        const bool skip = (lane < (p.q0 >> 6)) && ((cq0 - incl) * LOG2E + 2.f * Bb < -150.f);
        t0 = __builtin_popcountll(__ballot(skip)) & ~1;
#endif
        const int qi = p.q0 + wave * 32 + r32;
        const float ci = __shfl(pre, qi >> 6) + p.nck[qi];
        const float mhat0 = (cq0 - ci) * LOG2E - fmaxf(Bb - 60.f, 0.f);
        attn64_unit<true, true>(lds, Qw, p.qpitch, p.K + (size_t)t0 * 64 * p.kpitch, p.kpitch, p.V + (size_t)t0 * 64 * p.vpitch, p.vpitch, p.nck + t0 * 64, pre, t0, cq0, mhat0, p.nt - t0,
                                Gw, p.gpitch, Ow, p.opitch, a, pfn, nextw, nx, tid, lane, wave);
    } else {
        attn64_unit<false, false>(lds, Qw, p.qpitch, p.K, p.kpitch, p.V, p.vpitch, nullptr, 0.f, 0, 0.f, -fmaxf(Bm - 60.f, 0.f), p.nt, Gw, p.gpitch, Ow, p.opitch, a, pfn, nextw, nx, tid, lane, wave);
    }
}

struct SmallP { const bf16* Q; int qpitch; const float* Kc; int kpitch; const float* Vc; int vpitch; int P; const float* lfp; const float* lfn; const bf16* Kn; const bf16* Vn; int npitch; const bf16* Gt; int gpitch; bf16* O; int opitch; };
__device__ __forceinline__ bf16x8 cvt8(const f32x4 a, const f32x4 b) { v4u w; w.x = pk2(a.x, a.y); w.y = pk2(a.z, a.w); w.z = pk2(b.x, b.y); w.w = pk2(b.z, b.w); return __builtin_bit_cast(bf16x8, w); }
constexpr int SA_M = 0, SA_L = 512, SA_O = 1024, SA_NCK = 33792;
__device__ __forceinline__ void sample_attn(LAS unsigned char* lds, const SmallP& p, int tid, int lane, int wave) {
    const int r32 = lane & 31, hi = lane >> 5, qrow = r32 & 15;
    bf16x8 qr[4];
    { const bf16* qp = p.Q + (size_t)qrow * p.qpitch;
#pragma unroll
      for (int d0 = 0; d0 < 4; ++d0) qr[d0] = *(const bf16x8*)(qp + 16 * d0 + 8 * hi); }
    f32x16 o0, o1;
#pragma unroll
    for (int r = 0; r < 16; ++r) { o0[r] = 0.f; o1[r] = 0.f; }
    float m_run = -INFINITY, l_run = 0.f;
    const int npast = p.P / 64, nt = npast + (p.Kn ? 1 : 0);
    LAS float* NCK = (LAS float*)(lds + SA_NCK);
    if (p.lfp) {
        LAS float* WTOT = (LAS float*)(lds + SA_NCK + 4608);
        __syncthreads();
        const float x0 = p.lfp[(size_t)(2 * tid) * 6], x1 = p.lfp[(size_t)(2 * tid + 1) * 6];
        const float incl = wave_incl_scan(x0 + x1, lane);
        if (lane == 63) WTOT[wave] = incl;
        __syncthreads();
        float before = 0.f, total = 0.f;
#pragma unroll
        for (int w = 0; w < 8; ++w) { const float tv = WTOT[w]; total += tv; before += (w < wave) ? tv : 0.f; }
        const float s1 = total - (before + incl);
        NCK[2 * tid + 1] = s1 * LOG2E; NCK[2 * tid] = (s1 + x1) * LOG2E;
        if (tid < 64) { float cum = 0.f; for (int i = 0; i <= tid && i < 16; ++i) cum += p.lfn[(size_t)i * 6]; NCK[1024 + tid] = (tid < 16) ? -cum * LOG2E : 0.f; }
        __syncthreads();
    }
    for (int t = wave; t < nt; t += 8) {
        const bool isnew = (t >= npast);
        f32x16 c0, c1;
        if (p.lfp) {
#pragma unroll
            for (int g = 0; g < 4; ++g) { const f32x4 a0 = *(const LAS f32x4*)(NCK + t * 64 + 8 * g + 4 * hi), a1 = *(const LAS f32x4*)(NCK + t * 64 + 32 + 8 * g + 4 * hi);
                c0[4 * g] = a0.x; c0[4 * g + 1] = a0.y; c0[4 * g + 2] = a0.z; c0[4 * g + 3] = a0.w; c1[4 * g] = a1.x; c1[4 * g + 1] = a1.y; c1[4 * g + 2] = a1.z; c1[4 * g + 3] = a1.w; }
        } else {
#pragma unroll
            for (int r = 0; r < 16; ++r) { c0[r] = 0.f; c1[r] = 0.f; }
        }
        if (!isnew) {
            const float* k0p = p.Kc + (size_t)(t * 64 + r32) * p.kpitch + 8 * hi; const float* k1p = k0p + (size_t)32 * p.kpitch;
#pragma unroll
            for (int d0 = 0; d0 < 4; ++d0) {
                const bf16x8 k0 = cvt8(*(const f32x4*)(k0p + 16 * d0), *(const f32x4*)(k0p + 16 * d0 + 4));
                const bf16x8 k1 = cvt8(*(const f32x4*)(k1p + 16 * d0), *(const f32x4*)(k1p + 16 * d0 + 4));
                c0 = __builtin_amdgcn_mfma_f32_32x32x16_bf16(k0, qr[d0], c0, 0, 0, 0);
                c1 = __builtin_amdgcn_mfma_f32_32x32x16_bf16(k1, qr[d0], c1, 0, 0, 0);
            }
        } else {
            const bf16* k0p = p.Kn + (size_t)(r32 & 15) * p.npitch + 8 * hi;
#pragma unroll
            for (int d0 = 0; d0 < 4; ++d0) {
                const bf16x8 k0 = *(const bf16x8*)(k0p + 16 * d0);
                c0 = __builtin_amdgcn_mfma_f32_32x32x16_bf16(k0, qr[d0], c0, 0, 0, 0);
            }
#pragma unroll
            for (int r = 0; r < 16; ++r) { const int kv = 4 * hi + (r & 3) + 8 * (r >> 2); if (kv > qrow) c0[r] = -INFINITY; c1[r] = -INFINITY; }
        }
        float mx = fmaxf(c0[0], c1[0]);
#pragma unroll
        for (int r = 1; r < 16; ++r) mx = fmaxf(mx, fmaxf(c0[r], c1[r]));
        mx = fmaxf(mx, __shfl_xor(mx, 32));
        const float mn = fmaxf(m_run, mx);
        const float alpha = __builtin_amdgcn_exp2f(m_run - mn);
        m_run = mn;
        float sum = 0.f;
#pragma unroll
        for (int r = 0; r < 16; ++r) { c0[r] = __builtin_amdgcn_exp2f(c0[r] - mn); c1[r] = __builtin_amdgcn_exp2f(c1[r] - mn); sum += c0[r] + c1[r]; }
        l_run = l_run * alpha + sum;
#pragma unroll
        for (int r = 0; r < 8; ++r) { const float al = __shfl(alpha, crow(r, hi)); o0[r] *= al; o1[r] *= al; }
#pragma unroll
        for (int blk = 0; blk < 2; ++blk) {
            if (isnew && blk == 1) break;
#pragma unroll
            for (int s = 0; s < 2; ++s) {
                v4u pw;
                if (blk == 0) { pw.x = pk2(c0[8 * s], c0[8 * s + 1]); pw.y = pk2(c0[8 * s + 2], c0[8 * s + 3]); pw.z = pk2(c0[8 * s + 4], c0[8 * s + 5]); pw.w = pk2(c0[8 * s + 6], c0[8 * s + 7]); }
                else          { pw.x = pk2(c1[8 * s], c1[8 * s + 1]); pw.y = pk2(c1[8 * s + 2], c1[8 * s + 3]); pw.z = pk2(c1[8 * s + 4], c1[8 * s + 5]); pw.w = pk2(c1[8 * s + 6], c1[8 * s + 7]); }
                const bf16x8 pa = __builtin_bit_cast(bf16x8, pw);
                float va[8], vb[8];
#pragma unroll
                for (int j = 0; j < 8; ++j) { const int kvl = 32 * blk + 16 * s + 8 * (j >> 2) + 4 * hi + (j & 3);
                    if (!isnew) { const float* vp = p.Vc + (size_t)(t * 64 + kvl) * p.vpitch; va[j] = vp[r32]; vb[j] = vp[32 + r32]; }
                    else { const bf16* vp = p.Vn + (size_t)(kvl & 15) * p.npitch; va[j] = bf2f(vp[r32]); vb[j] = bf2f(vp[32 + r32]); } }
                const bf16x8 v0 = cvt8((f32x4){va[0], va[1], va[2], va[3]}, (f32x4){va[4], va[5], va[6], va[7]});
                const bf16x8 v1 = cvt8((f32x4){vb[0], vb[1], vb[2], vb[3]}, (f32x4){vb[4], vb[5], vb[6], vb[7]});
                o0 = __builtin_amdgcn_mfma_f32_32x32x16_bf16(pa, v0, o0, 0, 0, 0);
                o1 = __builtin_amdgcn_mfma_f32_32x32x16_bf16(pa, v1, o1, 0, 0, 0);
            }
        }
    }
    l_run += __shfl_xor(l_run, 32);
    LAS float* MW = (LAS float*)(lds + SA_M); LAS float* LW = (LAS float*)(lds + SA_L); LAS float* OW = (LAS float*)(lds + SA_O);
    __syncthreads();
    if (lane < 16) { MW[wave * 16 + lane] = m_run; LW[wave * 16 + lane] = l_run; }
#pragma unroll
    for (int r = 0; r < 8; ++r) { const int q = crow(r, hi); OW[(wave * 16 + q) * 64 + r32] = o0[r]; OW[(wave * 16 + q) * 64 + 32 + r32] = o1[r]; }
    __syncthreads();
    { const int q = tid >> 5, d = tid & 31;
      float M = MW[q];
#pragma unroll
      for (int w = 1; w < 8; ++w) M = fmaxf(M, MW[w * 16 + q]);
      float L = 0.f, a0 = 0.f, a1 = 0.f;
#pragma unroll
      for (int w = 0; w < 8; ++w) { const float f = __builtin_amdgcn_exp2f(MW[w * 16 + q] - M); L += f * LW[w * 16 + q]; a0 += f * OW[(w * 16 + q) * 64 + d]; a1 += f * OW[(w * 16 + q) * 64 + 32 + d]; }
      const float g0 = bf2f(p.Gt[(size_t)q * p.gpitch + d]), g1 = bf2f(p.Gt[(size_t)q * p.gpitch + 32 + d]);
      p.O[(size_t)q * p.opitch + d] = (bf16)f2bf(a0 / L * siluf(g0)); p.O[(size_t)q * p.opitch + 32 + d] = (bf16)f2bf(a1 / L * siluf(g1)); }
}

constexpr int RW_R = 0, RW_W = 16384, RW_KT = 32768, RW_V = 49152, RW_KK = 65536, RW_KA = 81920, RW_G = 98304, RW_X = 114688;
struct RwkvP { const bf16* Hs; bf16* Os; int T; int h; const float* s0; const float* prev0; float* s_out; float* sh_out; };
__device__ __forceinline__ void rwkv_task(LAS unsigned char* lds, const Args& a, const RwkvP& p, int tid) {
    LAS float* AR = (LAS float*)(lds + RW_R); LAS float* AW = (LAS float*)(lds + RW_W); LAS float* AKT = (LAS float*)(lds + RW_KT); LAS float* AV = (LAS float*)(lds + RW_V);
    LAS float* AKK = (LAS float*)(lds + RW_KK); LAS float* AKA = (LAS float*)(lds + RW_KA); LAS float* AG = (LAS float*)(lds + RW_G); LAS float* AX = (LAS float*)(lds + RW_X);
    const int tt = tid >> 3, e8 = (tid & 7) * 8, h = p.h;
    const float* mu = a.in[I_MU];
    float S[8];
    if (p.s0) {
#pragma unroll
        for (int e = 0; e < 8; ++e) S[e] = p.s0[tt * 64 + e8 + e];
    } else {
#pragma unroll
        for (int e = 0; e < 8; ++e) S[e] = 0.f;
    }
    for (int c0 = 0; c0 < p.T; c0 += 64) {
        const int n = (p.T - c0) < 64 ? (p.T - c0) : 64;
        const bool act = tt < n; const int trow = c0 + tt;
        const bf16* cur = p.Hs + (size_t)trow * NP; const bf16* prv = cur - NP; const bool first = (trow == 0);
        if (act) {
#pragma unroll
            for (int e = 0; e < 8; ++e) { const int col = e8 + e; const float c = bf2f(cur[HC_WD + col]);
                const float pv = first ? (p.prev0 ? p.prev0[1152 + col] : 0.f) : bf2f(prv[HC_WD + col]);
                const float xs = c + (pv - c) * mu[1152 + col];
                AX[tt * 64 + col] = (col < 32) ? ftanh(xs) : xs; }
        }
        __syncthreads();
        if (act) {
            float lw[8], la[8];
            { const f32x4 w0a = *(const f32x4*)(a.in[I_W0] + h * 64 + e8), w0b = *(const f32x4*)(a.in[I_W0] + h * 64 + e8 + 4);
              const f32x4 a0a = *(const f32x4*)(a.in[I_A0] + h * 64 + e8), a0b = *(const f32x4*)(a.in[I_A0] + h * 64 + e8 + 4);
              lw[0] = w0a.x; lw[1] = w0a.y; lw[2] = w0a.z; lw[3] = w0a.w; lw[4] = w0b.x; lw[5] = w0b.y; lw[6] = w0b.z; lw[7] = w0b.w;
              la[0] = a0a.x; la[1] = a0a.y; la[2] = a0a.z; la[3] = a0a.w; la[4] = a0b.x; la[5] = a0b.y; la[6] = a0b.z; la[7] = a0b.w; }
#pragma unroll 2
            for (int j = 0; j < 32; ++j) {
                const float tw = AX[tt * 64 + j], ta = AX[tt * 64 + 32 + j];
                const f32x4 u0 = *(const f32x4*)(a.in[I_WUP] + j * 384 + h * 64 + e8), u1 = *(const f32x4*)(a.in[I_WUP] + j * 384 + h * 64 + e8 + 4);
                const f32x4 p0 = *(const f32x4*)(a.in[I_AUP] + j * 384 + h * 64 + e8), p1 = *(const f32x4*)(a.in[I_AUP] + j * 384 + h * 64 + e8 + 4);
                lw[0] += tw * u0.x; lw[1] += tw * u0.y; lw[2] += tw * u0.z; lw[3] += tw * u0.w; lw[4] += tw * u1.x; lw[5] += tw * u1.y; lw[6] += tw * u1.z; lw[7] += tw * u1.w;
                la[0] += ta * p0.x; la[1] += ta * p0.y; la[2] += ta * p0.z; la[3] += ta * p0.w; la[4] += ta * p1.x; la[5] += ta * p1.y; la[6] += ta * p1.z; la[7] += ta * p1.w;
            }
            float kk[8], aa[8]; float ss = 0.f;
            const int c8 = h * 64 + e8;
            float rs[8], ks[8], vs[8], gs[8];
            { float cu[8], pv[8], mm[8];
#define RW_SHIFT(dst, HC, MUOFF) do { unpack8(*(const v4u*)(cur + (HC) + c8), cu); \
                if (first) { if (p.prev0) ld8(p.prev0 + (MUOFF) + c8, pv); else { _Pragma("unroll") for (int e = 0; e < 8; ++e) pv[e] = 0.f; } } \
                else unpack8(*(const v4u*)(prv + (HC) + c8), pv); \
                ld8(mu + (MUOFF) + c8, mm); \
                _Pragma("unroll") for (int e = 0; e < 8; ++e) dst[e] = cu[e] + (pv[e] - cu[e]) * mm[e]; } while (0)
              RW_SHIFT(rs, HC_RR, 0); RW_SHIFT(ks, HC_RK, 384); RW_SHIFT(vs, HC_RV, 768); RW_SHIFT(gs, HC_RG, 1216);
#undef RW_SHIFT
            }
            float kkw[8], kaw[8];
            ld8(a.in[I_KK] + c8, kkw); ld8(a.in[I_KA] + c8, kaw);
#pragma unroll
            for (int e = 0; e < 8; ++e) { const int d = e8 + e;
                const float wraw = -softplusf(-lw[e]) - 0.5f; const float dec = fexp(-fexp(wraw));
                const float av = sigmf(la[e]);
                kk[e] = ks[e] * kkw[e]; ss += kk[e] * kk[e]; aa[e] = av;
                AR[tt * 64 + d] = rs[e]; AW[tt * 64 + d] = dec; AKT[tt * 64 + d] = ks[e] * (1.f + (av - 1.f) * kaw[e]); AV[tt * 64 + d] = vs[e]; AG[tt * 64 + d] = gs[e];
            }
            ss = sum8(ss); const float rn = frsq(fmaxf(ss, 1e-24f));
#pragma unroll
            for (int e = 0; e < 8; ++e) { const float k2 = kk[e] * rn; AKK[tt * 64 + e8 + e] = k2; AKA[tt * 64 + e8 + e] = k2 * aa[e]; }
        }
        __syncthreads();
        for (int t = 0; t < n; ++t) {
            const f32x4 k0 = *(const LAS f32x4*)(AKK + t * 64 + e8), k1 = *(const LAS f32x4*)(AKK + t * 64 + e8 + 4);
            const f32x4 w0 = *(const LAS f32x4*)(AW + t * 64 + e8), w1 = *(const LAS f32x4*)(AW + t * 64 + e8 + 4);
            const f32x4 b0 = *(const LAS f32x4*)(AKA + t * 64 + e8), b1 = *(const LAS f32x4*)(AKA + t * 64 + e8 + 4);
            const f32x4 x0 = *(const LAS f32x4*)(AKT + t * 64 + e8), x1 = *(const LAS f32x4*)(AKT + t * 64 + e8 + 4);
            const f32x4 r0 = *(const LAS f32x4*)(AR + t * 64 + e8), r1 = *(const LAS f32x4*)(AR + t * 64 + e8 + 4);
            const float vv = AV[t * 64 + tt];
            float sa = S[0] * k0.x + S[1] * k0.y + S[2] * k0.z + S[3] * k0.w + S[4] * k1.x + S[5] * k1.y + S[6] * k1.z + S[7] * k1.w;
            sa = -sum8(sa);
            S[0] = S[0] * w0.x + sa * b0.x + vv * x0.x; S[1] = S[1] * w0.y + sa * b0.y + vv * x0.y; S[2] = S[2] * w0.z + sa * b0.z + vv * x0.z; S[3] = S[3] * w0.w + sa * b0.w + vv * x0.w;
            S[4] = S[4] * w1.x + sa * b1.x + vv * x1.x; S[5] = S[5] * w1.y + sa * b1.y + vv * x1.y; S[6] = S[6] * w1.z + sa * b1.z + vv * x1.z; S[7] = S[7] * w1.w + sa * b1.w + vv * x1.w;
            float y = S[0] * r0.x + S[1] * r0.y + S[2] * r0.z + S[3] * r0.w + S[4] * r1.x + S[5] * r1.y + S[6] * r1.z + S[7] * r1.w;
            y = sum8(y);
            if ((tid & 7) == 0) AX[t * 64 + tt] = y;
        }
        __syncthreads();
        {
            float y[8], sm = 0.f, bn = 0.f;
#pragma unroll
            for (int e = 0; e < 8; ++e) { y[e] = AX[tt * 64 + e8 + e]; sm += y[e]; bn += AR[tt * 64 + e8 + e] * AKT[tt * 64 + e8 + e] * a.in[I_RK][h * 64 + e8 + e]; }
            sm = sum8(sm) * (1.f / 64.f); bn = sum8(bn);
            float var = 0.f;
#pragma unroll
            for (int e = 0; e < 8; ++e) { const float d = y[e] - sm; var += d * d; }
            var = sum8(var) * (1.f / 64.f);
            const float rstd = frsq(var + GN_EPS);
            if (act) {
                v4u o; unsigned w[4];
#pragma unroll
                for (int e = 0; e < 8; e += 2) { const int c = h * 64 + e8 + e;
                    const float o0 = ((y[e] - sm) * rstd * a.in[I_GNW][c] + a.in[I_GNB][c] + bn * AV[tt * 64 + e8 + e]) * siluf(AG[tt * 64 + e8 + e]);
                    const float o1 = ((y[e + 1] - sm) * rstd * a.in[I_GNW][c + 1] + a.in[I_GNB][c + 1] + bn * AV[tt * 64 + e8 + e + 1]) * siluf(AG[tt * 64 + e8 + e + 1]);
                    w[e >> 1] = pk2(o0, o1); }
                o.x = w[0]; o.y = w[1]; o.z = w[2]; o.w = w[3];
                *(v4u*)(p.Os + (size_t)trow * DM + 384 + h * 64 + e8) = o;
            }
        }
        __syncthreads();
    }
#pragma unroll
    for (int e = 0; e < 8; ++e) p.s_out[tt * 64 + e8 + e] = S[e];
    if (p.sh_out) { const bf16* last = p.Hs + (size_t)(p.T - 1) * NP;
        for (int m = tid; m < 1600; m += 512) { const int c = (m < 1152) ? HC_RR + m : (m < 1184) ? HC_WD + (m - 1152) : (m < 1216) ? HC_AD + (m - 1184) : HC_RG + (m - 1216);
            p.sh_out[m] = bf2f(last[c]); } }
}


constexpr int NCH = SEQ / 64;
constexpr int NTASK_RWC = BATCH * 6 * NCH;
constexpr size_t WS_QE = 344 * MiB;
constexpr size_t WS_YL = WS_QE + (size_t)NTASK_RWC * 8192;
constexpr size_t WS_PT = WS_YL + (size_t)NTASK_RWC * 8192;
constexpr size_t WS_SC = WS_PT + (size_t)NTASK_RWC * 8192;
constexpr size_t WS_SL = WS_SC + (size_t)NTASK_RWC * 8192;
constexpr size_t WS_BON = WS_SL + (size_t)NTASK_RWC * 16384;
constexpr size_t WS_END2 = WS_BON + (size_t)NTASK_RWC * 256;
static_assert(WS_END2 <= 512 * MiB, "d_ws map (chunked RWKV)");

constexpr int LC_AX = 0, LC_G = 16384, LC_AT = 32768, LC_M0 = 49152, LC_MS = 9216, LC_GAM = LC_M0 + 10 * LC_MS;
#define LC_M(i) (LC_M0 + (i) * LC_MS)
typedef float f32x4v __attribute__((ext_vector_type(4)));

__device__ __forceinline__ void mm_nt(f32x4 (&acc)[2], const LAS unsigned char* X, const LAS unsigned char* Y, int bi, int bj0, int fr, int fq) {
#pragma unroll
    for (int ks = 0; ks < 2; ++ks) {
        const bf16x8 a = *(const LAS bf16x8*)(X + (16 * bi + fr) * 144 + 64 * ks + 16 * fq);
#pragma unroll
        for (int n = 0; n < 2; ++n) {
            const bf16x8 b = *(const LAS bf16x8*)(Y + (16 * (bj0 + n) + fr) * 144 + 64 * ks + 16 * fq);
            acc[n] = __builtin_amdgcn_mfma_f32_16x16x32_bf16(a, b, acc[n], 0, 0, 0);
        }
    }
}
#define ACC_ZERO(a) do { a[0] = (f32x4){0.f, 0.f, 0.f, 0.f}; a[1] = (f32x4){0.f, 0.f, 0.f, 0.f}; } while (0)
__device__ __forceinline__ void st_bf16_tile(LAS unsigned char* M, const f32x4 (&acc)[2], int bi, int bj0, int fr, int fq) {
#pragma unroll
    for (int n = 0; n < 2; ++n)
#pragma unroll
        for (int rg = 0; rg < 4; ++rg) *(LAS unsigned short*)(M + (16 * bi + 4 * fq + rg) * 144 + (16 * (bj0 + n) + fr) * 2) = (unsigned short)f2bf(acc[n][rg]);
}
__device__ __forceinline__ void copy_tile_bf16(bf16* dst, const LAS unsigned char* M, int tid) {
    const int row = tid >> 3, pc = tid & 7;
    *(v4u*)(dst + row * 64 + pc * 8) = *(const LAS v4u*)(M + row * 144 + pc * 16);
}

struct RwcP { const bf16* Hs; int h; int c0; size_t task; };
constexpr int RWC_Q0 = MT / 64 + BATCH * NMEM / 64;
struct RwcIn { v4u wdc, wdp, rc, rp, kc, kp, vc, vp; f32x4 wu, au; };
__device__ __forceinline__ void rwkv_local_load(RwcIn& in, const Args& a, const RwcP& p, int tid) {
    const int tt = tid >> 3, e8 = (tid & 7) * 8, c8 = p.h * 64 + e8; const int trow = p.c0 + tt;
    const bf16* cur = p.Hs + (size_t)trow * NP; const bf16* prv = (trow == 0) ? cur : cur - NP;
    in.wdc = *(const v4u*)(cur + HC_WD + e8); in.wdp = *(const v4u*)(prv + HC_WD + e8);
    in.rc = *(const v4u*)(cur + HC_RR + c8); in.rp = *(const v4u*)(prv + HC_RR + c8);
    in.kc = *(const v4u*)(cur + HC_RK + c8); in.kp = *(const v4u*)(prv + HC_RK + c8);
    in.vc = *(const v4u*)(cur + HC_RV + c8); in.vp = *(const v4u*)(prv + HC_RV + c8);
    const int j = tid >> 4, c4 = (tid & 15) * 4;
    in.wu = *(const f32x4*)(a.in[I_WUP] + j * 384 + p.h * 64 + c4); in.au = *(const f32x4*)(a.in[I_AUP] + j * 384 + p.h * 64 + c4);
}
__device__ __forceinline__ void rwkv_local_task(LAS unsigned char* lds, const Args& a, const RwcP& p, const RwcIn& in, RwcIn& nxt, volatile LAS unsigned* nextw, int& nx, bool& has_next, int tid, int lane, int wave) {
    asm volatile("" : "+v"(tid), "+v"(lane));
    LAS float* AX = (LAS float*)(lds + LC_AX); LAS float* G = (LAS float*)(lds + LC_G); LAS float* AT = (LAS float*)(lds + LC_AT); LAS float* GAM = (LAS float*)(lds + LC_GAM);
    const int tt = tid >> 3, e8 = (tid & 7) * 8, h = p.h, c8 = h * 64 + e8;
    const float* mu = a.in[I_MU];
    const int trow = p.c0 + tt; const bool first = (trow == 0);
    {
        { const int j = tid >> 4, c4 = (tid & 15) * 4; LAS unsigned short* ww = (LAS unsigned short*)(lds + LC_AT) + c4 * 40 + j; LAS unsigned short* wa = ww + 64 * 40;
          ww[0] = (unsigned short)f2bf(in.wu.x); ww[40] = (unsigned short)f2bf(in.wu.y); ww[80] = (unsigned short)f2bf(in.wu.z); ww[120] = (unsigned short)f2bf(in.wu.w);
          wa[0] = (unsigned short)f2bf(in.au.x); wa[40] = (unsigned short)f2bf(in.au.y); wa[80] = (unsigned short)f2bf(in.au.z); wa[120] = (unsigned short)f2bf(in.au.w); }
        float cu[8], pv[8], mm[8];
        unpack8(in.wdc, cu); unpack8(in.wdp, pv);
        if (first) { _Pragma("unroll") for (int e = 0; e < 8; ++e) pv[e] = 0.f; }
        ld8(mu + 1152 + e8, mm);
        float xs[8];
#pragma unroll
        for (int e = 0; e < 8; ++e) { xs[e] = cu[e] + (pv[e] - cu[e]) * mm[e]; if (e8 < 32) xs[e] = ftanh(xs[e]); }
        v4u w_; w_.x = pk2(xs[0], xs[1]); w_.y = pk2(xs[2], xs[3]); w_.z = pk2(xs[4], xs[5]); w_.w = pk2(xs[6], xs[7]);
        *(LAS v4u*)(lds + LC_AX + (e8 < 32 ? 0 : 5120) + tt * 80 + (e8 & 31) * 2) = w_;
    }
    __syncthreads();
    {
        const int bi_ = wave >> 1, bj_ = 2 * (wave & 1), fr_ = lane & 15, fq_ = lane >> 4;
        const bf16x8 xw = *(const LAS bf16x8*)(lds + LC_AX + (16 * bi_ + fr_) * 80 + 16 * fq_), xa = *(const LAS bf16x8*)(lds + LC_AX + 5120 + (16 * bi_ + fr_) * 80 + 16 * fq_);
        LAS float* LAO = (LAS float*)(lds + LC_M(8));
#pragma unroll
        for (int n = 0; n < 2; ++n) {
            const bf16x8 bw = *(const LAS bf16x8*)(lds + LC_AT + (16 * (bj_ + n) + fr_) * 80 + 16 * fq_), ba = *(const LAS bf16x8*)(lds + LC_AT + 5120 + (16 * (bj_ + n) + fr_) * 80 + 16 * fq_);
            f32x4 cw = {0.f, 0.f, 0.f, 0.f}, ca = {0.f, 0.f, 0.f, 0.f};
            cw = __builtin_amdgcn_mfma_f32_16x16x32_bf16(xw, bw, cw, 0, 0, 0); ca = __builtin_amdgcn_mfma_f32_16x16x32_bf16(xa, ba, ca, 0, 0, 0);
#pragma unroll
            for (int rg = 0; rg < 4; ++rg) { G[(16 * bi_ + 4 * fq_ + rg) * 64 + 16 * (bj_ + n) + fr_] = cw[rg]; LAO[(16 * bi_ + 4 * fq_ + rg) * 64 + 16 * (bj_ + n) + fr_] = ca[rg]; }
        }
    }
    __syncthreads();
    float rs[8], ks[8], vs[8], kk[8], be[8], lwv[8];
    {
        float lw[8], la[8];
        { float t8[8]; ld8(a.in[I_W0] + c8, lw); ld8(a.in[I_A0] + c8, la);
          const f32x4 g0 = *(const LAS f32x4*)(G + tt * 64 + e8), g1 = *(const LAS f32x4*)(G + tt * 64 + e8 + 4);
          const f32x4 h0 = *(const LAS f32x4*)((LAS float*)(lds + LC_M(8)) + tt * 64 + e8), h1 = *(const LAS f32x4*)((LAS float*)(lds + LC_M(8)) + tt * 64 + e8 + 4);
          lw[0] += g0.x; lw[1] += g0.y; lw[2] += g0.z; lw[3] += g0.w; lw[4] += g1.x; lw[5] += g1.y; lw[6] += g1.z; lw[7] += g1.w;
          la[0] += h0.x; la[1] += h0.y; la[2] += h0.z; la[3] += h0.w; la[4] += h1.x; la[5] += h1.y; la[6] += h1.z; la[7] += h1.w; (void)t8; }
        { float cu[8], pv[8], mm[8];
#define RW_SHIFT(dst, CW, PW, MUOFF) do { unpack8(CW, cu); unpack8(PW, pv); \
            if (first) { _Pragma("unroll") for (int e = 0; e < 8; ++e) pv[e] = 0.f; } \
            ld8(mu + (MUOFF) + c8, mm); \
            _Pragma("unroll") for (int e = 0; e < 8; ++e) dst[e] = cu[e] + (pv[e] - cu[e]) * mm[e]; } while (0)
          RW_SHIFT(rs, in.rc, in.rp, 0); RW_SHIFT(ks, in.kc, in.kp, 384); RW_SHIFT(vs, in.vc, in.vp, 768);
#undef RW_SHIFT
        }
        float kkw[8], kaw[8], rkw[8]; ld8(a.in[I_KK] + c8, kkw); ld8(a.in[I_KA] + c8, kaw); ld8(a.in[I_RK] + c8, rkw);
        float ss = 0.f, bn = 0.f;
#pragma unroll
        for (int e = 0; e < 8; ++e) {
            const float wraw = -softplusf(-lw[e]) - 0.5f; lwv[e] = -fexp(wraw);
            const float av = sigmf(la[e]);
            kk[e] = ks[e] * kkw[e]; ss += kk[e] * kk[e]; be[e] = av;
            ks[e] = ks[e] * (1.f + (av - 1.f) * kaw[e]);
            bn += rs[e] * ks[e] * rkw[e];
        }
        ss = sum8(ss); bn = sum8(bn); const float rn = frsq(fmaxf(ss, 1e-24f));
#pragma unroll
        for (int e = 0; e < 8; ++e) { kk[e] *= rn; be[e] *= kk[e]; }
        if ((tid & 7) == 0) ((float*)(a.ws + WS_BON))[p.task * 64 + tt] = bn;
        *(LAS f32x4*)(G + tt * 64 + e8) = (f32x4){lwv[0], lwv[1], lwv[2], lwv[3]}; *(LAS f32x4*)(G + tt * 64 + e8 + 4) = (f32x4){lwv[4], lwv[5], lwv[6], lwv[7]};
    }
    nx = (int)*nextw; has_next = (nx >= RWC_Q0) && (nx < RWC_Q0 + NTASK_RWC);
    if (has_next) { const int t2 = nx - RWC_Q0, bh2 = t2 / NCH; const RwcP pn{(const bf16*)(a.ws + WS_H) + (size_t)(bh2 / 6) * SEQ * NP, bh2 % 6, (t2 % NCH) * 64, (size_t)t2}; rwkv_local_load(nxt, a, pn, tid); }
    __syncthreads();
    { const int d = tid & 63, sg = tid >> 6; float loc[8]; float run = 0.f;
#pragma unroll
      for (int i = 0; i < 8; ++i) { run += G[(8 * sg + i) * 64 + d]; loc[i] = run; }
      AX[sg * 64 + d] = run;
      __syncthreads();
      float pre = 0.f;
#pragma unroll
      for (int j = 0; j < 8; ++j) { const float sv = AX[j * 64 + d]; pre += (j < sg) ? sv : 0.f; }
#pragma unroll
      for (int i = 0; i < 8; ++i) G[(8 * sg + i) * 64 + d] = pre + loc[i];
    }
    __syncthreads();
    {
        float g[8], gm[8], g63[8];
        { const f32x4 x0 = *(const LAS f32x4*)(G + tt * 64 + e8), x1 = *(const LAS f32x4*)(G + tt * 64 + e8 + 4);
          g[0] = x0.x; g[1] = x0.y; g[2] = x0.z; g[3] = x0.w; g[4] = x1.x; g[5] = x1.y; g[6] = x1.z; g[7] = x1.w; }
        { const f32x4 x0 = *(const LAS f32x4*)(G + 63 * 64 + e8), x1 = *(const LAS f32x4*)(G + 63 * 64 + e8 + 4);
          g63[0] = x0.x; g63[1] = x0.y; g63[2] = x0.z; g63[3] = x0.w; g63[4] = x1.x; g63[5] = x1.y; g63[6] = x1.z; g63[7] = x1.w; }
#pragma unroll
        for (int e = 0; e < 8; ++e) gm[e] = g[e] - lwv[e];
        float at[8], qt[8], bh[8], kh[8], bb[8], kb[8];
#pragma unroll
        for (int e = 0; e < 8; ++e) { const float e1 = fexp(gm[e]), e2 = fexp(g[e]), e3 = fexp(-g[e]), e4 = fexp(g63[e] - g[e]);
            at[e] = -kk[e] * e1; qt[e] = rs[e] * e2; bh[e] = be[e] * e3; kh[e] = ks[e] * e3; bb[e] = be[e] * e4; kb[e] = ks[e] * e4; }
        *(LAS f32x4*)(AT + tt * 64 + e8) = (f32x4){at[0], at[1], at[2], at[3]}; *(LAS f32x4*)(AT + tt * 64 + e8 + 4) = (f32x4){at[4], at[5], at[6], at[7]};
#define ST8(i, arr) do { v4u w_; w_.x = pk2(arr[0], arr[1]); w_.y = pk2(arr[2], arr[3]); w_.z = pk2(arr[4], arr[5]); w_.w = pk2(arr[6], arr[7]); *(LAS v4u*)(lds + LC_M(i) + tt * 144 + e8 * 2) = w_; } while (0)
        ST8(0, at); ST8(1, qt); ST8(2, bh); ST8(3, kh);
#undef ST8
#pragma unroll
        for (int e = 0; e < 8; ++e) {
            *(LAS unsigned short*)(lds + LC_M(4) + (e8 + e) * 144 + tt * 2) = (unsigned short)f2bf(bb[e]);
            *(LAS unsigned short*)(lds + LC_M(5) + (e8 + e) * 144 + tt * 2) = (unsigned short)f2bf(kb[e]);
            *(LAS unsigned short*)(lds + LC_M(6) + (e8 + e) * 144 + tt * 2) = (unsigned short)f2bf(vs[e]);
        }
        if (tt == 63) {
#pragma unroll
            for (int e = 0; e < 8; ++e) GAM[e8 + e] = fexp(g63[e]);
        }
    }
    __syncthreads();
    const int bi = wave >> 1, bj0 = 2 * (wave & 1), fr = lane & 15, fq = lane >> 4;
    {
        f32x4 cab[2], cak[2], cqb[2], cqk[2]; ACC_ZERO(cab); ACC_ZERO(cak); ACC_ZERO(cqb); ACC_ZERO(cqk);
        mm_nt(cab, lds + LC_M(0), lds + LC_M(2), bi, bj0, fr, fq); mm_nt(cak, lds + LC_M(0), lds + LC_M(3), bi, bj0, fr, fq);
        mm_nt(cqb, lds + LC_M(1), lds + LC_M(2), bi, bj0, fr, fq); mm_nt(cqk, lds + LC_M(1), lds + LC_M(3), bi, bj0, fr, fq);
#pragma unroll
        for (int n = 0; n < 2; ++n)
#pragma unroll
            for (int rg = 0; rg < 4; ++rg) { const int t = 16 * bi + 4 * fq + rg, s = 16 * (bj0 + n) + fr;
                cab[n][rg] = (s < t) ? cab[n][rg] : 0.f;
                AX[s * 64 + t] = cab[n][rg];
                *(LAS unsigned short*)(lds + LC_M(7) + t * 144 + s * 2) = (unsigned short)f2bf((s < t) ? cak[n][rg] : 0.f);
                *(LAS unsigned short*)(lds + LC_M(8) + t * 144 + s * 2) = (unsigned short)f2bf((s <= t) ? cqb[n][rg] : 0.f);
                *(LAS unsigned short*)(lds + LC_M(9) + t * 144 + s * 2) = (unsigned short)f2bf((s <= t) ? cqk[n][rg] : 0.f); }
        __syncthreads();
        st_bf16_tile(lds + LC_M(0), cab, bi, bj0, fr, fq);
        { const v4u z = {0u, 0u, 0u, 0u};
          *(LAS v4u*)(lds + LC_M(2) + tid * 16) = z; *(LAS v4u*)(lds + LC_M(3) + tid * 16) = z;
          if (tid < 64) { *(LAS v4u*)(lds + LC_M(2) + 8192 + tid * 16) = z; *(LAS v4u*)(lds + LC_M(3) + 8192 + tid * 16) = z; } }
    }
    {
        f32x4 c[2]; ACC_ZERO(c); mm_nt(c, lds + LC_M(7), lds + LC_M(6), bi, bj0, fr, fq);
#pragma unroll
        for (int n = 0; n < 2; ++n)
#pragma unroll
            for (int rg = 0; rg < 4; ++rg) G[(16 * bi + 4 * fq + rg) * 64 + 16 * (bj0 + n) + fr] = c[n][rg];
    }
    __syncthreads();
    {
        LAS float* R = (tid < 64) ? AT : G; const int col = tid & 63;
        LAS unsigned char* XT = lds + ((tid < 64) ? LC_M(2) : LC_M(3)) + col * 144;
#pragma unroll
        for (int b4 = 0; b4 < 4; ++b4) {
            if (b4 > 0) {
                f32x4 acc = {0.f, 0.f, 0.f, 0.f};
                const LAS unsigned char* Yb = lds + ((wave < 4) ? LC_M(2) : LC_M(3)) + (16 * (wave & 3) + fr) * 144;
#pragma unroll
                for (int ks = 0; ks < (b4 + 1) / 2; ++ks) {
                    const bf16x8 av = *(const LAS bf16x8*)(lds + LC_M(0) + (16 * b4 + fr) * 144 + 64 * ks + 16 * fq);
                    const bf16x8 bv = *(const LAS bf16x8*)(Yb + 64 * ks + 16 * fq);
                    acc = __builtin_amdgcn_mfma_f32_16x16x32_bf16(av, bv, acc, 0, 0, 0);
                }
                LAS float* Rw = ((wave < 4) ? AT : G) + 16 * (wave & 3) + fr;
#pragma unroll
                for (int rg = 0; rg < 4; ++rg) Rw[(16 * b4 + 4 * fq + rg) * 64] += acc[rg];
                __syncthreads();
            }
            if (tid < 128) {
                float r[16];
#pragma unroll
                for (int i = 0; i < 16; ++i) r[i] = R[(16 * b4 + i) * 64 + col];
#pragma unroll
                for (int j = 0; j < 15; ++j) {
#pragma unroll
                    for (int i4 = (j + 1) / 4; i4 < 4; ++i4) { const f32x4 a4 = *(const LAS f32x4*)(AX + (16 * b4 + j) * 64 + 16 * b4 + 4 * i4);
                        if (4 * i4 > j) r[4 * i4] += a4.x * r[j]; if (4 * i4 + 1 > j) r[4 * i4 + 1] += a4.y * r[j]; if (4 * i4 + 2 > j) r[4 * i4 + 2] += a4.z * r[j]; if (4 * i4 + 3 > j) r[4 * i4 + 3] += a4.w * r[j]; }
                }
                v4u w0, w1; w0.x = pk2(r[0], r[1]); w0.y = pk2(r[2], r[3]); w0.z = pk2(r[4], r[5]); w0.w = pk2(r[6], r[7]);
                w1.x = pk2(r[8], r[9]); w1.y = pk2(r[10], r[11]); w1.z = pk2(r[12], r[13]); w1.w = pk2(r[14], r[15]);
                *(LAS v4u*)(XT + 32 * b4) = w0; *(LAS v4u*)(XT + 32 * b4 + 16) = w1;
            }
            __syncthreads();
        }
    }
    {
        const LAS unsigned char* WT = lds + LC_M(2); const LAS unsigned char* WUT = lds + LC_M(3);
        f32x4 c[2];
#pragma unroll
        for (int n = 0; n < 2; ++n)
#pragma unroll
            for (int rg = 0; rg < 4; ++rg) c[n][rg] = bf2f(*(const LAS unsigned short*)(lds + LC_M(1) + (16 * bi + 4 * fq + rg) * 144 + (16 * (bj0 + n) + fr) * 2));
        mm_nt(c, lds + LC_M(8), WT, bi, bj0, fr, fq);
        st_bf16_tile(lds + LC_G, c, bi, bj0, fr, fq);
        ACC_ZERO(c); mm_nt(c, lds + LC_M(8), WUT, bi, bj0, fr, fq); mm_nt(c, lds + LC_M(9), lds + LC_M(6), bi, bj0, fr, fq);
        st_bf16_tile(lds + LC_AT, c, bi, bj0, fr, fq);
        ACC_ZERO(c); mm_nt(c, lds + LC_M(4), WT, bi, bj0, fr, fq);
#pragma unroll
        for (int n = 0; n < 2; ++n)
#pragma unroll
            for (int rg = 0; rg < 4; ++rg) { const int kp = 16 * bi + 4 * fq + rg, k = 16 * (bj0 + n) + fr; if (kp == k) c[n][rg] += GAM[k]; }
        st_bf16_tile(lds + LC_M(0), c, bi, bj0, fr, fq);
        ACC_ZERO(c); mm_nt(c, WUT, lds + LC_M(4), bi, bj0, fr, fq); mm_nt(c, lds + LC_M(6), lds + LC_M(5), bi, bj0, fr, fq);
#pragma unroll
        for (int n = 0; n < 2; ++n)
#pragma unroll
            for (int rg = 0; rg < 4; ++rg) AX[(16 * bi + 4 * fq + rg) * 64 + 16 * (bj0 + n) + fr] = c[n][rg];
    }
    __syncthreads();
    copy_tile_bf16((bf16*)(a.ws + WS_QE) + p.task * 4096, lds + LC_G, tid);
    copy_tile_bf16((bf16*)(a.ws + WS_YL) + p.task * 4096, lds + LC_AT, tid);
    copy_tile_bf16((bf16*)(a.ws + WS_PT) + p.task * 4096, lds + LC_M(0), tid);
    { float* sl = (float*)(a.ws + WS_SL) + p.task * 4096; *(f32x4*)(sl + tid * 4) = *(const LAS f32x4*)(AX + tid * 4); *(f32x4*)(sl + 2048 + tid * 4) = *(const LAS f32x4*)(AX + 2048 + tid * 4); }
    __syncthreads();
}

constexpr int CH_S = 0, CH_P = 9216;
__device__ __forceinline__ void rwkv_chain_task(LAS unsigned char* lds, const Args& a, int bh, int tid, int lane, int wave) {
    const int bi = wave >> 1, bj0 = 2 * (wave & 1), fr = lane & 15, fq = lane >> 4;
    const bf16* PT = (const bf16*)(a.ws + WS_PT) + (size_t)bh * NCH * 4096; const float* SL = (const float*)(a.ws + WS_SL) + (size_t)bh * NCH * 4096;
    bf16* SC = (bf16*)(a.ws + WS_SC) + (size_t)bh * NCH * 4096;
    f32x4 s[2]; ACC_ZERO(s);
    const int row = tid >> 3, pc = tid & 7;
    v4u preg = *(const v4u*)(PT + row * 64 + pc * 8);
    for (int c = 0; c < NCH; ++c) {
        __syncthreads();
        st_bf16_tile(lds + CH_S, s, bi, bj0, fr, fq);
        *(LAS v4u*)(lds + CH_P + row * 144 + pc * 16) = preg;
        __syncthreads();
        copy_tile_bf16(SC + (size_t)c * 4096, lds + CH_S, tid);
        if (c + 1 < NCH) preg = *(const v4u*)(PT + (size_t)(c + 1) * 4096 + row * 64 + pc * 8);
        f32x4 n_[2];
#pragma unroll
        for (int n = 0; n < 2; ++n)
#pragma unroll
            for (int rg = 0; rg < 4; ++rg) n_[n][rg] = SL[(size_t)c * 4096 + (16 * bi + 4 * fq + rg) * 64 + 16 * (bj0 + n) + fr];
        mm_nt(n_, lds + CH_S, lds + CH_P, bi, bj0, fr, fq);
        s[0] = n_[0]; s[1] = n_[1];
    }
    float* so = a.out + O_RSP + (size_t)bh * 4096;
#pragma unroll
    for (int n = 0; n < 2; ++n)
#pragma unroll
        for (int rg = 0; rg < 4; ++rg) so[(16 * bi + 4 * fq + rg) * 64 + 16 * (bj0 + n) + fr] = s[n][rg];
}

constexpr int YT_Q = 0, YT_S = 9216, YT_Y = 18432;
struct RwoIn { v4u qe, sc, vc, vp, gc, gp; unsigned short yl[8]; float bn; };
__device__ __forceinline__ void rwkv_out_load(RwoIn& in, const Args& a, const RwcP& p, int tid, int lane, int wave) {
    const int bi = wave >> 1, bj0 = 2 * (wave & 1), fr = lane & 15, fq = lane >> 4, row = tid >> 3, pc = tid & 7;
    in.qe = *(const v4u*)((const bf16*)(a.ws + WS_QE) + p.task * 4096 + row * 64 + pc * 8);
    in.sc = *(const v4u*)((const bf16*)(a.ws + WS_SC) + p.task * 4096 + row * 64 + pc * 8);
    const bf16* yl = (const bf16*)(a.ws + WS_YL) + p.task * 4096;
#pragma unroll
    for (int n = 0; n < 2; ++n)
#pragma unroll
        for (int rg = 0; rg < 4; ++rg) in.yl[4 * n + rg] = yl[(16 * bi + 4 * fq + rg) * 64 + 16 * (bj0 + n) + fr];
    const int tt = tid >> 3, e8 = (tid & 7) * 8, c8 = p.h * 64 + e8, trow = p.c0 + tt;
    const bf16* cur = p.Hs + (size_t)trow * NP; const bf16* prv = (trow == 0) ? cur : cur - NP;
    in.vc = *(const v4u*)(cur + HC_RV + c8); in.vp = *(const v4u*)(prv + HC_RV + c8); in.gc = *(const v4u*)(cur + HC_RG + c8); in.gp = *(const v4u*)(prv + HC_RG + c8);
    in.bn = ((const float*)(a.ws + WS_BON))[p.task * 64 + tt];
}
__device__ __forceinline__ void rwkv_out_task(LAS unsigned char* lds, const Args& a, const RwcP& p, const RwoIn& in, RwoIn& nxt, volatile LAS unsigned* nextw, int& nx, bool& has_next, bf16* Ob, int tid, int lane, int wave) {
    const int bi = wave >> 1, bj0 = 2 * (wave & 1), fr = lane & 15, fq = lane >> 4, row = tid >> 3, pc = tid & 7, h = p.h;
    LAS float* Y = (LAS float*)(lds + YT_Y);
    __syncthreads();
    *(LAS v4u*)(lds + YT_Q + row * 144 + pc * 16) = in.qe;
    *(LAS v4u*)(lds + YT_S + row * 144 + pc * 16) = in.sc;
    f32x4 c[2];
#pragma unroll
    for (int n = 0; n < 2; ++n)
#pragma unroll
        for (int rg = 0; rg < 4; ++rg) c[n][rg] = bf2f(in.yl[4 * n + rg]);
    __syncthreads();
    nx = (int)*nextw; has_next = nx < NTASK_RWC;
    if (has_next) { const int bh2 = nx / NCH; const RwcP pn{(const bf16*)(a.ws + WS_H) + (size_t)(bh2 / 6) * SEQ * NP, bh2 % 6, (nx % NCH) * 64, (size_t)nx}; rwkv_out_load(nxt, a, pn, tid, lane, wave); }
    mm_nt(c, lds + YT_Q, lds + YT_S, bi, bj0, fr, fq);
#pragma unroll
    for (int n = 0; n < 2; ++n)
#pragma unroll
        for (int rg = 0; rg < 4; ++rg) Y[(16 * bi + 4 * fq + rg) * 64 + 16 * (bj0 + n) + fr] = c[n][rg];
    __syncthreads();
    {
        const int tt = tid >> 3, e8 = (tid & 7) * 8, c8 = h * 64 + e8; const int trow = p.c0 + tt; const bool first = (trow == 0);
        const float* mu = a.in[I_MU];
        float y[8], sm = 0.f;
#pragma unroll
        for (int e = 0; e < 8; ++e) { y[e] = Y[tt * 64 + e8 + e]; sm += y[e]; }
        sm = sum8(sm) * (1.f / 64.f);
        float var = 0.f;
#pragma unroll
        for (int e = 0; e < 8; ++e) { const float d = y[e] - sm; var += d * d; }
        var = sum8(var) * (1.f / 64.f);
        const float rstd = frsq(var + GN_EPS);
        const float bn = in.bn;
        float vs[8], gs[8], cu[8], pv[8], mm[8], gw[8], gb[8];
        unpack8(in.vc, cu); unpack8(in.vp, pv); if (first) { _Pragma("unroll") for (int e = 0; e < 8; ++e) pv[e] = 0.f; }
        ld8(mu + 768 + c8, mm);
#pragma unroll
        for (int e = 0; e < 8; ++e) vs[e] = cu[e] + (pv[e] - cu[e]) * mm[e];
        unpack8(in.gc, cu); unpack8(in.gp, pv); if (first) { _Pragma("unroll") for (int e = 0; e < 8; ++e) pv[e] = 0.f; }
        ld8(mu + 1216 + c8, mm);
#pragma unroll
        for (int e = 0; e < 8; ++e) gs[e] = cu[e] + (pv[e] - cu[e]) * mm[e];
        ld8(a.in[I_GNW] + c8, gw); ld8(a.in[I_GNB] + c8, gb);
        float o[8];
#pragma unroll
        for (int e = 0; e < 8; ++e) o[e] = ((y[e] - sm) * rstd * gw[e] + gb[e] + bn * vs[e]) * siluf(gs[e]);
        v4u w_; w_.x = pk2(o[0], o[1]); w_.y = pk2(o[2], o[3]); w_.z = pk2(o[4], o[5]); w_.w = pk2(o[6], o[7]);
        *(v4u*)(Ob + ((size_t)(p.task / (6 * NCH)) * SEQ + trow) * DM + 384 + c8) = w_;
    }
}
constexpr int NQ_RW = 48 + 192, NQ_SM = 192 + 128;
__device__ __forceinline__ int q_next(const Ctx& F, int qi) {
    __syncthreads();
    if (F.tid == 0) F.MISC[0] = __hip_atomic_fetch_add(F.ctl + CW_Q + 64 * qi, 1u, __ATOMIC_RELAXED, __HIP_MEMORY_SCOPE_AGENT);
    __syncthreads();
    return (int)F.MISC[0];
}
template <bool FOX>
__device__ __forceinline__ void attn_queue(const Ctx& F, const Args& a, int qi, float Bb, float Bm) {
    bf16* H = (bf16*)(a.ws + WS_H); bf16* Ob = (bf16*)(a.ws + WS_XN); bf16* MKV = (bf16*)(a.ws + WS_MKV);
    const float* NCKP = (const float*)(a.ws + WS_NCKP); const float* NCKS = (const float*)(a.ws + WS_NCKS);
    LAS unsigned char* lds = F.lds + RING_OFF;
    constexpr int BASE = FOX ? 0 : 768, CNT = FOX ? 768 : 512;
    int tk = q_next(F, qi);
    if (tk >= CNT) return;
    tk += BASE;
    AttnPf pf, pfn; attn_prefetch(pf, a, tk, F.lane);
    for (;;) {
        if (F.tid == 0) { const unsigned r = __hip_atomic_fetch_add(F.ctl + CW_Q + 64 * qi, 1u, __ATOMIC_RELAXED, __HIP_MEMORY_SCOPE_AGENT); F.MISC[2] = (r < (unsigned)CNT) ? BASE + r : (unsigned)NQ_AT; }
        AttnP p;
        if constexpr (FOX) { const int u = tk, qb = 15 - (u & 15), bh = u >> 4, b = bh / 6, h = bh % 6; const size_t r0 = (size_t)b * SEQ + qb * 256;
            p = AttnP{H + r0 * NP + HC_FQ + h * 64, NP, H + (size_t)b * SEQ * NP + HC_FK + h * 64, NP, H + (size_t)b * SEQ * NP + HC_FV + h * 64, NP, NCKP + (size_t)bh * SEQ, NCKS + (size_t)bh * 64, a.in[I_FQG], a.in[I_FKG],
                      H + r0 * NP + HC_FG + h * 64, NP, Ob + r0 * DM + h * 64, DM, 4 * (qb + 1), qb * 256, 1};
        } else { const int u = tk - 768, b = u / 64, h = (u / 16) % 4, qb = u % 16; const size_t r0 = (size_t)b * SEQ + qb * 256;
            p = AttnP{H + r0 * NP + HC_MQ + h * 64, NP, MKV + (size_t)b * NMEM * 512 + h * 64, 512, MKV + (size_t)b * NMEM * 512 + 256 + h * 64, 512, nullptr, nullptr, nullptr, nullptr,
                      H + r0 * NP + HC_MG + h * 64, NP, Ob + r0 * DM + 768 + h * 64, DM, 4, 0, 0}; }
        int nx;
        attn_unit<FOX>(lds, p, a, pf, pfn, F.MISC + 2, nx, Bb, Bm, F.tid, F.lane, F.wave);
        if (nx >= NQ_AT) break;
        tk = nx; pf = pfn;
    }
}
__device__ __forceinline__ void p4_mixer(const Ctx& F, const Args& a, int qoff = 0) {
    bf16* H = (bf16*)(a.ws + WS_H); bf16* Ob = (bf16*)(a.ws + WS_XN); bf16* MKV = (bf16*)(a.ws + WS_MKV);
    const float* NCKP = (const float*)(a.ws + WS_NCKP); const float* NCKS = (const float*)(a.ws + WS_NCKS);
    LAS unsigned char* lds = F.lds + RING_OFF;
    for (;;) {
        const int tk = q_next(F, 0 + qoff); if (tk >= NQ_RW) break;
        RwkvP p;
        if (tk < 48) { rwkv_chain_task(lds, a, tk, F.tid, F.lane, F.wave);
            if (tk % 6 == 0) { const bf16* last = H + ((size_t)(tk / 6) * SEQ + SEQ - 1) * NP; float* sh = a.out + O_RHP + (size_t)(tk / 6) * 1600;
                for (int m = F.tid; m < 1600; m += 512) { const int c = (m < 1152) ? HC_RR + m : (m < 1184) ? HC_WD + (m - 1152) : (m < 1216) ? HC_AD + (m - 1184) : HC_RG + (m - 1216); sh[m] = bf2f(last[c]); } }
            continue; }
        { const int u = tk - 48, b = u / 6, h = u % 6;
            p = RwkvP{H + (size_t)(MP + b * DECS) * NP, Ob + (size_t)(MP + b * DECS) * DM, DECS, h, a.in[I_SRW] + (size_t)u * 4096, a.in[I_SSH] + (size_t)b * 1600,
                      a.out + O_RSS + (size_t)u * 4096, (h == 0) ? a.out + O_RHS + (size_t)b * 1600 : nullptr}; }
        rwkv_task(lds, a, p, F.tid);
    }
    float Bm;
    {
        float Bb = 0.f;
#if FOX_SKIP
        { const float gqm = wave_max(fabsf(a.in[I_FQG][F.lane])), gkm = wave_max(fabsf(a.in[I_FKG][F.lane])); Bb = 8.0f * gqm * gkm * LOG2E * 1.02f; }
#endif
        { const float gqm = wave_max(fabsf(a.in[I_MQG][F.lane])), gkm = wave_max(fabsf(a.in[I_MKG][F.lane])); Bm = __int_as_float(__builtin_amdgcn_readfirstlane(__float_as_int(8.0f * gqm * gkm * LOG2E * 1.02f))); }
#if !FOX_SKIP
        { const float gqm = wave_max(fabsf(a.in[I_FQG][F.lane])), gkm = wave_max(fabsf(a.in[I_FKG][F.lane])); Bb = 8.0f * gqm * gkm * LOG2E * 1.02f; }
#endif
        attn_queue<true>(F, a, 1 + qoff, Bb, Bm);
    }
    for (;;) {
        const int tk = q_next(F, 2 + qoff); if (tk >= NQ_SM) break;
        SmallP p;
        if (tk < 192) { const int u = tk, b = u / 6, h = u % 6; const size_t r0 = (size_t)MP + b * DECS;
            p = SmallP{H + r0 * NP + HC_FQ + h * 64, NP, a.in[I_CFK] + ((size_t)b * PAST * 6 + h) * 64, 384, a.in[I_CFV] + ((size_t)b * PAST * 6 + h) * 64, 384, PAST, a.in[I_CFL] + (size_t)b * PAST * 6 + h, a.out + O_FLS + (size_t)b * DECS * 6 + h,
                       H + r0 * NP + HC_FK + h * 64, H + r0 * NP + HC_FV + h * 64, NP, H + r0 * NP + HC_FG + h * 64, NP, Ob + r0 * DM + h * 64, DM};
        } else { const int u = tk - 192, b = u / 4, h = u % 4; const size_t r0 = (size_t)MP + b * DECS;
            p = SmallP{H + r0 * NP + HC_MQ + h * 64, NP, a.in[I_CMK] + ((size_t)b * NMEM * 4 + h) * 64, 256, a.in[I_CMV] + ((size_t)b * NMEM * 4 + h) * 64, 256, NMEM, nullptr, nullptr,
                       nullptr, nullptr, NP, H + r0 * NP + HC_MG + h * 64, NP, Ob + r0 * DM + 768 + h * 64, DM}; }
        sample_attn(lds, p, F.tid, F.lane, F.wave);
    }
    {
        attn_queue<false>(F, a, 21 + qoff, 0.f, Bm);
    }
}

__device__ __forceinline__ void p3b_rwkv_local(const Ctx& F, const Args& a, int qoff = 0) {
    const bf16* H = (const bf16*)(a.ws + WS_H); LAS unsigned char* lds = F.lds + RING_OFF;
    for (;;) { const int blk = q_next(F, 3 + qoff); if (blk >= NBLK_PREP) break; prep_block_task(lds, a, blk, F.tid, F.lane, F.wave); }
    int cur = RWC_Q0 + q_next(F, 4 + 5 + qoff);
    if (cur >= RWC_Q0 + NTASK_RWC) return;
    RwcIn in, nxt;
    { const int tk = cur - RWC_Q0, bh = tk / NCH; const RwcP p{H + (size_t)(bh / 6) * SEQ * NP, bh % 6, (tk % NCH) * 64, (size_t)tk}; rwkv_local_load(in, a, p, F.tid); }
    for (;;) {
        if (F.tid == 0) F.MISC[2] = RWC_Q0 + __hip_atomic_fetch_add(F.ctl + CW_Q + 64 * (4 + 5 + qoff), 1u, __ATOMIC_RELAXED, __HIP_MEMORY_SCOPE_AGENT);
        int nx; bool has_next = false;
        const int tk = cur - RWC_Q0, bh = tk / NCH; const RwcP p{H + (size_t)(bh / 6) * SEQ * NP, bh % 6, (tk % NCH) * 64, (size_t)tk};
        rwkv_local_task(lds, a, p, in, nxt, F.MISC + 2, nx, has_next, F.tid, F.lane, F.wave);
        if (!has_next) break;
        cur = nx; in = nxt;
    }
}
__device__ __forceinline__ void p5_rwkv_out(const Ctx& F, const Args& a, int qoff = 0) {
    const bf16* H = (const bf16*)(a.ws + WS_H); bf16* Ob = (bf16*)(a.ws + WS_XN); LAS unsigned char* lds = F.lds + RING_OFF;
    int cur = q_next(F, 4 + qoff);
    if (cur >= NTASK_RWC) return;
    RwoIn in, nxt;
    { const int bh = cur / NCH; const RwcP p{H + (size_t)(bh / 6) * SEQ * NP, bh % 6, (cur % NCH) * 64, (size_t)cur}; rwkv_out_load(in, a, p, F.tid, F.lane, F.wave); }
    for (;;) {
        if (F.tid == 0) F.MISC[2] = __hip_atomic_fetch_add(F.ctl + CW_Q + 64 * (4 + qoff), 1u, __ATOMIC_RELAXED, __HIP_MEMORY_SCOPE_AGENT);
        int nx; bool has_next = false;
        const int bh = cur / NCH; const RwcP p{H + (size_t)(bh / 6) * SEQ * NP, bh % 6, (cur % NCH) * 64, (size_t)cur};
        rwkv_out_task(lds, a, p, in, nxt, F.MISC + 2, nx, has_next, Ob, F.tid, F.lane, F.wave);
        if (!has_next) break;
        cur = nx; in = nxt;
    }
}


struct EpiRes {
    static constexpr bool PERM = true, AFTER_DRAIN = false;
    const float* xp; const float* xs; float* yp; float* ys;
    __device__ __forceinline__ void operator()(const pg8::f32x4 (&acc)[2][2][4][2], const pg8::Unit& u, int wr, int wc, int fr, int fq) const {
        const int row0 = u.pm * 256 + wr * 64 + fr, col0 = u.pn * 256 + wc * 32 + 8 * fq;
        const bool samp = u.pm >= (MP / 256);
        const float* xb = samp ? xs - (size_t)MP * DM : xp; float* yb = samp ? ys - (size_t)MP * DM : yp;
#pragma unroll
        for (int ai = 0; ai < 2; ++ai)
#pragma unroll
            for (int m = 0; m < 4; ++m) { const size_t ro = (size_t)(row0 + ai * 128 + m * 16) * DM + col0;
#pragma unroll
                for (int bj = 0; bj < 2; ++bj) {
                    const pg8::f32x4 x0 = *(const pg8::f32x4*)(xb + ro + bj * 128), x1 = *(const pg8::f32x4*)(xb + ro + bj * 128 + 4);
                    *(pg8::f32x4*)(yb + ro + bj * 128) = acc[ai][bj][m][0] + x0; *(pg8::f32x4*)(yb + ro + bj * 128 + 4) = acc[ai][bj][m][1] + x1; } }
    }
};

struct OneUnit { int pm, pn;
    __device__ __forceinline__ bool next(int i, pg8::Unit& u) const { if (i > 0) return false; u.pm = pm; u.pn = pn; return true; }
    __device__ __forceinline__ void a_ready(const pg8::Unit&) const {}
    __device__ __forceinline__ void done(const pg8::Unit&) const {} };
__global__ void __launch_bounds__(NWAVES * 64, 2) fwd_kernel(Args args) {
    extern __shared__ __attribute__((aligned(16))) unsigned char lds[];
    Ctx F;
    F.lds = (LAS unsigned char*)lds;
    F.MISC = (volatile LAS unsigned*)(F.lds + MISC_OFF);
    F.tid = threadIdx.x; F.lane = F.tid & 63; F.wave = __builtin_amdgcn_readfirstlane(F.tid >> 6);
    F.G = gridDim.x; { const int bx = blockIdx.x; F.vcu = (F.G % 8 == 0) ? (bx % 8) * (F.G / 8) + bx / 8 : bx; }
    F.ctl = (gu32*)(args.ws + WS_CTL);
    for (int u = F.tid; u < (LDS_BYTES - LDSCTL_OFF) / 4; u += NWAVES * 64) ((LAS unsigned*)(F.lds + LDSCTL_OFF))[u] = 0u;
    __syncthreads();
    XcdBarrier bar; bar.bar = (unsigned*)(F.ctl + CW_BAR); bar.x = 0; bar.st = nullptr;
#if MK_ONE_LAUNCH
    bar = xcd_barrier_post((unsigned*)(F.ctl + CW_BAR), F.MISC + 8);
#define GRID_BAR() xcd_barrier(bar)
#else
#define GRID_BAR() do {} while (0)
#endif
    const int lo = args.ph_lo, hi = args.ph_hi;
#define IN(k) (lo <= (k) && (k) < hi)
#define BOTH(k) (IN(k) && IN((k) + 1))
    bf16* H = (bf16*)(args.ws + WS_H);
    if (IN(0)) { p0_prologue(F, args); if (BOTH(0)) GRID_BAR(); }
    if (IN(1)) {
        { pg8::Gemm g{(const bf16*)(args.ws + WS_XN), (const bf16*)(args.ws + WS_WIN), MT, NP, DM}; pg8::StaticOrder S; S.init(MT, NP, F.G, (int)blockIdx.x);
          pg8::EpiBf16<0> E{H, NP, nullptr, 0, 0, 1.f};
          pg8::gemm_phase<pg8::EpiBf16<0>, pg8::StaticOrder, PG8_ALIGN, PG8_SP2>(F.lds + RING_OFF, g, S, E); }
        { pg8::Gemm g{(const bf16*)(args.ws + WS_MEMN), (const bf16*)(args.ws + WS_WMEM), BATCH * NMEM, 512, DM}; pg8::StaticOrder S; S.init(BATCH * NMEM, 512, F.G, (int)((blockIdx.x + 16u) % (unsigned)F.G))    ;
          pg8::EpiBf16<0> E{(bf16*)(args.ws + WS_MKV), 512, nullptr, 0, 0, 1.f};
          pg8::gemm_phase<pg8::EpiBf16<0>, pg8::StaticOrder, PG8_ALIGN, PG8_SP2>(F.lds + RING_OFF, g, S, E); }
        if (IN(1) && IN(3)) GRID_BAR();
    }
    if (IN(3)) { p3b_rwkv_local(F, args); if (BOTH(3)) GRID_BAR(); }
    if (IN(4)) { p4_mixer(F, args); if (BOTH(4)) GRID_BAR(); }
    if (IN(5)) {
        if (F.vcu < 8) {
            pg8::Gemm g{(const bf16*)(args.ws + WS_XN), (const bf16*)(args.ws + WS_WOUT), MT, DM, DM}; OneUnit S{MP / 256 + (F.vcu >> 2), F.vcu & 3};
            EpiRes E{args.in[I_XP], args.in[I_XS], args.out + O_YP, args.out + O_YS};
            pg8::gemm_phase<EpiRes, OneUnit, PG8_ALIGN, PG8_SP2>(F.lds + RING_OFF, g, S, E);
        }
        p5_rwkv_out(F, args); if (BOTH(5)) GRID_BAR(); }
    if (IN(6)) {
        pg8::Gemm g{(const bf16*)(args.ws + WS_XN), (const bf16*)(args.ws + WS_WOUT), MP, DM, DM}; pg8::StaticOrder S; S.init(MP, DM, F.G, (int)blockIdx.x);
        EpiRes E{args.in[I_XP], args.in[I_XS], args.out + O_YP, args.out + O_YS};
        pg8::gemm_phase<EpiRes, pg8::StaticOrder, PG8_ALIGN, PG8_SP2>(F.lds + RING_OFF, g, S, E);
    }
#undef IN
#undef BOTH
}

extern "C" void kernel_launch(void* const* d_in, const int* in_sizes, int n_in, void* d_out, int out_size, void* d_ws, size_t ws_size, hipStream_t stream) {
    static int grid = 0;
    if (grid == 0) {
        if (n_in != 30 || out_size != (int)O_END || ws_size < WS_END2) { fprintf(stderr, "kernel_launch: unexpected shapes (n_in %d out %d ws %zu)\n", n_in, out_size, ws_size); grid = -1; return; }
        int dev = 0, cus = 0;
        if (hipGetDevice(&dev) != hipSuccess || hipDeviceGetAttribute(&cus, hipDeviceAttributeMultiprocessorCount, dev) != hipSuccess) { grid = -1; return; }
        if (hipFuncSetAttribute((const void*)fwd_kernel, hipFuncAttributeMaxDynamicSharedMemorySize, LDS_BYTES) != hipSuccess) { fprintf(stderr, "kernel_launch: hipFuncSetAttribute failed\n"); grid = -1; return; }
        (void)hipGetLastError();
        grid = cus;
    }
    if (grid < 0) return;
    (void)hipMemsetAsync((char*)d_ws + WS_CTL, 0, CTL_ZERO_BYTES, stream);
    Args a{};
    for (int i = 0; i < 30; ++i) a.in[i] = (const float*)d_in[i];
    a.out = (float*)d_out; a.ws = (unsigned char*)d_ws; a.pad = PROBE_PAD;
#if MK_ONE_LAUNCH
    a.ph_lo = 0; a.ph_hi = N_PHASES; a.li = 0;
    hipLaunchKernelGGL(fwd_kernel, dim3(grid), dim3(NWAVES * 64), LDS_BYTES, stream, a);
#else
    for (int li = 0; li < N_PHASES; ++li) { a.ph_lo = li; a.ph_hi = li + 1; a.li = li;
        hipLaunchKernelGGL(fwd_kernel, dim3(grid), dim3(NWAVES * 64), LDS_BYTES, stream, a); }
#endif
}
```

```cpp
#include <hip/hip_runtime.h>
#include <cstdio>
#include <cstdint>
#include <cmath>

#define PROBE_PAD 0
namespace pg8 {
#define PG8_LAS __attribute__((address_space(3)))
typedef unsigned short bf16_t;
typedef short bf16x8 __attribute__((ext_vector_type(8)));
typedef float f32x4 __attribute__((ext_vector_type(4)));
typedef unsigned u32x4 __attribute__((ext_vector_type(4)));
constexpr int BM = 256, BK = 64, HALF = 128, HTB = HALF * BK * 2  , STAGE_BYTES = 8 * HTB, NXCD = 8, WGM = 8;

__host__ __device__ __forceinline__ int lds_byte(int r, int c) { const int st = (r >> 4) * 2 + (c >> 5), rr = r & 15, cc = c & 31, ob = rr * 64 + cc * 2; return st * 1024 + (ob ^ (((ob >> 9) & 1) << 5)); }
__host__ __device__ __forceinline__ void stage_rc(int b, int& R, int& C) { const int st = b / 1024, sb = b % 1024, swz = sb ^ (((sb >> 9) & 1) << 5); R = (st >> 1) * 16 + swz / 64; C = (st & 1) * 32 + (swz % 64) / 2; }
__host__ __device__ __forceinline__ int perm32(int rho) { const int n = rho >> 4, i = rho & 15; return 8 * (i >> 2) + 4 * n + (i & 3); }

struct Unit { int pm, pn; };
struct Gemm { const bf16_t* A; const bf16_t* Bt; int M, N, K; };

struct StaticOrder {
    int nM, nN, nwg, G, c;
    __host__ __device__ void init(int M, int N, int G_, int c_) { nM = M / BM; nN = N / BM; nwg = nM * nN; G = G_; c = c_; }
    __host__ __device__ bool next(int i, Unit& u) const {
        const long L = (long)i * G + c; if (L >= nwg) return false;
        int wgid = (int)L; { const int q = nwg / NXCD, r = nwg % NXCD, xcd = wgid % NXCD, off = wgid / NXCD; wgid = (xcd < r ? xcd * (q + 1) : r * (q + 1) + (xcd - r) * q) + off; }
        const int nig = WGM * nN, gid = wgid / nig, fm = gid * WGM, gsz = (nM - fm) < WGM ? (nM - fm) : WGM;
        u.pm = fm + ((wgid % nig) % gsz); u.pn = (wgid % nig) / gsz; return true;
    }
    __device__ __forceinline__ void a_ready(const Unit&) const {}
    __device__ __forceinline__ void done(const Unit&) const {}
};

__device__ __forceinline__ unsigned cvt_pk_bf16(float lo, float hi) { unsigned r; asm volatile("v_cvt_pk_bf16_f32 %0, %1, %2" : "=v"(r) : "v"(lo), "v"(hi)); return r; }
typedef float f32x2 __attribute__((ext_vector_type(2)));
__device__ __forceinline__ f32x2 gelu_pk(f32x2 v) {
    const f32x2 av = __builtin_elementwise_abs(v), d = av * 0.2316418882f + 1.0f;
    f32x2 t; t.x = __builtin_amdgcn_rcpf(d.x); t.y = __builtin_amdgcn_rcpf(d.y);
    f32x2 q = t * 0.5307027145f + (-0.7265760135f); q = q * t + 0.7107068705f; q = q * t + (-0.142248368f); q = q * t + 0.127414796f; q = q * t;
    const f32x2 s = (v * v) * (-0.72134752044f);
    f32x2 e; e.x = __builtin_amdgcn_exp2f(s.x); e.y = __builtin_amdgcn_exp2f(s.y);
    const f32x2 m = v * (q * e), r = v - m;
    f32x2 o; o.x = v.x < 0.f ? m.x : r.x; o.y = v.y < 0.f ? m.y : r.y; return o;
}

template <int ACT  > struct EpiBf16 {
    static constexpr bool PERM = true, AFTER_DRAIN = false; static_assert(ACT == 0 || ACT == 1, "EpiBf16: ACT is 0 (none) or 1 (gelu_pk)");
    bf16_t* O; int ldc; const float* bias; int split_cols; size_t split_stride; float scale0;
    __device__ __forceinline__ void operator()(const f32x4 (&acc)[2][2][4][2], const Unit& u, int wr, int wc, int fr, int fq) const {
        const int row0 = u.pm * BM + wr * 64 + fr; int colt = u.pn * BM; bf16_t* base = O;
        float sc = 1.f; if (split_cols) { const int t = colt / split_cols; base += (size_t)t * split_stride; colt -= t * split_cols; if (t == 0) sc = scale0; }
        const int col0 = colt + wc * 32 + 8 * fq, bcol0 = u.pn * BM + wc * 32 + 8 * fq;
        f32x4 bv[2][2];
#pragma unroll
        for (int bj = 0; bj < 2; ++bj)
#pragma unroll
            for (int n = 0; n < 2; ++n) bv[bj][n] = bias ? *(const f32x4*)(bias + bcol0 + bj * HALF + 4 * n) : (f32x4){0.f, 0.f, 0.f, 0.f};
#pragma unroll
        for (int ai = 0; ai < 2; ++ai)
#pragma unroll
            for (int m = 0; m < 4; ++m) { bf16_t* rowp = base + (size_t)(row0 + ai * HALF + m * 16) * ldc + col0;
#pragma unroll
                for (int bj = 0; bj < 2; ++bj) { f32x4 v0 = acc[ai][bj][m][0] + bv[bj][0], v1 = acc[ai][bj][m][1] + bv[bj][1];
                    if (ACT == 1) { f32x2 a = gelu_pk((f32x2){v0[0], v0[1]}), b = gelu_pk((f32x2){v0[2], v0[3]}), c = gelu_pk((f32x2){v1[0], v1[1]}), d = gelu_pk((f32x2){v1[2], v1[3]});
                        v0 = (f32x4){a.x, a.y, b.x, b.y}; v1 = (f32x4){c.x, c.y, d.x, d.y}; }
                    v0 = v0 * sc; v1 = v1 * sc; u32x4 w; w.x = cvt_pk_bf16(v0[0], v0[1]); w.y = cvt_pk_bf16(v0[2], v0[3]); w.z = cvt_pk_bf16(v1[0], v1[1]); w.w = cvt_pk_bf16(v1[2], v1[3]);
                    *(u32x4*)(rowp + bj * HALF) = w; } }
    }
};


template <class Epi, class Sched, bool ALIGN_EPI = false, bool SP2 = false>
__device__ __forceinline__ void gemm_phase(PG8_LAS unsigned char* lds, const Gemm g, const Sched& S, const Epi& E) {
    const int tid = threadIdx.x, wid = __builtin_amdgcn_readfirstlane(tid >> 6), lane = tid & 63, wr = wid >> 2, wc = wid & 3, fr = lane & 15, fq = lane >> 4;
    const int K = g.K, nt = K / BK;
    unsigned voffA[2], voffB[2];
#pragma unroll
    for (int i = 0; i < 2; ++i) { int R, C; stage_rc(tid * 16 + i * 8192, R, C); const int Rb = Epi::PERM ? ((R & ~31) + perm32(R & 31)) : R;
        voffA[i] = (unsigned)(R * K + C) * 2u; voffB[i] = (unsigned)(Rb * K + C) * 2u; }
    const size_t kstep = (size_t)(BK * 2);
    const size_t hstep = (size_t)HALF * K * 2;
    const size_t tstep = 2 * hstep;
    const unsigned ldsw = (unsigned)wid * 1024u;
    const int aoff = lds_byte(wr * 64 + fr, fq * 8), boff = lds_byte(wc * 32 + fr, fq * 8);
#define PG8_SA(b, h) (((b) * 2 + (h)) * HTB)
#define PG8_SB(b, h) ((4 + (b) * 2 + (h)) * HTB)
#define PG8_STAGE(bufoff, gbase, voff) do { _Pragma("unroll") for (int _i = 0; _i < 2; ++_i) \
        __builtin_amdgcn_global_load_lds((const unsigned*)((const char*)(gbase) + (voff)[_i]), (PG8_LAS unsigned*)(lds + (bufoff) + ldsw + _i * 8192), 16, 0, 0); } while (0)
#define PG8_LDA(dst, b, h) do { _Pragma("unroll") for (int m = 0; m < 4; ++m) _Pragma("unroll") for (int k = 0; k < 2; ++k) dst[m][k] = *(const PG8_LAS bf16x8*)(lds + PG8_SA(b, h) + aoff + m * 2048 + k * 1024); } while (0)
#define PG8_LDB(dst, b, h) do { _Pragma("unroll") for (int n = 0; n < 2; ++n) _Pragma("unroll") for (int k = 0; k < 2; ++k) dst[n][k] = *(const PG8_LAS bf16x8*)(lds + PG8_SB(b, h) + boff + n * 2048 + k * 1024); } while (0)
#define PG8_MMA(ai, bj, At, Bt) do { __builtin_amdgcn_s_setprio(1); _Pragma("unroll") for (int m = 0; m < 4; ++m) _Pragma("unroll") for (int n = 0; n < 2; ++n) _Pragma("unroll") for (int k = 0; k < 2; ++k) \
        acc[ai][bj][m][n] = __builtin_amdgcn_mfma_f32_16x16x32_bf16(Bt[n][k], At[m][k], acc[ai][bj][m][n], 0, 0, 0); __builtin_amdgcn_s_setprio(0); } while (0)
#define PG8_WAIT_V(n) asm volatile("s_waitcnt vmcnt(" #n ")" ::: "memory")
#define PG8_WAIT_L(n) asm volatile("s_waitcnt lgkmcnt(" #n ")" ::: "memory")
#define PG8_BAR __builtin_amdgcn_s_barrier()
#define PG8_SCHED __builtin_amdgcn_sched_barrier(0)
    Unit cur, nxt; int ui = 0;
    if (!S.next(0, cur)) return;
    f32x4 acc[2][2][4][2];
#pragma unroll
    for (int a = 0; a < 2; ++a)
#pragma unroll
        for (int b = 0; b < 2; ++b)
#pragma unroll
            for (int m = 0; m < 4; ++m)
#pragma unroll
                for (int n = 0; n < 2; ++n) acc[a][b][m][n] = (f32x4){0.f, 0.f, 0.f, 0.f};
    bf16x8 At[4][2], B0[2][2], B1[2][2];
    const char* cA = (const char*)g.A + (size_t)cur.pm * tstep; const char* cB = (const char*)g.Bt + (size_t)cur.pn * tstep;
    S.a_ready(cur);
    if constexpr (SP2) {
        PG8_STAGE(PG8_SB(0, 0), cB, voffB); PG8_STAGE(PG8_SB(0, 1), cB + hstep, voffB); PG8_STAGE(PG8_SA(0, 0), cA, voffA); PG8_STAGE(PG8_SA(0, 1), cA + hstep, voffA);
        if (wr == 1) PG8_BAR;
        PG8_WAIT_V(2); PG8_BAR;
        PG8_STAGE(PG8_SB(1, 0), cB + kstep, voffB); PG8_STAGE(PG8_SA(1, 0), cA + kstep, voffA); PG8_STAGE(PG8_SB(1, 1), cB + hstep + kstep, voffB);
        PG8_WAIT_V(6); PG8_BAR;
    } else {
        PG8_STAGE(PG8_SB(0, 0), cB, voffB); PG8_STAGE(PG8_SA(0, 0), cA, voffA); PG8_STAGE(PG8_SB(0, 1), cB + hstep, voffB); PG8_STAGE(PG8_SA(0, 1), cA + hstep, voffA);
        if (wr == 1) PG8_BAR;
        PG8_WAIT_V(4); PG8_BAR;
        PG8_STAGE(PG8_SB(1, 0), cB + kstep, voffB); PG8_STAGE(PG8_SA(1, 0), cA + kstep, voffA); PG8_STAGE(PG8_SB(1, 1), cB + hstep + kstep, voffB);
        PG8_WAIT_V(6); PG8_BAR;
    }
    for (;;) {
        const bool has_next = S.next(ui + 1, nxt);
        const char* nA = has_next ? (const char*)g.A + (size_t)nxt.pm * tstep : cA; const char* nB = has_next ? (const char*)g.Bt + (size_t)nxt.pn * tstep : cB;
        for (int t = 0; t < nt; t += 2) {
            const bool last = (t == nt - 2);
            const char* a1 = cA + (size_t)(t + 1) * kstep;
            const char* a2 = last ? nA : cA + (size_t)(t + 2) * kstep; const char* b2 = last ? nB : cB + (size_t)(t + 2) * kstep;
            const char* a3 = a2 + kstep; const char* b3 = b2 + kstep;
            if (last && has_next) S.a_ready(nxt);
            if constexpr (SP2) {
            PG8_LDB(B0, 0, 0); PG8_LDB(B1, 0, 1); PG8_SCHED; PG8_LDA(At, 0, 0); PG8_STAGE(PG8_SA(1, 1), a1 + hstep, voffA);
            PG8_WAIT_V(8); PG8_WAIT_L(0); PG8_BAR; PG8_MMA(0, 0, At, B0); PG8_MMA(0, 1, At, B1); PG8_BAR; PG8_SCHED;
            PG8_LDA(At, 0, 1); PG8_STAGE(PG8_SB(0, 0), b2, voffB); PG8_STAGE(PG8_SB(0, 1), b2 + hstep, voffB); PG8_STAGE(PG8_SA(0, 0), a2, voffA);
            PG8_WAIT_V(8); PG8_WAIT_L(0); PG8_BAR; PG8_MMA(1, 0, At, B0); PG8_MMA(1, 1, At, B1); PG8_BAR; PG8_SCHED;
            PG8_LDB(B0, 1, 0); PG8_LDB(B1, 1, 1); PG8_SCHED; PG8_LDA(At, 1, 0); PG8_STAGE(PG8_SA(0, 1), a2 + hstep, voffA);
            PG8_WAIT_V(8); PG8_WAIT_L(0); PG8_BAR; PG8_MMA(0, 0, At, B0); PG8_MMA(0, 1, At, B1); PG8_BAR; PG8_SCHED;
            PG8_LDA(At, 1, 1); PG8_STAGE(PG8_SB(1, 0), b3, voffB); PG8_STAGE(PG8_SB(1, 1), b3 + hstep, voffB); PG8_STAGE(PG8_SA(1, 0), a3, voffA);
            PG8_WAIT_V(8); PG8_WAIT_L(0); PG8_BAR; PG8_MMA(1, 0, At, B0); PG8_MMA(1, 1, At, B1); PG8_BAR; PG8_SCHED;
            } else {
            PG8_LDB(B0, 0, 0); PG8_SCHED; PG8_LDA(At, 0, 0); PG8_STAGE(PG8_SA(1, 1), a1 + hstep, voffA);
            PG8_WAIT_L(8); PG8_BAR; PG8_WAIT_L(0); PG8_MMA(0, 0, At, B0); PG8_BAR; PG8_SCHED;
            PG8_LDB(B1, 0, 1); PG8_STAGE(PG8_SB(0, 0), b2, voffB);
            PG8_BAR; PG8_WAIT_L(0); PG8_MMA(0, 1, At, B1); PG8_BAR;
            PG8_LDA(At, 0, 1); PG8_STAGE(PG8_SA(0, 0), a2, voffA);
            PG8_BAR; PG8_WAIT_L(0); PG8_MMA(1, 0, At, B0); PG8_BAR; PG8_SCHED;
            PG8_STAGE(PG8_SB(0, 1), b2 + hstep, voffB);
            PG8_WAIT_V(6); PG8_BAR; PG8_MMA(1, 1, At, B1); PG8_BAR;
            PG8_LDB(B0, 1, 0); PG8_SCHED; PG8_LDA(At, 1, 0); PG8_STAGE(PG8_SA(0, 1), a2 + hstep, voffA);
            PG8_WAIT_L(8); PG8_BAR; PG8_WAIT_L(0); PG8_MMA(0, 0, At, B0); PG8_BAR; PG8_SCHED;
            PG8_LDB(B1, 1, 1); PG8_STAGE(PG8_SB(1, 0), b3, voffB);
            PG8_BAR; PG8_WAIT_L(0); PG8_MMA(0, 1, At, B1); PG8_BAR;
            PG8_LDA(At, 1, 1); PG8_STAGE(PG8_SA(1, 0), a3, voffA);
            PG8_BAR; PG8_WAIT_L(0); PG8_MMA(1, 0, At, B0); PG8_BAR; PG8_SCHED;
            PG8_STAGE(PG8_SB(1, 1), b3 + hstep, voffB);
            PG8_WAIT_V(6); PG8_BAR; PG8_MMA(1, 1, At, B1); PG8_BAR;
            }
        }
        if constexpr (ALIGN_EPI) { if (wr == 0) PG8_BAR; }
        if constexpr (!Epi::AFTER_DRAIN) { E(acc, cur, wr, wc, fr, fq); S.done(cur); }
        if (!has_next) break;
#pragma unroll
        for (int a = 0; a < 2; ++a)
#pragma unroll
            for (int b = 0; b < 2; ++b)
#pragma unroll
                for (int m = 0; m < 4; ++m)
#pragma unroll
                    for (int n = 0; n < 2; ++n) acc[a][b][m][n] = (f32x4){0.f, 0.f, 0.f, 0.f};
        cur = nxt; cA = nA; cB = nB; ++ui;
        if constexpr (ALIGN_EPI) { if (wr == 1) PG8_BAR; }
    }
    PG8_WAIT_V(0);
    if constexpr (!ALIGN_EPI) { if (wr == 0) PG8_BAR; }
    PG8_BAR;
    if constexpr (Epi::AFTER_DRAIN) { E.fused(acc, cur, wr, wc, fr, fq, lds, wid, lane); S.done(cur); }
#undef PG8_SA
#undef PG8_SB
#undef PG8_STAGE
#undef PG8_LDA
#undef PG8_LDB
#undef PG8_MMA
#undef PG8_WAIT_V
#undef PG8_WAIT_L
#undef PG8_BAR
#undef PG8_SCHED
}
}
#ifndef PG8_SP2
#define PG8_SP2 true
#endif
#ifndef PG8_ALIGN
#define PG8_ALIGN true
#endif
#define GAS __attribute__((address_space(1)))
#define LAS __attribute__((address_space(3)))
typedef unsigned short bf16;
typedef unsigned v4u __attribute__((ext_vector_type(4)));
typedef float f32x4 __attribute__((ext_vector_type(4)));
typedef short bf16x8 __attribute__((ext_vector_type(8)));
typedef GAS unsigned gu32;
typedef GAS unsigned long long gu64;
#define RLX_AGENT __ATOMIC_RELAXED, __HIP_MEMORY_SCOPE_AGENT
#define LDS_WAIT() asm volatile("s_waitcnt lgkmcnt(0)" ::: "memory")
#define VM_WAIT() asm volatile("s_waitcnt vmcnt(0)" ::: "memory")
__device__ __forceinline__ unsigned long long rt() { return __builtin_amdgcn_s_memrealtime(); }
typedef float f32x2_t __attribute__((ext_vector_type(2))); typedef __bf16 bf16x2_t __attribute__((ext_vector_type(2)));
__device__ __forceinline__ unsigned pk2(float lo, float hi) { const f32x2_t v = {lo, hi}; const bf16x2_t b = __builtin_convertvector(v, bf16x2_t); return __builtin_bit_cast(unsigned, b); }
__device__ __forceinline__ unsigned f2bf(float f) { return pk2(f, 0.f) & 0xffffu; }

#define XB_TMO      128
#define XB_XCNT(j)  (256  + 64 * (j))
#define XB_XSUB(j)  (1280 + 64 * (j))
#define XB_XGEN(j)  (2304 + 64 * (j))
#define XB_TOP      3328
#define XB_TOPGEN   3392
#define XCD_BAR_WORDS 3456
#define XB_SPIN_CAP (1u << 18)

__device__ __forceinline__ unsigned xb_ld(unsigned* p)              { return __hip_atomic_load(p, __ATOMIC_RELAXED, __HIP_MEMORY_SCOPE_AGENT); }
__device__ __forceinline__ unsigned xb_add(unsigned* p, unsigned v) { return __hip_atomic_fetch_add(p, v, __ATOMIC_RELAXED, __HIP_MEMORY_SCOPE_AGENT); }
__device__ __forceinline__ unsigned xb_xcc_id() { return (unsigned)__builtin_amdgcn_s_getreg((3 << 11) | 20) & 0xFu; }
#define XB_SPIN(cond, bar) do { unsigned _sp = 0; while (cond) { __builtin_amdgcn_s_sleep(1); \
    if ((++_sp & 255u) == 0u) { if (xb_ld(&(bar)[XB_TMO])) break; if (_sp > XB_SPIN_CAP) { atomicAdd(&(bar)[XB_TMO], 1u); break; } } } } while (0)

struct XcdBarrier {
    unsigned* bar; unsigned x;
    volatile LAS unsigned* st;
};

__device__ __forceinline__ XcdBarrier xcd_barrier_post(unsigned* bar, volatile LAS unsigned* st) {
    XcdBarrier b; b.bar = bar; b.x = xb_xcc_id(); b.st = st;
    if (threadIdx.x == 0) (void)xb_add(&bar[XB_XCNT(b.x)], 1u);
    return b;
}
__device__ __forceinline__ void xcd_barrier_complete(unsigned* bar, unsigned x, unsigned& nloc, unsigned& nx) {
    const unsigned G = gridDim.x * gridDim.y * gridDim.z;
    unsigned sum, cnt, mine, sp = 0u;
    for (;;) {
        sum = 0u; cnt = 0u; mine = 0u;
#pragma unroll
        for (unsigned j = 0; j < 16; ++j) { const unsigned c = xb_ld(&bar[XB_XCNT(j)]); sum += c; cnt += (c > 0u) ? 1u : 0u; mine = (j == x) ? c : mine; }
        if (sum == G) break;
        __builtin_amdgcn_s_sleep(1);
        if ((++sp & 255u) == 0u) { if (xb_ld(&bar[XB_TMO])) break; if (sp > XB_SPIN_CAP) { atomicAdd(&bar[XB_TMO], 1u); break; } }
    }
    nloc = mine > 0u ? mine : 1u; nx = cnt > 0u ? cnt : 1u;
}

__device__ __forceinline__ void xcd_barrier(const XcdBarrier& b) {
    asm volatile("s_waitcnt vmcnt(0)" ::: "memory");
    __syncthreads();
    if (threadIdx.x == 0) {
        unsigned* bar = b.bar;
        __builtin_amdgcn_s_waitcnt(0);
        unsigned nloc = b.st[0], nx = b.st[1];
        if (nloc == 0u) { xcd_barrier_complete(bar, b.x, nloc, nx); b.st[0] = nloc; b.st[1] = nx; }
        const unsigned old = xb_add(&bar[XB_XSUB(b.x)], 1u);
        const unsigned gen = old / nloc;
        if (old + 1u == (gen + 1u) * nloc) {
            __builtin_amdgcn_fence(__ATOMIC_RELEASE, "agent");
            asm volatile("s_waitcnt vmcnt(0)" ::: "memory");
            const unsigned og = xb_add(&bar[XB_TOP], 1u);
            const unsigned tg = og / nx;
            if (og + 1u == (tg + 1u) * nx) xb_add(&bar[XB_TOPGEN], 1u);
            else XB_SPIN(xb_ld(&bar[XB_TOPGEN]) == tg, bar);
            __builtin_amdgcn_fence(__ATOMIC_ACQUIRE, "agent");
            xb_add(&bar[XB_XGEN(b.x)], 1u);
            asm volatile("s_waitcnt vmcnt(0)" ::: "memory");
        } else {
            XB_SPIN(xb_ld(&bar[XB_XGEN(b.x)]) == gen, bar);
            __builtin_amdgcn_fence(__ATOMIC_ACQUIRE, "agent");
            asm volatile("s_waitcnt vmcnt(0)" ::: "memory");
        }
    }
    __syncthreads();
}

constexpr int NWAVES = 8;
#ifndef FOX_SKIP
#define FOX_SKIP 1
#endif
#ifndef MK_ONE_LAUNCH
#define MK_ONE_LAUNCH 1
#endif
constexpr int N_PHASES = 7;

constexpr int DM = 1024, BATCH = 8, SEQ = 4096, DECB = 32, DECS = 16, PAST = 1024, NMEM = 256;
constexpr int MP = BATCH * SEQ, MS = DECB * DECS, MT = MP + MS;
constexpr int NIN = 3654, NP = 3840;
constexpr int HC_FQ = 0, HC_FK = 384, HC_FV = 768, HC_FG = 1152, HC_RR = 1536, HC_RK = 1920, HC_RV = 2304, HC_RG = 2688,
              HC_MQ = 3072, HC_MG = 3328, HC_WD = 3584, HC_AD = 3616, HC_FF = 3648;
constexpr float NORM_EPS = 1e-6f, GN_EPS = 64e-5f, LOG2E = 1.4426950408889634f, C2 = 0.125f * 1.4426950408889634f;

constexpr size_t O_YP = 0, O_YS = O_YP + (size_t)MP * DM, O_FKP = O_YS + (size_t)MS * DM, O_FVP = O_FKP + (size_t)MP * 384, O_FLP = O_FVP + (size_t)MP * 384,
                 O_MKP = O_FLP + (size_t)MP * 6, O_MVP = O_MKP + (size_t)BATCH * NMEM * 256, O_RSP = O_MVP + (size_t)BATCH * NMEM * 256, O_RHP = O_RSP + (size_t)BATCH * 6 * 4096,
                 O_FKS = O_RHP + (size_t)BATCH * 1600, O_FVS = O_FKS + (size_t)MS * 384, O_FLS = O_FVS + (size_t)MS * 384, O_RSS = O_FLS + (size_t)MS * 6,
                 O_RHS = O_RSS + (size_t)DECB * 6 * 4096, O_END = O_RHS + (size_t)DECB * 1600;
static_assert(O_END == 61933056, "d_out map");

constexpr size_t MiB = 1u << 20;
constexpr size_t WS_CTL = 0, CTL_ZERO_BYTES = 1 * MiB;
constexpr size_t WS_WIN = 2 * MiB, WS_WOUT = 10 * MiB, WS_WMEM = 12 * MiB, WS_MEMN = 13 * MiB, WS_MKV = 17 * MiB, WS_NCKP = 19 * MiB, WS_NCKS = 20 * MiB;
constexpr size_t WS_XN = 24 * MiB;
constexpr size_t WS_H = 96 * MiB;
constexpr size_t WS_END = WS_H + (size_t)MT * NP * 2;
static_assert(WS_XN + (size_t)MT * DM * 2 <= WS_H && WS_END <= 400 * MiB, "d_ws map");
constexpr int CW_BAR = 4096, CW_Q = 64;

constexpr int RING_OFF = 0, RING_BYTES = 131072;
constexpr int LDS_BYTES = 147456;
constexpr int LDSCTL_OFF = LDS_BYTES - 448, MISC_OFF = LDSCTL_OFF + 320;

struct Args { const float* in[30]; float* out; unsigned char* ws; int ph_lo, ph_hi, li, pad; };
enum { I_XP = 0, I_XS, I_MEMP, I_CFK, I_CFV, I_CFL, I_CMK, I_CMV, I_SRW, I_SSH, I_NG, I_WIN, I_FQG, I_FKG, I_FBF, I_MU, I_W0, I_WUP, I_A0, I_AUP,
       I_KK, I_KA, I_RK, I_GNW, I_GNB, I_MNG, I_WMKV, I_MQG, I_MKG, I_WOUT };

struct Ctx { LAS unsigned char* lds; volatile LAS unsigned* MISC; gu32* ctl; int tid, lane, wave, vcu, G; };

__device__ __forceinline__ float bf2f(bf16 u) { return __uint_as_float((unsigned)u << 16); }
__device__ __forceinline__ float wave_sum(float v) {
#pragma unroll
    for (int o = 1; o < 64; o <<= 1) v += __shfl_xor(v, o);
    return v;
}
__device__ __forceinline__ float wave_max(float v) {
#pragma unroll
    for (int o = 1; o < 64; o <<= 1) v = fmaxf(v, __shfl_xor(v, o));
    return v;
}
__device__ __forceinline__ float sum8(float v) { v += __shfl_xor(v, 1); v += __shfl_xor(v, 2); v += __shfl_xor(v, 4); return v; }
__device__ __forceinline__ void unpack8(const v4u w, float (&f)[8]) {
    f[0] = __uint_as_float(w.x << 16); f[1] = __uint_as_float(w.x & 0xffff0000u); f[2] = __uint_as_float(w.y << 16); f[3] = __uint_as_float(w.y & 0xffff0000u);
    f[4] = __uint_as_float(w.z << 16); f[5] = __uint_as_float(w.z & 0xffff0000u); f[6] = __uint_as_float(w.w << 16); f[7] = __uint_as_float(w.w & 0xffff0000u); }
__device__ __forceinline__ void ld8(const float* p, float (&f)[8]) { const f32x4 a = *(const f32x4*)p, b = *(const f32x4*)(p + 4);
    f[0] = a.x; f[1] = a.y; f[2] = a.z; f[3] = a.w; f[4] = b.x; f[5] = b.y; f[6] = b.z; f[7] = b.w; }
__device__ __forceinline__ float fexp(float x) { return __builtin_amdgcn_exp2f(x * LOG2E); }
__device__ __forceinline__ float frcp(float x) { return __builtin_amdgcn_rcpf(x); }
__device__ __forceinline__ float frsq(float x) { return __builtin_amdgcn_rsqf(x); }
__device__ __forceinline__ float flog(float x) { return __builtin_amdgcn_logf(x) * 0.6931471805599453f; }
__device__ __forceinline__ float siluf(float g) { return g * frcp(1.f + fexp(-g)); }
__device__ __forceinline__ float sigmf(float x) { return frcp(1.f + fexp(-x)); }
__device__ __forceinline__ float softplusf(float z) { return fmaxf(z, 0.f) + flog(1.f + fexp(-fabsf(z))); }
__device__ __forceinline__ float ftanh(float x) { return 1.f - 2.f * frcp(fexp(2.f * x) + 1.f); }

__device__ __forceinline__ int colmap_in(int n) {
    if (n < 1152) return n;
    if (n < 1158) return HC_FF + (n - 1152);
    if (n < 1542) return HC_FG + (n - 1158);
    if (n < 3142) { const int m = n - 1542;
        if (m < 1152) return HC_RR + m;
        if (m < 1184) return HC_WD + (m - 1152);
        if (m < 1216) return HC_AD + (m - 1184);
        return HC_RG + (m - 1216); }
    return HC_MQ + (n - 3142);
}
template <int MODE>
__device__ __forceinline__ void transpose_item(const float* W, int K, int N, bf16* WT, LAS float* scr, int item, int lane) {
    const int nblk = (N + 31) / 32, kb = item / nblk, nb = item % nblk, k0 = 64 * kb, n0 = 32 * nb;
    const int nl0 = lane & 31; const bool okn = (n0 + nl0) < N;
#pragma unroll 8
    for (int i = 0; i < 32; ++i) { const int kk = 2 * i + (lane >> 5); scr[kk * 33 + nl0] = okn ? W[(size_t)(k0 + kk) * N + n0 + nl0] : 0.f; }
    LDS_WAIT(); asm volatile("" ::: "memory");
    const int c = lane & 7;
#pragma unroll
    for (int j = 0; j < 4; ++j) { const int nl = (lane >> 3) + 8 * j, n = n0 + nl; const LAS float* s = scr + (8 * c) * 33 + nl;
        v4u o; o.x = pk2(s[0 * 33], s[1 * 33]); o.y = pk2(s[2 * 33], s[3 * 33]); o.z = pk2(s[4 * 33], s[5 * 33]); o.w = pk2(s[6 * 33], s[7 * 33]);
        if (n < N) { const int row = (MODE == 0) ? colmap_in(n) : n; *(v4u*)(WT + (size_t)row * K + k0 + 8 * c) = o; } }
    LDS_WAIT(); asm volatile("" ::: "memory");
}
__device__ __forceinline__ void rms_row_to_bf16(const float* xrow, const float* g, bf16* orow, int lane) {
    const f32x4* xr = (const f32x4*)xrow + lane; const f32x4* gr = (const f32x4*)g + lane;
    f32x4 v[4]; float s = 0.f;
#pragma unroll
    for (int j = 0; j < 4; ++j) { v[j] = xr[64 * j]; s += (v[j].x * v[j].x + v[j].y * v[j].y) + (v[j].z * v[j].z + v[j].w * v[j].w); }
    const float rstd = frsq(wave_sum(s) * (1.f / DM) + NORM_EPS);
    unsigned long long* o8 = (unsigned long long*)orow + lane;
#pragma unroll
    for (int j = 0; j < 4; ++j) { const f32x4 gg = gr[64 * j]; const f32x4 y = v[j] * rstd * gg;
        o8[64 * j] = (unsigned long long)pk2(y.x, y.y) | ((unsigned long long)pk2(y.z, y.w) << 32); }
}
__device__ __forceinline__ void p0_prologue(const Ctx& F, const Args& a) {
    LAS float* scr = (LAS float*)(F.lds + RING_OFF + F.wave * 16384);
    const int gw = F.vcu * NWAVES + F.wave, NGW = F.G * NWAVES;
    bf16* WinT = (bf16*)(a.ws + WS_WIN); bf16* WoutT = (bf16*)(a.ws + WS_WOUT); bf16* WmemT = (bf16*)(a.ws + WS_WMEM);
    constexpr int I_IN = (DM / 64) * ((NIN + 31) / 32), I_OUT = (DM / 64) * (DM / 32), I_MEM = (DM / 64) * (512 / 32);
    for (int it = gw; it < I_IN + I_OUT + I_MEM; it += NGW) {
        int r = it;
        if (r < I_IN) { transpose_item<0>(a.in[I_WIN], DM, NIN, WinT, scr, r, F.lane); continue; } r -= I_IN;
        if (r < I_OUT) { transpose_item<1>(a.in[I_WOUT], DM, DM, WoutT, scr, r, F.lane); continue; } r -= I_OUT;
        transpose_item<1>(a.in[I_WMKV], DM, 512, WmemT, scr, r, F.lane);
    }
    for (int r = NIN + gw; r < NP; r += NGW) { v4u z = {0u, 0u, 0u, 0u}; v4u* p = (v4u*)(WinT + (size_t)r * DM); p[F.lane] = z; p[F.lane + 64] = z; }
    bf16* XN = (bf16*)(a.ws + WS_XN); bf16* MEMN = (bf16*)(a.ws + WS_MEMN);
    for (int m0 = 2 * gw; m0 < MT + BATCH * NMEM; m0 += 2 * NGW) {
        const float* xr = (m0 < MP) ? a.in[I_XP] + (size_t)m0 * DM : (m0 < MT) ? a.in[I_XS] + (size_t)(m0 - MP) * DM : a.in[I_MEMP] + (size_t)(m0 - MT) * DM;
        const f32x4* gr = (const f32x4*)((m0 < MT) ? a.in[I_NG] : a.in[I_MNG]) + F.lane;
        unsigned long long* o8 = (unsigned long long*)((m0 < MT) ? XN + (size_t)m0 * DM : MEMN + (size_t)(m0 - MT) * DM) + F.lane;
        f32x4 v0[4], v1[4]; float s0 = 0.f, s1 = 0.f;
#pragma unroll
        for (int j = 0; j < 4; ++j) { v0[j] = ((const f32x4*)xr)[F.lane + 64 * j]; v1[j] = ((const f32x4*)xr)[256 + F.lane + 64 * j]; }
#pragma unroll
        for (int j = 0; j < 4; ++j) { s0 += (v0[j].x * v0[j].x + v0[j].y * v0[j].y) + (v0[j].z * v0[j].z + v0[j].w * v0[j].w); s1 += (v1[j].x * v1[j].x + v1[j].y * v1[j].y) + (v1[j].z * v1[j].z + v1[j].w * v1[j].w); }
#pragma unroll
        for (int o = 1; o < 64; o <<= 1) { s0 += __shfl_xor(s0, o); s1 += __shfl_xor(s1, o); }
        const float r0 = frsq(s0 * (1.f / DM) + NORM_EPS), r1 = frsq(s1 * (1.f / DM) + NORM_EPS);
#pragma unroll
        for (int j = 0; j < 4; ++j) { const f32x4 gg = gr[64 * j]; const f32x4 y0 = v0[j] * r0 * gg, y1 = v1[j] * r1 * gg;
            o8[64 * j] = (unsigned long long)pk2(y0.x, y0.y) | ((unsigned long long)pk2(y0.z, y0.w) << 32);
            o8[256 + 64 * j] = (unsigned long long)pk2(y1.x, y1.y) | ((unsigned long long)pk2(y1.z, y1.w) << 32); }
    }
}

__device__ __forceinline__ float wave_incl_scan(float v, int lane) {
#pragma unroll
    for (int o = 1; o < 64; o <<= 1) { const float n = __shfl_up(v, o); if (lane >= o) v += n; }
    return v;
}
constexpr int NBLK_PREP = MT / 64 + BATCH * NMEM / 64;
__device__ __forceinline__ void prep_block_task(LAS unsigned char* lds, const Args& a, int blk, int tid, int lane, int wave) {
    bf16* H = (bf16*)(a.ws + WS_H); bf16* MKV = (bf16*)(a.ws + WS_MKV); float* out = a.out;
    LAS float* LF = (LAS float*)lds;
    const int l8 = (lane & 7) * 8;
    __syncthreads();
    if (blk < MT / 64) {
        float gq[8], gk[8], gm[8];
        ld8(a.in[I_FQG] + l8, gq); ld8(a.in[I_FKG] + l8, gk); ld8(a.in[I_MQG] + l8, gm);
#pragma unroll
        for (int e = 0; e < 8; ++e) { gq[e] *= C2; gm[e] *= C2; }
        { constexpr int i0 = 0;
            v4u rq4[8], rk4[8], rv4[8], rm4[8]; float rf[8];
#pragma unroll
            for (int i = 0; i < 8; ++i) { const bf16* hr = H + (size_t)(blk * 64 + wave * 8 + i0 + i) * NP;
                if (lane < 48) { rq4[i] = *(const v4u*)(hr + HC_FQ + lane * 8); rk4[i] = *(const v4u*)(hr + HC_FK + lane * 8); rv4[i] = *(const v4u*)(hr + HC_FV + lane * 8); }
                if (lane < 32) rm4[i] = *(const v4u*)(hr + HC_MQ + lane * 8);
                rf[i] = (lane < 6) ? bf2f(hr[HC_FF + lane]) : 0.f; }
#pragma unroll
            for (int i = 0; i < 8; ++i) {
                const int rl = wave * 8 + i0 + i, m = blk * 64 + rl; bf16* hr = H + (size_t)m * NP;
                float* ok = (m < MP) ? out + O_FKP + (size_t)m * 384 : out + O_FKS + (size_t)(m - MP) * 384;
                float* ov = (m < MP) ? out + O_FVP + (size_t)m * 384 : out + O_FVS + (size_t)(m - MP) * 384;
                float* ol = (m < MP) ? out + O_FLP + (size_t)m * 6 : out + O_FLS + (size_t)(m - MP) * 6;
                if (lane < 48) {
                    float q[8], k[8], v[8];
                    unpack8(rq4[i], q); unpack8(rk4[i], k); unpack8(rv4[i], v);
                    float sq = 0.f, sk = 0.f;
#pragma unroll
                    for (int e = 0; e < 8; ++e) { sq += q[e] * q[e]; sk += k[e] * k[e]; }
                    sq = sum8(sq); sk = sum8(sk);
                    const float rq = frsq(sq * (1.f / 64.f) + NORM_EPS), rk = frsq(sk * (1.f / 64.f) + NORM_EPS);
#pragma unroll
                    for (int e = 0; e < 8; ++e) { q[e] = q[e] * rq * gq[e]; k[e] = k[e] * rk * gk[e]; }
                    v4u wq, wk; wq.x = pk2(q[0], q[1]); wq.y = pk2(q[2], q[3]); wq.z = pk2(q[4], q[5]); wq.w = pk2(q[6], q[7]);
                    wk.x = pk2(k[0], k[1]); wk.y = pk2(k[2], k[3]); wk.z = pk2(k[4], k[5]); wk.w = pk2(k[6], k[7]);
                    *(v4u*)(hr + HC_FQ + lane * 8) = wq; *(v4u*)(hr + HC_FK + lane * 8) = wk;
                    *(f32x4*)(ok + lane * 8) = (f32x4){k[0], k[1], k[2], k[3]}; *(f32x4*)(ok + lane * 8 + 4) = (f32x4){k[4], k[5], k[6], k[7]};
                    *(f32x4*)(ov + lane * 8) = (f32x4){v[0], v[1], v[2], v[3]}; *(f32x4*)(ov + lane * 8 + 4) = (f32x4){v[4], v[5], v[6], v[7]};
                }
                if (lane < 32) {
                    float q[8]; unpack8(rm4[i], q);
                    float sq = 0.f;
#pragma unroll
                    for (int e = 0; e < 8; ++e) sq += q[e] * q[e];
                    sq = sum8(sq); const float rq = frsq(sq * (1.f / 64.f) + NORM_EPS);
                    v4u wq; wq.x = pk2(q[0] * rq * gm[0], q[1] * rq * gm[1]); wq.y = pk2(q[2] * rq * gm[2], q[3] * rq * gm[3]); wq.z = pk2(q[4] * rq * gm[4], q[5] * rq * gm[5]); wq.w = pk2(q[6] * rq * gm[6], q[7] * rq * gm[7]);
                    *(v4u*)(hr + HC_MQ + lane * 8) = wq;
                }
                if (lane < 6) { const float z = rf[i] + a.in[I_FBF][lane]; const float lf = -softplusf(-z); ol[lane] = lf; LF[rl * 8 + lane] = lf; }
            }
        }
        __syncthreads();
        if (blk < MP / 64 && wave < 6) {
            const int b = blk / (SEQ / 64), kb = blk % (SEQ / 64);
            const float incl = wave_incl_scan(LF[lane * 8 + wave], lane);
            ((float*)(a.ws + WS_NCKP))[(size_t)(b * 6 + wave) * SEQ + kb * 64 + lane] = incl;
            if (lane == 63) ((float*)(a.ws + WS_NCKS))[(b * 6 + wave) * 64 + kb] = incl;
        }
    } else {
        float gk[8]; ld8(a.in[I_MKG] + l8, gk);
#pragma unroll 2
        for (int i = 0; i < 8; ++i) {
            const int mm = (blk - MT / 64) * 64 + wave * 8 + i; bf16* kr = MKV + (size_t)mm * 512;
            if (lane < 32) {
                float k[8], v[8]; unpack8(*(const v4u*)(kr + lane * 8), k); unpack8(*(const v4u*)(kr + 256 + lane * 8), v);
                float sk = 0.f;
#pragma unroll
                for (int e = 0; e < 8; ++e) sk += k[e] * k[e];
                sk = sum8(sk); const float rk = frsq(sk * (1.f / 64.f) + NORM_EPS);
#pragma unroll
                for (int e = 0; e < 8; ++e) k[e] = k[e] * rk * gk[e];
                v4u wk; wk.x = pk2(k[0], k[1]); wk.y = pk2(k[2], k[3]); wk.z = pk2(k[4], k[5]); wk.w = pk2(k[6], k[7]);
                *(v4u*)(kr + lane * 8) = wk;
                float* okm = out + O_MKP + (size_t)mm * 256 + lane * 8; float* ovm = out + O_MVP + (size_t)mm * 256 + lane * 8;
                *(f32x4*)okm = (f32x4){k[0], k[1], k[2], k[3]}; *(f32x4*)(okm + 4) = (f32x4){k[4], k[5], k[6], k[7]};
                *(f32x4*)ovm = (f32x4){v[0], v[1], v[2], v[3]}; *(f32x4*)(ovm + 4) = (f32x4){v[4], v[5], v[6], v[7]};
            }
        }
    }
}

typedef float f32x16 __attribute__((ext_vector_type(16)));
typedef unsigned u32x2 __attribute__((ext_vector_type(2)));
__device__ __forceinline__ int crow(int r, int hi) { return (r & 3) + 8 * (r >> 2) + 4 * hi; }

struct AttnP { const bf16* Q; int qpitch; const bf16* K; int kpitch; const bf16* V; int vpitch; const float* nck; const float* bt; const float* gq; const float* gk; const bf16* Gt; int gpitch; bf16* O; int opitch; int nt; int q0; int causal; };
constexpr int AT_KS = 0, AT_VT = 9216, AT_NK = 18432, AT_BUF = 18688, AT_PS = 2 * AT_BUF, AT_AL = AT_PS + 8 * 4608;
constexpr int NQ_AT = 768 + 512;
struct AttnPf { float btv, nq0; };
__device__ __forceinline__ void attn_prefetch(AttnPf& pf, const Args& a, int tk, int lane) {
    pf.btv = 0.f; pf.nq0 = 0.f;
    if (tk < 768) { const int qb = 15 - (tk & 15), bh = tk >> 4;
        pf.btv = (lane < 4 * (qb + 1)) ? ((const float*)(a.ws + WS_NCKS))[(size_t)bh * 64 + lane] : 0.f;
        pf.nq0 = ((const float*)(a.ws + WS_NCKP))[(size_t)bh * SEQ + qb * 256]; }
}
constexpr int A6_SLOTB = 8192, A6_K = 0, A6_V = 3 * A6_SLOTB, A6_WS = 6 * A6_SLOTB, A6_OST = A6_WS + 8 * 256, A6_NK = A6_OST + 8 * 8192, A6_END = A6_NK + 3 * 2048;
static_assert(A6_END <= RING_BYTES, "attention LDS map");
typedef short s16x4 __attribute__((ext_vector_type(4)));
typedef LAS const char* lds_cptr;
#define A6_SBAR() __builtin_amdgcn_sched_barrier(0)
#define A6_PIN(x) asm volatile("" : "+v"(x))
#define A6_MFMA(a, b, c) __builtin_amdgcn_mfma_f32_32x32x16_bf16(a, b, c, 0, 0, 0)
#define A6_WAIT_BAR(N) asm volatile("s_waitcnt vmcnt(" #N ") lgkmcnt(0)\n\ts_barrier" ::: "memory")
__device__ __forceinline__ void a6_glds16(const void* g, unsigned lds_base) {
    unsigned sv; asm volatile("s_mov_b32 %0, m0\n\ts_mov_b32 m0, %2\n\ts_nop 0\n\tglobal_load_lds_dwordx4 %1, off\n\ts_mov_b32 m0, %0" : "=&s"(sv) : "v"(g), "s"(lds_base) : "memory"); }
__device__ __forceinline__ void a6_glds4(const void* g, unsigned lds_base) {
    unsigned sv; asm volatile("s_mov_b32 %0, m0\n\ts_mov_b32 m0, %2\n\ts_nop 0\n\tglobal_load_lds_dword %1, off\n\ts_mov_b32 m0, %0" : "=&s"(sv) : "v"(g), "s"(lds_base) : "memory"); }
__device__ __forceinline__ void a6_kload2(bf16x8* kf, lds_cptr kp, int d0) { kf[2 * d0] = *(LAS const bf16x8*)(kp + d0 * 2048); kf[2 * d0 + 1] = *(LAS const bf16x8*)(kp + d0 * 2048 + 512); }
__device__ __forceinline__ s16x4 a6_vtr(lds_cptr p) { return __builtin_bit_cast(s16x4, __builtin_amdgcn_ds_read_tr16_b64_v4i16((LAS s16x4*)p)); }
#define A6_MX3(a, b, c) __builtin_fmaxf(__builtin_fmaxf((a), (b)), (c))
__device__ __forceinline__ float a6_rowmax(const f32x16& p0, const f32x16& p1) {
    float a = A6_MX3(p0[0], p0[1], p1[0]), b = A6_MX3(p0[2], p0[3], p1[1]); a = A6_MX3(a, p1[2], p1[3]);
#pragma unroll
    for (int r = 4; r < 16; r += 4) { a = A6_MX3(a, p0[r], p0[r + 1]); b = A6_MX3(b, p0[r + 2], p0[r + 3]); a = A6_MX3(a, p1[r], p1[r + 1]); b = A6_MX3(b, p1[r + 2], p1[r + 3]); }
    float m = __builtin_fmaxf(a, b); auto rr = __builtin_amdgcn_permlane32_swap(__float_as_uint(m), __float_as_uint(m), false, false);
    return __builtin_fmaxf(__uint_as_float(rr[0]), __uint_as_float(rr[1])); }
__device__ __forceinline__ void a6_cmask(f32x16& p0, f32x16& p1, int jb, int qrel, int hi) {
    const int qk = qrel - 64 * jb - 4 * hi;
#pragma unroll
    for (int r = 0; r < 16; ++r) { const int kc = (r & 3) + 8 * (r >> 2); if (kc > qk) p0[r] = -INFINITY; if (kc + 32 > qk) p1[r] = -INFINITY; } }

template <bool BIAS, bool CAUSAL>
__device__ __forceinline__ void attn64_unit(LAS unsigned char* lds, const bf16* Qw, int qpitch, const bf16* K, int kpitch, const bf16* V, int vpitch, const float* nck, float pre, int t0, float cq0, float mhat0,
                                            int NT, const bf16* Gw, int gpitch, bf16* Ow, int opitch, const Args& a, AttnPf& pfn, volatile LAS unsigned* nextw, int& nx, int tid, int lane, int wid) {
    asm volatile("" : "+v"(lane));
    const int r32 = lane & 31, hi = lane >> 5;
    const unsigned lds0 = (unsigned)(size_t)lds; LAS float* wsf = (LAS float*)(lds + A6_WS) + wid * 64; LAS float* wsfh = wsf + 4 * hi;
    const bf16* ksrc = K + (size_t)lane * kpitch + wid * 8;
    const bf16* vsrc = V + (size_t)(16 * (wid & 3) + (lane >> 2)) * vpitch + (wid >> 2) * 32 + (lane & 3) * 8;
    const float* nsrc = nck + lane;
    const unsigned kdst = lds0 + A6_K + wid * 1024, vdst = lds0 + A6_V + wid * 1024, ndst = lds0 + A6_NK + wid * 256;
#define DMA_K(t, slot) do { a6_glds16(ksrc + (size_t)(t) * 64 * kpitch, (unsigned)__builtin_amdgcn_readfirstlane(kdst + (slot))); \
                            if (BIAS) a6_glds4(nsrc + (t) * 64, (unsigned)__builtin_amdgcn_readfirstlane(ndst + ((slot) >> 2))); } while (0)
#define DMA_V(t, slot) a6_glds16(vsrc + (size_t)(t) * 64 * vpitch, (unsigned)__builtin_amdgcn_readfirstlane(vdst + (slot)))
    const lds_cptr vp0 = (lds_cptr)lds + A6_V + ((lane >> 4) & 1) * 32 + (lane & 3) * 8 + (4 * hi + ((lane & 15) >> 2)) * 64;
    const lds_cptr kp0 = (lds_cptr)lds + A6_K + hi * 1024 + r32 * 16;
    const lds_cptr np0 = (lds_cptr)lds + A6_NK + wid * 256 + hi * 16;
    bf16x8 qr[4];
#pragma unroll
    for (int d0 = 0; d0 < 4; ++d0) qr[d0] = *reinterpret_cast<const bf16x8*>(&Qw[(size_t)r32 * qpitch + d0 * 16 + hi * 8]);
    float mhat = mhat0, l_reg = 0.f; asm volatile("" : "+v"(mhat));
    DMA_K(0, 0); DMA_V(0, 0); DMA_K(1, A6_SLOTB); DMA_K(2, 2 * A6_SLOTB);
    f32x16 o[2]; o[0] = f32x16{}; o[1] = f32x16{};
    const int qrel = wid * 32 + r32; bool resc = false;
    f32x16 pA0, pA1, pB0, pB1; bf16x8 kf[8]; s16x4 vlo[8], vhi[8]; v4u pw0, pw1, pw2, pw3;
    int sl_prev = 0, sl_cur = 0, sl_next = A6_SLOTB;
#define ROT() do { sl_prev = sl_cur; sl_cur = sl_next; sl_next = (sl_next == 2 * A6_SLOTB) ? 0 : sl_next + A6_SLOTB; } while (0)
#define CTV(tt) (BIAS ? (cq0 - __int_as_float(__builtin_amdgcn_readlane(__float_as_int(pre), t0 + (tt)))) * LOG2E - mhat : -mhat)
#define BIASF(y, ct) (BIAS ? __builtin_fmaf((y), -LOG2E, (ct)) : (ct))
#define NKRD(P0, P1, slot) do { if (BIAS) { _Pragma("unroll") for (int g_ = 0; g_ < 4; ++g_) { const f32x4 a0_ = *(LAS const f32x4*)(np0 + ((slot) >> 2) + g_ * 32), a1_ = *(LAS const f32x4*)(np0 + ((slot) >> 2) + 128 + g_ * 32); \
        P0[4 * g_] = a0_.x; P0[4 * g_ + 1] = a0_.y; P0[4 * g_ + 2] = a0_.z; P0[4 * g_ + 3] = a0_.w; P1[4 * g_] = a1_.x; P1[4 * g_ + 1] = a1_.y; P1[4 * g_ + 2] = a1_.z; P1[4 * g_ + 3] = a1_.w; } } } while (0)
#define EX(v) __builtin_amdgcn_exp2f(v)
#define RESC() do { if (resc) { _Pragma("unroll") for (int d_ = 0; d_ < 2; ++d_) _Pragma("unroll") for (int r = 0; r < 16; ++r) o[d_][r] *= wsfh[(r & 3) + 8 * (r >> 2)]; } } while (0)
#define DECIDE(C0, C1, WITH_L) do { const float rm_ = a6_rowmax(C0, C1); resc = false; \
      if (__builtin_expect(__any(rm_ > 8.f), 0)) { const float dl_ = __builtin_fmaxf(rm_, 0.f); mhat += dl_; \
          _Pragma("unroll") for (int r = 0; r < 16; ++r) { C0[r] -= dl_; C1[r] -= dl_; } \
          if (WITH_L) { const float f_ = __builtin_amdgcn_exp2f(-dl_); l_reg *= f_; if (hi == 0) wsf[r32] = f_; resc = true; } } } while (0)
    if (BIAS) { A6_WAIT_BAR(5); } else { A6_WAIT_BAR(3); }
    nx = (int)*nextw; if (nx < NQ_AT) attn_prefetch(pfn, a, nx, lane);
    NKRD(pA0, pA1, 0);
    { const float ct = CTV(0);
#pragma unroll
      for (int r = 0; r < 16; ++r) { pA0[r] = BIASF(pA0[r], ct); pA1[r] = BIASF(pA1[r], ct); } }
    _Pragma("unroll") for (int d0 = 0; d0 < 4; ++d0) a6_kload2(kf, kp0, d0);
    pA0 = A6_MFMA(kf[0], qr[0], pA0); pA1 = A6_MFMA(kf[1], qr[0], pA1); pA0 = A6_MFMA(kf[2], qr[1], pA0); pA1 = A6_MFMA(kf[3], qr[1], pA1);
    pA0 = A6_MFMA(kf[4], qr[2], pA0); pA1 = A6_MFMA(kf[5], qr[2], pA1); pA0 = A6_MFMA(kf[6], qr[3], pA0); pA1 = A6_MFMA(kf[7], qr[3], pA1);
    if (CAUSAL && NT == 4) a6_cmask(pA0, pA1, 0, qrel, hi);
    DECIDE(pA0, pA1, false);
#pragma unroll
    for (int r = 0; r < 16; ++r) { pA0[r] = EX(pA0[r]); pA1[r] = EX(pA1[r]); }
    A6_WAIT_BAR(0);
    DMA_K(3, 0); DMA_V(1, A6_SLOTB); ROT();
    _Pragma("unroll") for (int d0 = 0; d0 < 4; ++d0) a6_kload2(kf, kp0 + sl_cur, d0);
    NKRD(pB0, pB1, sl_cur);
    { const float ct = CTV(1);
#pragma unroll
      for (int r = 0; r < 16; ++r) { pB0[r] = BIASF(pB0[r], ct); pB1[r] = BIASF(pB1[r], ct); } }
    if (BIAS) { A6_WAIT_BAR(3); } else { A6_WAIT_BAR(2); }
#define PKW(P, i) pk2(P[i], P[i + 1])
#define PAF(k) __builtin_bit_cast(bf16x8, pw##k)
#define VFR(i) (bf16x8){vlo[i][0], vlo[i][1], vlo[i][2], vlo[i][3], vhi[i][0], vhi[i][1], vhi[i][2], vhi[i][3]}
#define VRD(i) do { vlo[i] = a6_vtr(vp_ + (((i) >> 2) * 4096 + ((i) & 3) * 1024)); vhi[i] = a6_vtr(vp_ + (((i) >> 2) * 4096 + ((i) & 3) * 1024 + 512)); } while (0)
#define KRD(G, d0) do { if (G) { a6_kload2(kf, kp0 + sl_next, d0); A6_SBAR(); } } while (0)
#define GAPA(MF, a0, a1, a2, a3, W0, W1, PW) do { MF; sacc += a0; sacc += a1; sacc += a2; sacc += a3; W0; W1; A6_PIN(PW); A6_PIN(sacc); A6_SBAR(); } while (0)
#define GAPB(MF, X, i, G, Y) do { MF; X[i] = EX(X[i]); X[i + 1] = EX(X[i + 1]); X[i + 2] = EX(X[i + 2]); X[i + 3] = EX(X[i + 3]); \
        if (G) { Y[i] = BIASF(Y[i], ctn); Y[i + 1] = BIASF(Y[i + 1], ctn); Y[i + 2] = BIASF(Y[i + 2], ctn); Y[i + 3] = BIASF(Y[i + 3], ctn); A6_PIN(Y); } A6_PIN(X); A6_SBAR(); } while (0)
#define STEP(C0, C1, P0, P1, t, MASK, GK, GV, GL) do { A6_SBAR(); \
    const lds_cptr vp_ = vp0 + sl_prev; \
    VRD(0); A6_SBAR(); float sacc = P0[0] + P0[1]; \
                       GAPA(C0 = A6_MFMA(kf[0], qr[0], C0), P0[2], P0[3], P0[4], P0[5],     pw0[0] = PKW(P0, 0),  pw0[1] = PKW(P0, 2),  pw0); \
    VRD(4); A6_SBAR(); GAPA(C1 = A6_MFMA(kf[1], qr[0], C1), P0[6], P0[7], P0[8], P0[9],     pw0[2] = PKW(P0, 4),  pw0[3] = PKW(P0, 6),  pw0); \
    VRD(1); A6_SBAR(); GAPA(C0 = A6_MFMA(kf[2], qr[1], C0), P0[10], P0[11], P0[12], P0[13], pw1[0] = PKW(P0, 8),  pw1[1] = PKW(P0, 10), pw1); \
    VRD(5); A6_SBAR(); GAPA(C1 = A6_MFMA(kf[3], qr[1], C1), P0[14], P0[15], P1[0], P1[1],   pw1[2] = PKW(P0, 12), pw1[3] = PKW(P0, 14), pw1); \
    VRD(2); A6_SBAR(); GAPA(C0 = A6_MFMA(kf[4], qr[2], C0), P1[2], P1[3], P1[4], P1[5],     pw2[0] = PKW(P1, 0),  pw2[1] = PKW(P1, 2),  pw2); \
    VRD(6); A6_SBAR(); GAPA(C1 = A6_MFMA(kf[5], qr[2], C1), P1[6], P1[7], P1[8], P1[9],     pw2[2] = PKW(P1, 4),  pw2[3] = PKW(P1, 6),  pw2); \
    VRD(3); A6_SBAR(); GAPA(C0 = A6_MFMA(kf[6], qr[3], C0), P1[10], P1[11], P1[12], P1[13], pw3[0] = PKW(P1, 8),  pw3[1] = PKW(P1, 10), pw3); \
    VRD(7); A6_SBAR(); GAPA(C1 = A6_MFMA(kf[7], qr[3], C1), P1[14], P1[15], 0.f, 0.f,       pw3[2] = PKW(P1, 12), pw3[3] = PKW(P1, 14), pw3); \
    l_reg += sacc; \
    if (GK) DMA_K((t) + 3, sl_cur); if (GV) DMA_V((t) + 1, sl_next); \
    if (GL) NKRD(P0, P1, sl_next);                                                       \
    if (MASK && CAUSAL) a6_cmask(C0, C1, (t) - (NT - 4), qrel, hi); \
    DECIDE(C0, C1, true); \
    const float ctn = CTV((t) + 1); A6_SBAR(); \
    GAPB(o[0] = A6_MFMA(PAF(0), VFR(0), o[0]), C0, 0, GL, P0);              GAPB(o[1] = A6_MFMA(PAF(0), VFR(4), o[1]), C0, 4, GL, P0); \
    KRD(GL, 0); GAPB(o[0] = A6_MFMA(PAF(1), VFR(1), o[0]), C0, 8, GL, P0);  KRD(GL, 1); GAPB(o[1] = A6_MFMA(PAF(1), VFR(5), o[1]), C0, 12, GL, P0); \
    KRD(GL, 2); GAPB(o[0] = A6_MFMA(PAF(2), VFR(2), o[0]), C1, 0, GL, P1);  KRD(GL, 3); GAPB(o[1] = A6_MFMA(PAF(2), VFR(6), o[1]), C1, 4, GL, P1); \
    GAPB(o[0] = A6_MFMA(PAF(3), VFR(3), o[0]), C1, 8, GL, P1);              GAPB(o[1] = A6_MFMA(PAF(3), VFR(7), o[1]), C1, 12, GL, P1); \
    } while (0)
#define STEADYW() do { if (BIAS) { A6_WAIT_BAR(3); } else { A6_WAIT_BAR(2); } } while (0)
    int t = 1;
    for (; t + 5 < NT; t += 2) {
        STEP(pB0, pB1, pA0, pA1, t, false, true, true, true);     STEADYW(); RESC(); ROT();
        STEP(pA0, pA1, pB0, pB1, t + 1, false, true, true, true); STEADYW(); RESC(); ROT();
    }
#define ENDW(tt) do { if ((tt) + 3 < NT) { STEADYW(); } else if ((tt) + 2 < NT) { A6_WAIT_BAR(1); } else { A6_WAIT_BAR(0); } } while (0)
    for (; t + 1 < NT; t += 2) {
        STEP(pB0, pB1, pA0, pA1, t, true, (t + 3 < NT), (t + 1 < NT), (t + 1 < NT));         ENDW(t);     RESC(); ROT();
        STEP(pA0, pA1, pB0, pB1, t + 1, true, (t + 4 < NT), (t + 2 < NT), (t + 2 < NT));     ENDW(t + 1); RESC(); ROT();
    }
    const int erow = lane >> 3, ech = lane & 7;
    v4u gt[4];
#pragma unroll
    for (int i = 0; i < 4; ++i) gt[i] = *(const v4u*)(Gw + (size_t)(i * 8 + erow) * gpitch + ech * 8);
    STEP(pB0, pB1, pA0, pA1, NT - 1, true, false, false, false); RESC();
    { float sacc = pB0[0] + pB0[1];
#pragma unroll
      for (int r = 2; r < 16; ++r) sacc += pB0[r];
#pragma unroll
      for (int r = 0; r < 16; ++r) sacc += pB1[r];
      l_reg += sacc;
      pw0 = (v4u){PKW(pB0, 0), PKW(pB0, 2), PKW(pB0, 4), PKW(pB0, 6)}; pw1 = (v4u){PKW(pB0, 8), PKW(pB0, 10), PKW(pB0, 12), PKW(pB0, 14)};
      pw2 = (v4u){PKW(pB1, 0), PKW(pB1, 2), PKW(pB1, 4), PKW(pB1, 6)}; pw3 = (v4u){PKW(pB1, 8), PKW(pB1, 10), PKW(pB1, 12), PKW(pB1, 14)};
      const lds_cptr vp_ = vp0 + sl_cur; _Pragma("unroll") for (int i = 0; i < 8; ++i) VRD(i);
      o[0] = A6_MFMA(PAF(0), VFR(0), o[0]); o[1] = A6_MFMA(PAF(0), VFR(4), o[1]); o[0] = A6_MFMA(PAF(1), VFR(1), o[0]); o[1] = A6_MFMA(PAF(1), VFR(5), o[1]);
      o[0] = A6_MFMA(PAF(2), VFR(2), o[0]); o[1] = A6_MFMA(PAF(2), VFR(6), o[1]); o[0] = A6_MFMA(PAF(3), VFR(3), o[0]); o[1] = A6_MFMA(PAF(3), VFR(7), o[1]); }
    { auto rr = __builtin_amdgcn_permlane32_swap(__float_as_uint(l_reg), __float_as_uint(l_reg), false, false); l_reg = __uint_as_float(rr[0]) + __uint_as_float(rr[1]); }
    if (hi == 0) wsf[32 + r32] = l_reg;
    asm volatile("s_waitcnt lgkmcnt(0)" ::: "memory"); __builtin_amdgcn_wave_barrier();
    LAS float* stg = (LAS float*)(lds + A6_OST) + wid * 2048; LAS float* stgh = stg + 4 * hi * 64 + r32;
#pragma unroll
    for (int r = 0; r < 16; ++r) { const int oc = (r & 3) + 8 * (r >> 2); const float rl = __builtin_amdgcn_rcpf(wsfh[32 + oc]);
        stgh[oc * 64] = o[0][r] * rl; stgh[oc * 64 + 32] = o[1][r] * rl; }
    asm volatile("s_waitcnt lgkmcnt(0)" ::: "memory"); __builtin_amdgcn_wave_barrier();
#pragma unroll
    for (int i = 0; i < 4; ++i) { const int row = i * 8 + erow;
        const f32x4 x0 = *(LAS const f32x4*)(stg + row * 64 + ech * 8), x1 = *(LAS const f32x4*)(stg + row * 64 + ech * 8 + 4); const v4u g = gt[i]; v4u w;
        w.x = pk2(x0.x * siluf(__uint_as_float(g.x << 16)), x0.y * siluf(__uint_as_float(g.x & 0xffff0000u)));
        w.y = pk2(x0.z * siluf(__uint_as_float(g.y << 16)), x0.w * siluf(__uint_as_float(g.y & 0xffff0000u)));
        w.z = pk2(x1.x * siluf(__uint_as_float(g.z << 16)), x1.y * siluf(__uint_as_float(g.z & 0xffff0000u)));
        w.w = pk2(x1.z * siluf(__uint_as_float(g.w << 16)), x1.w * siluf(__uint_as_float(g.w & 0xffff0000u)));
        *(v4u*)(Ow + (size_t)row * opitch + ech * 8) = w; }
    asm volatile("s_waitcnt lgkmcnt(0)\n\ts_barrier" ::: "memory");
#undef DMA_K
#undef DMA_V
#undef ROT
#undef CTV
#undef BIASF
#undef NKRD
#undef EX
#undef RESC
#undef DECIDE
#undef PKW
#undef PAF
#undef VFR
#undef VRD
#undef KRD
#undef ENDW
#undef STEADYW
#undef GAPA
#undef GAPB
#undef STEP
}

template <bool FOX>
__device__ __forceinline__ void attn_unit(LAS unsigned char* lds, const AttnP& p, const Args& a, const AttnPf& pf, AttnPf& pfn, volatile LAS unsigned* nextw, int& nx, float Bb, float Bm, int tid, int lane, int wave) {
    const int r32 = lane & 31;
    const bf16* Qw = p.Q + (size_t)(wave * 32) * p.qpitch; const bf16* Gw = p.Gt + (size_t)(wave * 32) * p.gpitch; bf16* Ow = p.O + (size_t)(wave * 32) * p.opitch;
    if constexpr (FOX) {
        const float btv = pf.btv; const float incl = wave_incl_scan(btv, lane); const float pre = incl - btv;
        const float cq0 = __shfl(pre, p.q0 >> 6) + pf.nq0;
        int t0 = 0;
#if FOX_SKIP
        const bool skip = (lane < (p.q0 >> 6)) && ((cq0 - incl) * LOG2E + 2.f * Bb < -150.f);
        t0 = __builtin_popcountll(__ballot(skip)) & ~1;
#endif
        const int qi = p.q0 + wave * 32 + r32;
        const float ci = __shfl(pre, qi >> 6) + p.nck[qi];
        const float mhat0 = (cq0 - ci) * LOG2E - fmaxf(Bb - 60.f, 0.f);
        attn64_unit<true, true>(lds, Qw, p.qpitch, p.K + (size_t)t0 * 64 * p.kpitch, p.kpitch, p.V + (size_t)t0 * 64 * p.vpitch, p.vpitch, p.nck + t0 * 64, pre, t0, cq0, mhat0, p.nt - t0,
                                Gw, p.gpitch, Ow, p.opitch, a, pfn, nextw, nx, tid, lane, wave);
    } else {
        attn64_unit<false, false>(lds, Qw, p.qpitch, p.K, p.kpitch, p.V, p.vpitch, nullptr, 0.f, 0, 0.f, -fmaxf(Bm - 60.f, 0.f), p.nt, Gw, p.gpitch, Ow, p.opitch, a, pfn, nextw, nx, tid, lane, wave);
    }
}

struct SmallP { const bf16* Q; int qpitch; const float* Kc; int kpitch; const float* Vc; int vpitch; int P; const float* lfp; const float* lfn; const bf16* Kn; const bf16* Vn; int npitch; const bf16* Gt; int gpitch; bf16* O; int opitch; };
__device__ __forceinline__ bf16x8 cvt8(const f32x4 a, const f32x4 b) { v4u w; w.x = pk2(a.x, a.y); w.y = pk2(a.z, a.w); w.z = pk2(b.x, b.y); w.w = pk2(b.z, b.w); return __builtin_bit_cast(bf16x8, w); }
constexpr int SA_M = 0, SA_L = 512, SA_O = 1024, SA_NCK = 33792;
__device__ __forceinline__ void sample_attn(LAS unsigned char* lds, const SmallP& p, int tid, int lane, int wave) {
    const int r32 = lane & 31, hi = lane >> 5, qrow = r32 & 15;
    bf16x8 qr[4];
    { const bf16* qp = p.Q + (size_t)qrow * p.qpitch;
#pragma unroll
      for (int d0 = 0; d0 < 4; ++d0) qr[d0] = *(const bf16x8*)(qp + 16 * d0 + 8 * hi); }
    f32x16 o0, o1;
#pragma unroll
    for (int r = 0; r < 16; ++r) { o0[r] = 0.f; o1[r] = 0.f; }
    float m_run = -INFINITY, l_run = 0.f;
    const int npast = p.P / 64, nt = npast + (p.Kn ? 1 : 0);
    LAS float* NCK = (LAS float*)(lds + SA_NCK);
    if (p.lfp) {
        LAS float* WTOT = (LAS float*)(lds + SA_NCK + 4608);
        __syncthreads();
        const float x0 = p.lfp[(size_t)(2 * tid) * 6], x1 = p.lfp[(size_t)(2 * tid + 1) * 6];
        const float incl = wave_incl_scan(x0 + x1, lane);
        if (lane == 63) WTOT[wave] = incl;
        __syncthreads();
        float before = 0.f, total = 0.f;
#pragma unroll
        for (int w = 0; w < 8; ++w) { const float tv = WTOT[w]; total += tv; before += (w < wave) ? tv : 0.f; }
        const float s1 = total - (before + incl);
        NCK[2 * tid + 1] = s1 * LOG2E; NCK[2 * tid] = (s1 + x1) * LOG2E;
        if (tid < 64) { float cum = 0.f; for (int i = 0; i <= tid && i < 16; ++i) cum += p.lfn[(size_t)i * 6]; NCK[1024 + tid] = (tid < 16) ? -cum * LOG2E : 0.f; }
        __syncthreads();
    }
    for (int t = wave; t < nt; t += 8) {
        const bool isnew = (t >= npast);
        f32x16 c0, c1;
        if (p.lfp) {
#pragma unroll
            for (int g = 0; g < 4; ++g) { const f32x4 a0 = *(const LAS f32x4*)(NCK + t * 64 + 8 * g + 4 * hi), a1 = *(const LAS f32x4*)(NCK + t * 64 + 32 + 8 * g + 4 * hi);
                c0[4 * g] = a0.x; c0[4 * g + 1] = a0.y; c0[4 * g + 2] = a0.z; c0[4 * g + 3] = a0.w; c1[4 * g] = a1.x; c1[4 * g + 1] = a1.y; c1[4 * g + 2] = a1.z; c1[4 * g + 3] = a1.w; }
        } else {
#pragma unroll
            for (int r = 0; r < 16; ++r) { c0[r] = 0.f; c1[r] = 0.f; }
        }
        if (!isnew) {
            const float* k0p = p.Kc + (size_t)(t * 64 + r32) * p.kpitch + 8 * hi; const float* k1p = k0p + (size_t)32 * p.kpitch;
#pragma unroll
            for (int d0 = 0; d0 < 4; ++d0) {
                const bf16x8 k0 = cvt8(*(const f32x4*)(k0p + 16 * d0), *(const f32x4*)(k0p + 16 * d0 + 4));
                const bf16x8 k1 = cvt8(*(const f32x4*)(k1p + 16 * d0), *(const f32x4*)(k1p + 16 * d0 + 4));
                c0 = __builtin_amdgcn_mfma_f32_32x32x16_bf16(k0, qr[d0], c0, 0, 0, 0);
                c1 = __builtin_amdgcn_mfma_f32_32x32x16_bf16(k1, qr[d0], c1, 0, 0, 0);
            }
        } else {
            const bf16* k0p = p.Kn + (size_t)(r32 & 15) * p.npitch + 8 * hi;
#pragma unroll
            for (int d0 = 0; d0 < 4; ++d0) {
                const bf16x8 k0 = *(const bf16x8*)(k0p + 16 * d0);
                c0 = __builtin_amdgcn_mfma_f32_32x32x16_bf16(k0, qr[d0], c0, 0, 0, 0);
            }
#pragma unroll
            for (int r = 0; r < 16; ++r) { const int kv = 4 * hi + (r & 3) + 8 * (r >> 2); if (kv > qrow) c0[r] = -INFINITY; c1[r] = -INFINITY; }
        }
        float mx = fmaxf(c0[0], c1[0]);
#pragma unroll
        for (int r = 1; r < 16; ++r) mx = fmaxf(mx, fmaxf(c0[r], c1[r]));
        mx = fmaxf(mx, __shfl_xor(mx, 32));
        const float mn = fmaxf(m_run, mx);
        const float alpha = __builtin_amdgcn_exp2f(m_run - mn);
        m_run = mn;
        float sum = 0.f;
#pragma unroll
        for (int r = 0; r < 16; ++r) { c0[r] = __builtin_amdgcn_exp2f(c0[r] - mn); c1[r] = __builtin_amdgcn_exp2f(c1[r] - mn); sum += c0[r] + c1[r]; }
        l_run = l_run * alpha + sum;
#pragma unroll
        for (int r = 0; r < 8; ++r) { const float al = __shfl(alpha, crow(r, hi)); o0[r] *= al; o1[r] *= al; }
#pragma unroll
        for (int blk = 0; blk < 2; ++blk) {
            if (isnew && blk == 1) break;
#pragma unroll
            for (int s = 0; s < 2; ++s) {
                v4u pw;
                if (blk == 0) { pw.x = pk2(c0[8 * s], c0[8 * s + 1]); pw.y = pk2(c0[8 * s + 2], c0[8 * s + 3]); pw.z = pk2(c0[8 * s + 4], c0[8 * s + 5]); pw.w = pk2(c0[8 * s + 6], c0[8 * s + 7]); }
                else          { pw.x = pk2(c1[8 * s], c1[8 * s + 1]); pw.y = pk2(c1[8 * s + 2], c1[8 * s + 3]); pw.z = pk2(c1[8 * s + 4], c1[8 * s + 5]); pw.w = pk2(c1[8 * s + 6], c1[8 * s + 7]); }
                const bf16x8 pa = __builtin_bit_cast(bf16x8, pw);
                float va[8], vb[8];
#pragma unroll
                for (int j = 0; j < 8; ++j) { const int kvl = 32 * blk + 16 * s + 8 * (j >> 2) + 4 * hi + (j & 3);
                    if (!isnew) { const float* vp = p.Vc + (size_t)(t * 64 + kvl) * p.vpitch; va[j] = vp[r32]; vb[j] = vp[32 + r32]; }
                    else { const bf16* vp = p.Vn + (size_t)(kvl & 15) * p.npitch; va[j] = bf2f(vp[r32]); vb[j] = bf2f(vp[32 + r32]); } }
                const bf16x8 v0 = cvt8((f32x4){va[0], va[1], va[2], va[3]}, (f32x4){va[4], va[5], va[6], va[7]});
                const bf16x8 v1 = cvt8((f32x4){vb[0], vb[1], vb[2], vb[3]}, (f32x4){vb[4], vb[5], vb[6], vb[7]});
                o0 = __builtin_amdgcn_mfma_f32_32x32x16_bf16(pa, v0, o0, 0, 0, 0);
                o1 = __builtin_amdgcn_mfma_f32_32x32x16_bf16(pa, v1, o1, 0, 0, 0);
            }
        }
    }
    l_run += __shfl_xor(l_run, 32);
    LAS float* MW = (LAS float*)(lds + SA_M); LAS float* LW = (LAS float*)(lds + SA_L); LAS float* OW = (LAS float*)(lds + SA_O);
    __syncthreads();
    if (lane < 16) { MW[wave * 16 + lane] = m_run; LW[wave * 16 + lane] = l_run; }
#pragma unroll
    for (int r = 0; r < 8; ++r) { const int q = crow(r, hi); OW[(wave * 16 + q) * 64 + r32] = o0[r]; OW[(wave * 16 + q) * 64 + 32 + r32] = o1[r]; }
    __syncthreads();
    { const int q = tid >> 5, d = tid & 31;
      float M = MW[q];
#pragma unroll
      for (int w = 1; w < 8; ++w) M = fmaxf(M, MW[w * 16 + q]);
      float L = 0.f, a0 = 0.f, a1 = 0.f;
#pragma unroll
      for (int w = 0; w < 8; ++w) { const float f = __builtin_amdgcn_exp2f(MW[w * 16 + q] - M); L += f * LW[w * 16 + q]; a0 += f * OW[(w * 16 + q) * 64 + d]; a1 += f * OW[(w * 16 + q) * 64 + 32 + d]; }
      const float g0 = bf2f(p.Gt[(size_t)q * p.gpitch + d]), g1 = bf2f(p.Gt[(size_t)q * p.gpitch + 32 + d]);
      p.O[(size_t)q * p.opitch + d] = (bf16)f2bf(a0 / L * siluf(g0)); p.O[(size_t)q * p.opitch + 32 + d] = (bf16)f2bf(a1 / L * siluf(g1)); }
}

constexpr int RW_R = 0, RW_W = 16384, RW_KT = 32768, RW_V = 49152, RW_KK = 65536, RW_KA = 81920, RW_G = 98304, RW_X = 114688;
struct RwkvP { const bf16* Hs; bf16* Os; int T; int h; const float* s0; const float* prev0; float* s_out; float* sh_out; };
__device__ __forceinline__ void rwkv_task(LAS unsigned char* lds, const Args& a, const RwkvP& p, int tid) {
    LAS float* AR = (LAS float*)(lds + RW_R); LAS float* AW = (LAS float*)(lds + RW_W); LAS float* AKT = (LAS float*)(lds + RW_KT); LAS float* AV = (LAS float*)(lds + RW_V);
    LAS float* AKK = (LAS float*)(lds + RW_KK); LAS float* AKA = (LAS float*)(lds + RW_KA); LAS float* AG = (LAS float*)(lds + RW_G); LAS float* AX = (LAS float*)(lds + RW_X);
    const int tt = tid >> 3, e8 = (tid & 7) * 8, h = p.h;
    const float* mu = a.in[I_MU];
    float S[8];
    if (p.s0) {
#pragma unroll
        for (int e = 0; e < 8; ++e) S[e] = p.s0[tt * 64 + e8 + e];
    } else {
#pragma unroll
        for (int e = 0; e < 8; ++e) S[e] = 0.f;
    }
    for (int c0 = 0; c0 < p.T; c0 += 64) {
        const int n = (p.T - c0) < 64 ? (p.T - c0) : 64;
        const bool act = tt < n; const int trow = c0 + tt;
        const bf16* cur = p.Hs + (size_t)trow * NP; const bf16* prv = cur - NP; const bool first = (trow == 0);
        if (act) {
#pragma unroll
            for (int e = 0; e < 8; ++e) { const int col = e8 + e; const float c = bf2f(cur[HC_WD + col]);
                const float pv = first ? (p.prev0 ? p.prev0[1152 + col] : 0.f) : bf2f(prv[HC_WD + col]);
                const float xs = c + (pv - c) * mu[1152 + col];
                AX[tt * 64 + col] = (col < 32) ? ftanh(xs) : xs; }
        }
        __syncthreads();
        if (act) {
            float lw[8], la[8];
            { const f32x4 w0a = *(const f32x4*)(a.in[I_W0] + h * 64 + e8), w0b = *(const f32x4*)(a.in[I_W0] + h * 64 + e8 + 4);
              const f32x4 a0a = *(const f32x4*)(a.in[I_A0] + h * 64 + e8), a0b = *(const f32x4*)(a.in[I_A0] + h * 64 + e8 + 4);
              lw[0] = w0a.x; lw[1] = w0a.y; lw[2] = w0a.z; lw[3] = w0a.w; lw[4] = w0b.x; lw[5] = w0b.y; lw[6] = w0b.z; lw[7] = w0b.w;
              la[0] = a0a.x; la[1] = a0a.y; la[2] = a0a.z; la[3] = a0a.w; la[4] = a0b.x; la[5] = a0b.y; la[6] = a0b.z; la[7] = a0b.w; }
#pragma unroll 2
            for (int j = 0; j < 32; ++j) {
                const float tw = AX[tt * 64 + j], ta = AX[tt * 64 + 32 + j];
                const f32x4 u0 = *(const f32x4*)(a.in[I_WUP] + j * 384 + h * 64 + e8), u1 = *(const f32x4*)(a.in[I_WUP] + j * 384 + h * 64 + e8 + 4);
                const f32x4 p0 = *(const f32x4*)(a.in[I_AUP] + j * 384 + h * 64 + e8), p1 = *(const f32x4*)(a.in[I_AUP] + j * 384 + h * 64 + e8 + 4);
                lw[0] += tw * u0.x; lw[1] += tw * u0.y; lw[2] += tw * u0.z; lw[3] += tw * u0.w; lw[4] += tw * u1.x; lw[5] += tw * u1.y; lw[6] += tw * u1.z; lw[7] += tw * u1.w;
                la[0] += ta * p0.x; la[1] += ta * p0.y; la[2] += ta * p0.z; la[3] += ta * p0.w; la[4] += ta * p1.x; la[5] += ta * p1.y; la[6] += ta * p1.z; la[7] += ta * p1.w;
            }
            float kk[8], aa[8]; float ss = 0.f;
            const int c8 = h * 64 + e8;
            float rs[8], ks[8], vs[8], gs[8];
            { float cu[8], pv[8], mm[8];
#define RW_SHIFT(dst, HC, MUOFF) do { unpack8(*(const v4u*)(cur + (HC) + c8), cu); \
                if (first) { if (p.prev0) ld8(p.prev0 + (MUOFF) + c8, pv); else { _Pragma("unroll") for (int e = 0; e < 8; ++e) pv[e] = 0.f; } } \
                else unpack8(*(const v4u*)(prv + (HC) + c8), pv); \
                ld8(mu + (MUOFF) + c8, mm); \
                _Pragma("unroll") for (int e = 0; e < 8; ++e) dst[e] = cu[e] + (pv[e] - cu[e]) * mm[e]; } while (0)
              RW_SHIFT(rs, HC_RR, 0); RW_SHIFT(ks, HC_RK, 384); RW_SHIFT(vs, HC_RV, 768); RW_SHIFT(gs, HC_RG, 1216);
#undef RW_SHIFT
            }
            float kkw[8], kaw[8];
            ld8(a.in[I_KK] + c8, kkw); ld8(a.in[I_KA] + c8, kaw);
#pragma unroll
            for (int e = 0; e < 8; ++e) { const int d = e8 + e;
                const float wraw = -softplusf(-lw[e]) - 0.5f; const float dec = fexp(-fexp(wraw));
                const float av = sigmf(la[e]);
                kk[e] = ks[e] * kkw[e]; ss += kk[e] * kk[e]; aa[e] = av;
                AR[tt * 64 + d] = rs[e]; AW[tt * 64 + d] = dec; AKT[tt * 64 + d] = ks[e] * (1.f + (av - 1.f) * kaw[e]); AV[tt * 64 + d] = vs[e]; AG[tt * 64 + d] = gs[e];
            }
            ss = sum8(ss); const float rn = frsq(fmaxf(ss, 1e-24f));
#pragma unroll
            for (int e = 0; e < 8; ++e) { const float k2 = kk[e] * rn; AKK[tt * 64 + e8 + e] = k2; AKA[tt * 64 + e8 + e] = k2 * aa[e]; }
        }
        __syncthreads();
        for (int t = 0; t < n; ++t) {
            const f32x4 k0 = *(const LAS f32x4*)(AKK + t * 64 + e8), k1 = *(const LAS f32x4*)(AKK + t * 64 + e8 + 4);
            const f32x4 w0 = *(const LAS f32x4*)(AW + t * 64 + e8), w1 = *(const LAS f32x4*)(AW + t * 64 + e8 + 4);
            const f32x4 b0 = *(const LAS f32x4*)(AKA + t * 64 + e8), b1 = *(const LAS f32x4*)(AKA + t * 64 + e8 + 4);
            const f32x4 x0 = *(const LAS f32x4*)(AKT + t * 64 + e8), x1 = *(const LAS f32x4*)(AKT + t * 64 + e8 + 4);
            const f32x4 r0 = *(const LAS f32x4*)(AR + t * 64 + e8), r1 = *(const LAS f32x4*)(AR + t * 64 + e8 + 4);
            const float vv = AV[t * 64 + tt];
            float sa = S[0] * k0.x + S[1] * k0.y + S[2] * k0.z + S[3] * k0.w + S[4] * k1.x + S[5] * k1.y + S[6] * k1.z + S[7] * k1.w;
            sa = -sum8(sa);
            S[0] = S[0] * w0.x + sa * b0.x + vv * x0.x; S[1] = S[1] * w0.y + sa * b0.y + vv * x0.y; S[2] = S[2] * w0.z + sa * b0.z + vv * x0.z; S[3] = S[3] * w0.w + sa * b0.w + vv * x0.w;
            S[4] = S[4] * w1.x + sa * b1.x + vv * x1.x; S[5] = S[5] * w1.y + sa * b1.y + vv * x1.y; S[6] = S[6] * w1.z + sa * b1.z + vv * x1.z; S[7] = S[7] * w1.w + sa * b1.w + vv * x1.w;
            float y = S[0] * r0.x + S[1] * r0.y + S[2] * r0.z + S[3] * r0.w + S[4] * r1.x + S[5] * r1.y + S[6] * r1.z + S[7] * r1.w;
            y = sum8(y);
            if ((tid & 7) == 0) AX[t * 64 + tt] = y;
        }
        __syncthreads();
        {
            float y[8], sm = 0.f, bn = 0.f;
#pragma unroll
            for (int e = 0; e < 8; ++e) { y[e] = AX[tt * 64 + e8 + e]; sm += y[e]; bn += AR[tt * 64 + e8 + e] * AKT[tt * 64 + e8 + e] * a.in[I_RK][h * 64 + e8 + e]; }
            sm = sum8(sm) * (1.f / 64.f); bn = sum8(bn);
            float var = 0.f;
#pragma unroll
            for (int e = 0; e < 8; ++e) { const float d = y[e] - sm; var += d * d; }
            var = sum8(var) * (1.f / 64.f);
            const float rstd = frsq(var + GN_EPS);
            if (act) {
                v4u o; unsigned w[4];
#pragma unroll
                for (int e = 0; e < 8; e += 2) { const int c = h * 64 + e8 + e;
                    const float o0 = ((y[e] - sm) * rstd * a.in[I_GNW][c] + a.in[I_GNB][c] + bn * AV[tt * 64 + e8 + e]) * siluf(AG[tt * 64 + e8 + e]);
                    const float o1 = ((y[e + 1] - sm) * rstd * a.in[I_GNW][c + 1] + a.in[I_GNB][c + 1] + bn * AV[tt * 64 + e8 + e + 1]) * siluf(AG[tt * 64 + e8 + e + 1]);
                    w[e >> 1] = pk2(o0, o1); }
                o.x = w[0]; o.y = w[1]; o.z = w[2]; o.w = w[3];
                *(v4u*)(p.Os + (size_t)trow * DM + 384 + h * 64 + e8) = o;
            }
        }
        __syncthreads();
    }
#pragma unroll
    for (int e = 0; e < 8; ++e) p.s_out[tt * 64 + e8 + e] = S[e];
    if (p.sh_out) { const bf16* last = p.Hs + (size_t)(p.T - 1) * NP;
        for (int m = tid; m < 1600; m += 512) { const int c = (m < 1152) ? HC_RR + m : (m < 1184) ? HC_WD + (m - 1152) : (m < 1216) ? HC_AD + (m - 1184) : HC_RG + (m - 1216);
            p.sh_out[m] = bf2f(last[c]); } }
}


constexpr int NCH = SEQ / 64;
constexpr int NTASK_RWC = BATCH * 6 * NCH;
constexpr size_t WS_QE = 344 * MiB;
constexpr size_t WS_YL = WS_QE + (size_t)NTASK_RWC * 8192;
constexpr size_t WS_PT = WS_YL + (size_t)NTASK_RWC * 8192;
constexpr size_t WS_SC = WS_PT + (size_t)NTASK_RWC * 8192;
constexpr size_t WS_SL = WS_SC + (size_t)NTASK_RWC * 8192;
constexpr size_t WS_BON = WS_SL + (size_t)NTASK_RWC * 16384;
constexpr size_t WS_END2 = WS_BON + (size_t)NTASK_RWC * 256;
static_assert(WS_END2 <= 512 * MiB, "d_ws map (chunked RWKV)");

constexpr int LC_AX = 0, LC_G = 16384, LC_AT = 32768, LC_M0 = 49152, LC_MS = 9216, LC_GAM = LC_M0 + 10 * LC_MS;
#define LC_M(i) (LC_M0 + (i) * LC_MS)
typedef float f32x4v __attribute__((ext_vector_type(4)));

__device__ __forceinline__ void mm_nt(f32x4 (&acc)[2], const LAS unsigned char* X, const LAS unsigned char* Y, int bi, int bj0, int fr, int fq) {
#pragma unroll
    for (int ks = 0; ks < 2; ++ks) {
        const bf16x8 a = *(const LAS bf16x8*)(X + (16 * bi + fr) * 144 + 64 * ks + 16 * fq);
#pragma unroll
        for (int n = 0; n < 2; ++n) {
            const bf16x8 b = *(const LAS bf16x8*)(Y + (16 * (bj0 + n) + fr) * 144 + 64 * ks + 16 * fq);
            acc[n] = __builtin_amdgcn_mfma_f32_16x16x32_bf16(a, b, acc[n], 0, 0, 0);
        }
    }
}
#define ACC_ZERO(a) do { a[0] = (f32x4){0.f, 0.f, 0.f, 0.f}; a[1] = (f32x4){0.f, 0.f, 0.f, 0.f}; } while (0)
__device__ __forceinline__ void st_bf16_tile(LAS unsigned char* M, const f32x4 (&acc)[2], int bi, int bj0, int fr, int fq) {
#pragma unroll
    for (int n = 0; n < 2; ++n)
#pragma unroll
        for (int rg = 0; rg < 4; ++rg) *(LAS unsigned short*)(M + (16 * bi + 4 * fq + rg) * 144 + (16 * (bj0 + n) + fr) * 2) = (unsigned short)f2bf(acc[n][rg]);
}
__device__ __forceinline__ void copy_tile_bf16(bf16* dst, const LAS unsigned char* M, int tid) {
    const int row = tid >> 3, pc = tid & 7;
    *(v4u*)(dst + row * 64 + pc * 8) = *(const LAS v4u*)(M + row * 144 + pc * 16);
}

struct RwcP { const bf16* Hs; int h; int c0; size_t task; };
constexpr int RWC_Q0 = MT / 64 + BATCH * NMEM / 64;
struct RwcIn { v4u wdc, wdp, rc, rp, kc, kp, vc, vp; f32x4 wu, au; };
__device__ __forceinline__ void rwkv_local_load(RwcIn& in, const Args& a, const RwcP& p, int tid) {
    const int tt = tid >> 3, e8 = (tid & 7) * 8, c8 = p.h * 64 + e8; const int trow = p.c0 + tt;
    const bf16* cur = p.Hs + (size_t)trow * NP; const bf16* prv = (trow == 0) ? cur : cur - NP;
    in.wdc = *(const v4u*)(cur + HC_WD + e8); in.wdp = *(const v4u*)(prv + HC_WD + e8);
    in.rc = *(const v4u*)(cur + HC_RR + c8); in.rp = *(const v4u*)(prv + HC_RR + c8);
    in.kc = *(const v4u*)(cur + HC_RK + c8); in.kp = *(const v4u*)(prv + HC_RK + c8);
    in.vc = *(const v4u*)(cur + HC_RV + c8); in.vp = *(const v4u*)(prv + HC_RV + c8);
    const int j = tid >> 4, c4 = (tid & 15) * 4;
    in.wu = *(const f32x4*)(a.in[I_WUP] + j * 384 + p.h * 64 + c4); in.au = *(const f32x4*)(a.in[I_AUP] + j * 384 + p.h * 64 + c4);
}
__device__ __forceinline__ void rwkv_local_task(LAS unsigned char* lds, const Args& a, const RwcP& p, const RwcIn& in, RwcIn& nxt, volatile LAS unsigned* nextw, int& nx, bool& has_next, int tid, int lane, int wave) {
    asm volatile("" : "+v"(tid), "+v"(lane));
    LAS float* AX = (LAS float*)(lds + LC_AX); LAS float* G = (LAS float*)(lds + LC_G); LAS float* AT = (LAS float*)(lds + LC_AT); LAS float* GAM = (LAS float*)(lds + LC_GAM);
    const int tt = tid >> 3, e8 = (tid & 7) * 8, h = p.h, c8 = h * 64 + e8;
    const float* mu = a.in[I_MU];
    const int trow = p.c0 + tt; const bool first = (trow == 0);
    {
        { const int j = tid >> 4, c4 = (tid & 15) * 4; LAS unsigned short* ww = (LAS unsigned short*)(lds + LC_AT) + c4 * 40 + j; LAS unsigned short* wa = ww + 64 * 40;
          ww[0] = (unsigned short)f2bf(in.wu.x); ww[40] = (unsigned short)f2bf(in.wu.y); ww[80] = (unsigned short)f2bf(in.wu.z); ww[120] = (unsigned short)f2bf(in.wu.w);
          wa[0] = (unsigned short)f2bf(in.au.x); wa[40] = (unsigned short)f2bf(in.au.y); wa[80] = (unsigned short)f2bf(in.au.z); wa[120] = (unsigned short)f2bf(in.au.w); }
        float cu[8], pv[8], mm[8];
        unpack8(in.wdc, cu); unpack8(in.wdp, pv);
        if (first) { _Pragma("unroll") for (int e = 0; e < 8; ++e) pv[e] = 0.f; }
        ld8(mu + 1152 + e8, mm);
        float xs[8];
#pragma unroll
        for (int e = 0; e < 8; ++e) { xs[e] = cu[e] + (pv[e] - cu[e]) * mm[e]; if (e8 < 32) xs[e] = ftanh(xs[e]); }
        v4u w_; w_.x = pk2(xs[0], xs[1]); w_.y = pk2(xs[2], xs[3]); w_.z = pk2(xs[4], xs[5]); w_.w = pk2(xs[6], xs[7]);
        *(LAS v4u*)(lds + LC_AX + (e8 < 32 ? 0 : 5120) + tt * 80 + (e8 & 31) * 2) = w_;
    }
    __syncthreads();
    {
        const int bi_ = wave >> 1, bj_ = 2 * (wave & 1), fr_ = lane & 15, fq_ = lane >> 4;
        const bf16x8 xw = *(const LAS bf16x8*)(lds + LC_AX + (16 * bi_ + fr_) * 80 + 16 * fq_), xa = *(const LAS bf16x8*)(lds + LC_AX + 5120 + (16 * bi_ + fr_) * 80 + 16 * fq_);
        LAS float* LAO = (LAS float*)(lds + LC_M(8));
#pragma unroll
        for (int n = 0; n < 2; ++n) {
            const bf16x8 bw = *(const LAS bf16x8*)(lds + LC_AT + (16 * (bj_ + n) + fr_) * 80 + 16 * fq_), ba = *(const LAS bf16x8*)(lds + LC_AT + 5120 + (16 * (bj_ + n) + fr_) * 80 + 16 * fq_);
            f32x4 cw = {0.f, 0.f, 0.f, 0.f}, ca = {0.f, 0.f, 0.f, 0.f};
            cw = __builtin_amdgcn_mfma_f32_16x16x32_bf16(xw, bw, cw, 0, 0, 0); ca = __builtin_amdgcn_mfma_f32_16x16x32_bf16(xa, ba, ca, 0, 0, 0);
#pragma unroll
            for (int rg = 0; rg < 4; ++rg) { G[(16 * bi_ + 4 * fq_ + rg) * 64 + 16 * (bj_ + n) + fr_] = cw[rg]; LAO[(16 * bi_ + 4 * fq_ + rg) * 64 + 16 * (bj_ + n) + fr_] = ca[rg]; }
        }
    }
    __syncthreads();
    float rs[8], ks[8], vs[8], kk[8], be[8], lwv[8];
    {
        float lw[8], la[8];
        { float t8[8]; ld8(a.in[I_W0] + c8, lw); ld8(a.in[I_A0] + c8, la);
          const f32x4 g0 = *(const LAS f32x4*)(G + tt * 64 + e8), g1 = *(const LAS f32x4*)(G + tt * 64 + e8 + 4);
          const f32x4 h0 = *(const LAS f32x4*)((LAS float*)(lds + LC_M(8)) + tt * 64 + e8), h1 = *(const LAS f32x4*)((LAS float*)(lds + LC_M(8)) + tt * 64 + e8 + 4);
          lw[0] += g0.x; lw[1] += g0.y; lw[2] += g0.z; lw[3] += g0.w; lw[4] += g1.x; lw[5] += g1.y; lw[6] += g1.z; lw[7] += g1.w;
          la[0] += h0.x; la[1] += h0.y; la[2] += h0.z; la[3] += h0.w; la[4] += h1.x; la[5] += h1.y; la[6] += h1.z; la[7] += h1.w; (void)t8; }
        { float cu[8], pv[8], mm[8];
#define RW_SHIFT(dst, CW, PW, MUOFF) do { unpack8(CW, cu); unpack8(PW, pv); \
            if (first) { _Pragma("unroll") for (int e = 0; e < 8; ++e) pv[e] = 0.f; } \
            ld8(mu + (MUOFF) + c8, mm); \
            _Pragma("unroll") for (int e = 0; e < 8; ++e) dst[e] = cu[e] + (pv[e] - cu[e]) * mm[e]; } while (0)
          RW_SHIFT(rs, in.rc, in.rp, 0); RW_SHIFT(ks, in.kc, in.kp, 384); RW_SHIFT(vs, in.vc, in.vp, 768);
#undef RW_SHIFT
        }
        float kkw[8], kaw[8], rkw[8]; ld8(a.in[I_KK] + c8, kkw); ld8(a.in[I_KA] + c8, kaw); ld8(a.in[I_RK] + c8, rkw);
        float ss = 0.f, bn = 0.f;
#pragma unroll
        for (int e = 0; e < 8; ++e) {
            const float wraw = -softplusf(-lw[e]) - 0.5f; lwv[e] = -fexp(wraw);
            const float av = sigmf(la[e]);
            kk[e] = ks[e] * kkw[e]; ss += kk[e] * kk[e]; be[e] = av;
            ks[e] = ks[e] * (1.f + (av - 1.f) * kaw[e]);
            bn += rs[e] * ks[e] * rkw[e];
        }
        ss = sum8(ss); bn = sum8(bn); const float rn = frsq(fmaxf(ss, 1e-24f));
#pragma unroll
        for (int e = 0; e < 8; ++e) { kk[e] *= rn; be[e] *= kk[e]; }
        if ((tid & 7) == 0) ((float*)(a.ws + WS_BON))[p.task * 64 + tt] = bn;
        *(LAS f32x4*)(G + tt * 64 + e8) = (f32x4){lwv[0], lwv[1], lwv[2], lwv[3]}; *(LAS f32x4*)(G + tt * 64 + e8 + 4) = (f32x4){lwv[4], lwv[5], lwv[6], lwv[7]};
    }
    nx = (int)*nextw; has_next = (nx >= RWC_Q0) && (nx < RWC_Q0 + NTASK_RWC);
    if (has_next) { const int t2 = nx - RWC_Q0, bh2 = t2 / NCH; const RwcP pn{(const bf16*)(a.ws + WS_H) + (size_t)(bh2 / 6) * SEQ * NP, bh2 % 6, (t2 % NCH) * 64, (size_t)t2}; rwkv_local_load(nxt, a, pn, tid); }
    __syncthreads();
    { const int d = tid & 63, sg = tid >> 6; float loc[8]; float run = 0.f;
#pragma unroll
      for (int i = 0; i < 8; ++i) { run += G[(8 * sg + i) * 64 + d]; loc[i] = run; }
      AX[sg * 64 + d] = run;
      __syncthreads();
      float pre = 0.f;
#pragma unroll
      for (int j = 0; j < 8; ++j) { const float sv = AX[j * 64 + d]; pre += (j < sg) ? sv : 0.f; }
#pragma unroll
      for (int i = 0; i < 8; ++i) G[(8 * sg + i) * 64 + d] = pre + loc[i];
    }
    __syncthreads();
    {
        float g[8], gm[8], g63[8];
        { const f32x4 x0 = *(const LAS f32x4*)(G + tt * 64 + e8), x1 = *(const LAS f32x4*)(G + tt * 64 + e8 + 4);
          g[0] = x0.x; g[1] = x0.y; g[2] = x0.z; g[3] = x0.w; g[4] = x1.x; g[5] = x1.y; g[6] = x1.z; g[7] = x1.w; }
        { const f32x4 x0 = *(const LAS f32x4*)(G + 63 * 64 + e8), x1 = *(const LAS f32x4*)(G + 63 * 64 + e8 + 4);
          g63[0] = x0.x; g63[1] = x0.y; g63[2] = x0.z; g63[3] = x0.w; g63[4] = x1.x; g63[5] = x1.y; g63[6] = x1.z; g63[7] = x1.w; }
#pragma unroll
        for (int e = 0; e < 8; ++e) gm[e] = g[e] - lwv[e];
        float at[8], qt[8], bh[8], kh[8], bb[8], kb[8];
#pragma unroll
        for (int e = 0; e < 8; ++e) { const float e1 = fexp(gm[e]), e2 = fexp(g[e]), e3 = fexp(-g[e]), e4 = fexp(g63[e] - g[e]);
            at[e] = -kk[e] * e1; qt[e] = rs[e] * e2; bh[e] = be[e] * e3; kh[e] = ks[e] * e3; bb[e] = be[e] * e4; kb[e] = ks[e] * e4; }
        *(LAS f32x4*)(AT + tt * 64 + e8) = (f32x4){at[0], at[1], at[2], at[3]}; *(LAS f32x4*)(AT + tt * 64 + e8 + 4) = (f32x4){at[4], at[5], at[6], at[7]};
#define ST8(i, arr) do { v4u w_; w_.x = pk2(arr[0], arr[1]); w_.y = pk2(arr[2], arr[3]); w_.z = pk2(arr[4], arr[5]); w_.w = pk2(arr[6], arr[7]); *(LAS v4u*)(lds + LC_M(i) + tt * 144 + e8 * 2) = w_; } while (0)
        ST8(0, at); ST8(1, qt); ST8(2, bh); ST8(3, kh);
#undef ST8
#pragma unroll
        for (int e = 0; e < 8; ++e) {
            *(LAS unsigned short*)(lds + LC_M(4) + (e8 + e) * 144 + tt * 2) = (unsigned short)f2bf(bb[e]);
            *(LAS unsigned short*)(lds + LC_M(5) + (e8 + e) * 144 + tt * 2) = (unsigned short)f2bf(kb[e]);
            *(LAS unsigned short*)(lds + LC_M(6) + (e8 + e) * 144 + tt * 2) = (unsigned short)f2bf(vs[e]);
        }
        if (tt == 63) {
#pragma unroll
            for (int e = 0; e < 8; ++e) GAM[e8 + e] = fexp(g63[e]);
        }
    }
    __syncthreads();
    const int bi = wave >> 1, bj0 = 2 * (wave & 1), fr = lane & 15, fq = lane >> 4;
    {
        f32x4 cab[2], cak[2], cqb[2], cqk[2]; ACC_ZERO(cab); ACC_ZERO(cak); ACC_ZERO(cqb); ACC_ZERO(cqk);
        mm_nt(cab, lds + LC_M(0), lds + LC_M(2), bi, bj0, fr, fq); mm_nt(cak, lds + LC_M(0), lds + LC_M(3), bi, bj0, fr, fq);
        mm_nt(cqb, lds + LC_M(1), lds + LC_M(2), bi, bj0, fr, fq); mm_nt(cqk, lds + LC_M(1), lds + LC_M(3), bi, bj0, fr, fq);
#pragma unroll
        for (int n = 0; n < 2; ++n)
#pragma unroll
            for (int rg = 0; rg < 4; ++rg) { const int t = 16 * bi + 4 * fq + rg, s = 16 * (bj0 + n) + fr;
                cab[n][rg] = (s < t) ? cab[n][rg] : 0.f;
                AX[s * 64 + t] = cab[n][rg];
                *(LAS unsigned short*)(lds + LC_M(7) + t * 144 + s * 2) = (unsigned short)f2bf((s < t) ? cak[n][rg] : 0.f);
                *(LAS unsigned short*)(lds + LC_M(8) + t * 144 + s * 2) = (unsigned short)f2bf((s <= t) ? cqb[n][rg] : 0.f);
                *(LAS unsigned short*)(lds + LC_M(9) + t * 144 + s * 2) = (unsigned short)f2bf((s <= t) ? cqk[n][rg] : 0.f); }
        __syncthreads();
        st_bf16_tile(lds + LC_M(0), cab, bi, bj0, fr, fq);
        { const v4u z = {0u, 0u, 0u, 0u};
          *(LAS v4u*)(lds + LC_M(2) + tid * 16) = z; *(LAS v4u*)(lds + LC_M(3) + tid * 16) = z;
          if (tid < 64) { *(LAS v4u*)(lds + LC_M(2) + 8192 + tid * 16) = z; *(LAS v4u*)(lds + LC_M(3) + 8192 + tid * 16) = z; } }
    }
    {
        f32x4 c[2]; ACC_ZERO(c); mm_nt(c, lds + LC_M(7), lds + LC_M(6), bi, bj0, fr, fq);
#pragma unroll
        for (int n = 0; n < 2; ++n)
#pragma unroll
            for (int rg = 0; rg < 4; ++rg) G[(16 * bi + 4 * fq + rg) * 64 + 16 * (bj0 + n) + fr] = c[n][rg];
    }
    __syncthreads();
    {
        LAS float* R = (tid < 64) ? AT : G; const int col = tid & 63;
        LAS unsigned char* XT = lds + ((tid < 64) ? LC_M(2) : LC_M(3)) + col * 144;
#pragma unroll
        for (int b4 = 0; b4 < 4; ++b4) {
            if (b4 > 0) {
                f32x4 acc = {0.f, 0.f, 0.f, 0.f};
                const LAS unsigned char* Yb = lds + ((wave < 4) ? LC_M(2) : LC_M(3)) + (16 * (wave & 3) + fr) * 144;
#pragma unroll
                for (int ks = 0; ks < (b4 + 1) / 2; ++ks) {
                    const bf16x8 av = *(const LAS bf16x8*)(lds + LC_M(0) + (16 * b4 + fr) * 144 + 64 * ks + 16 * fq);
                    const bf16x8 bv = *(const LAS bf16x8*)(Yb + 64 * ks + 16 * fq);
                    acc = __builtin_amdgcn_mfma_f32_16x16x32_bf16(av, bv, acc, 0, 0, 0);
                }
                LAS float* Rw = ((wave < 4) ? AT : G) + 16 * (wave & 3) + fr;
#pragma unroll
                for (int rg = 0; rg < 4; ++rg) Rw[(16 * b4 + 4 * fq + rg) * 64] += acc[rg];
                __syncthreads();
            }
            if (tid < 128) {
                float r[16];
#pragma unroll
                for (int i = 0; i < 16; ++i) r[i] = R[(16 * b4 + i) * 64 + col];
#pragma unroll
                for (int j = 0; j < 15; ++j) {
#pragma unroll
                    for (int i4 = (j + 1) / 4; i4 < 4; ++i4) { const f32x4 a4 = *(const LAS f32x4*)(AX + (16 * b4 + j) * 64 + 16 * b4 + 4 * i4);
                        if (4 * i4 > j) r[4 * i4] += a4.x * r[j]; if (4 * i4 + 1 > j) r[4 * i4 + 1] += a4.y * r[j]; if (4 * i4 + 2 > j) r[4 * i4 + 2] += a4.z * r[j]; if (4 * i4 + 3 > j) r[4 * i4 + 3] += a4.w * r[j]; }
                }
                v4u w0, w1; w0.x = pk2(r[0], r[1]); w0.y = pk2(r[2], r[3]); w0.z = pk2(r[4], r[5]); w0.w = pk2(r[6], r[7]);
                w1.x = pk2(r[8], r[9]); w1.y = pk2(r[10], r[11]); w1.z = pk2(r[12], r[13]); w1.w = pk2(r[14], r[15]);
                *(LAS v4u*)(XT + 32 * b4) = w0; *(LAS v4u*)(XT + 32 * b4 + 16) = w1;
            }
            __syncthreads();
        }
    }
    {
        const LAS unsigned char* WT = lds + LC_M(2); const LAS unsigned char* WUT = lds + LC_M(3);
        f32x4 c[2];
#pragma unroll
        for (int n = 0; n < 2; ++n)
#pragma unroll
            for (int rg = 0; rg < 4; ++rg) c[n][rg] = bf2f(*(const LAS unsigned short*)(lds + LC_M(1) + (16 * bi + 4 * fq + rg) * 144 + (16 * (bj0 + n) + fr) * 2));
        mm_nt(c, lds + LC_M(8), WT, bi, bj0, fr, fq);
        st_bf16_tile(lds + LC_G, c, bi, bj0, fr, fq);
        ACC_ZERO(c); mm_nt(c, lds + LC_M(8), WUT, bi, bj0, fr, fq); mm_nt(c, lds + LC_M(9), lds + LC_M(6), bi, bj0, fr, fq);
        st_bf16_tile(lds + LC_AT, c, bi, bj0, fr, fq);
        ACC_ZERO(c); mm_nt(c, lds + LC_M(4), WT, bi, bj0, fr, fq);
#pragma unroll
        for (int n = 0; n < 2; ++n)
#pragma unroll
            for (int rg = 0; rg < 4; ++rg) { const int kp = 16 * bi + 4 * fq + rg, k = 16 * (bj0 + n) + fr; if (kp == k) c[n][rg] += GAM[k]; }
        st_bf16_tile(lds + LC_M(0), c, bi, bj0, fr, fq);
        ACC_ZERO(c); mm_nt(c, WUT, lds + LC_M(4), bi, bj0, fr, fq); mm_nt(c, lds + LC_M(6), lds + LC_M(5), bi, bj0, fr, fq);
#pragma unroll
        for (int n = 0; n < 2; ++n)
#pragma unroll
            for (int rg = 0; rg < 4; ++rg) AX[(16 * bi + 4 * fq + rg) * 64 + 16 * (bj0 + n) + fr] = c[n][rg];
    }
    __syncthreads();
    copy_tile_bf16((bf16*)(a.ws + WS_QE) + p.task * 4096, lds + LC_G, tid);
    copy_tile_bf16((bf16*)(a.ws + WS_YL) + p.task * 4096, lds + LC_AT, tid);
    copy_tile_bf16((bf16*)(a.ws + WS_PT) + p.task * 4096, lds + LC_M(0), tid);
    { float* sl = (float*)(a.ws + WS_SL) + p.task * 4096; *(f32x4*)(sl + tid * 4) = *(const LAS f32x4*)(AX + tid * 4); *(f32x4*)(sl + 2048 + tid * 4) = *(const LAS f32x4*)(AX + 2048 + tid * 4); }
    __syncthreads();
}

constexpr int CH_S = 0, CH_P = 9216;
__device__ __forceinline__ void rwkv_chain_task(LAS unsigned char* lds, const Args& a, int bh, int tid, int lane, int wave) {
    const int bi = wave >> 1, bj0 = 2 * (wave & 1), fr = lane & 15, fq = lane >> 4;
    const bf16* PT = (const bf16*)(a.ws + WS_PT) + (size_t)bh * NCH * 4096; const float* SL = (const float*)(a.ws + WS_SL) + (size_t)bh * NCH * 4096;
    bf16* SC = (bf16*)(a.ws + WS_SC) + (size_t)bh * NCH * 4096;
    f32x4 s[2]; ACC_ZERO(s);
    const int row = tid >> 3, pc = tid & 7;
    v4u preg = *(const v4u*)(PT + row * 64 + pc * 8);
    for (int c = 0; c < NCH; ++c) {
        __syncthreads();
        st_bf16_tile(lds + CH_S, s, bi, bj0, fr, fq);
        *(LAS v4u*)(lds + CH_P + row * 144 + pc * 16) = preg;
        __syncthreads();
        copy_tile_bf16(SC + (size_t)c * 4096, lds + CH_S, tid);
        if (c + 1 < NCH) preg = *(const v4u*)(PT + (size_t)(c + 1) * 4096 + row * 64 + pc * 8);
        f32x4 n_[2];
#pragma unroll
        for (int n = 0; n < 2; ++n)
#pragma unroll
            for (int rg = 0; rg < 4; ++rg) n_[n][rg] = SL[(size_t)c * 4096 + (16 * bi + 4 * fq + rg) * 64 + 16 * (bj0 + n) + fr];
        mm_nt(n_, lds + CH_S, lds + CH_P, bi, bj0, fr, fq);
        s[0] = n_[0]; s[1] = n_[1];
    }
    float* so = a.out + O_RSP + (size_t)bh * 4096;
#pragma unroll
    for (int n = 0; n < 2; ++n)
#pragma unroll
        for (int rg = 0; rg < 4; ++rg) so[(16 * bi + 4 * fq + rg) * 64 + 16 * (bj0 + n) + fr] = s[n][rg];
}

constexpr int YT_Q = 0, YT_S = 9216, YT_Y = 18432;
struct RwoIn { v4u qe, sc, vc, vp, gc, gp; unsigned short yl[8]; float bn; };
__device__ __forceinline__ void rwkv_out_load(RwoIn& in, const Args& a, const RwcP& p, int tid, int lane, int wave) {
    const int bi = wave >> 1, bj0 = 2 * (wave & 1), fr = lane & 15, fq = lane >> 4, row = tid >> 3, pc = tid & 7;
    in.qe = *(const v4u*)((const bf16*)(a.ws + WS_QE) + p.task * 4096 + row * 64 + pc * 8);
    in.sc = *(const v4u*)((const bf16*)(a.ws + WS_SC) + p.task * 4096 + row * 64 + pc * 8);
    const bf16* yl = (const bf16*)(a.ws + WS_YL) + p.task * 4096;
#pragma unroll
    for (int n = 0; n < 2; ++n)
#pragma unroll
        for (int rg = 0; rg < 4; ++rg) in.yl[4 * n + rg] = yl[(16 * bi + 4 * fq + rg) * 64 + 16 * (bj0 + n) + fr];
    const int tt = tid >> 3, e8 = (tid & 7) * 8, c8 = p.h * 64 + e8, trow = p.c0 + tt;
    const bf16* cur = p.Hs + (size_t)trow * NP; const bf16* prv = (trow == 0) ? cur : cur - NP;
    in.vc = *(const v4u*)(cur + HC_RV + c8); in.vp = *(const v4u*)(prv + HC_RV + c8); in.gc = *(const v4u*)(cur + HC_RG + c8); in.gp = *(const v4u*)(prv + HC_RG + c8);
    in.bn = ((const float*)(a.ws + WS_BON))[p.task * 64 + tt];
}
__device__ __forceinline__ void rwkv_out_task(LAS unsigned char* lds, const Args& a, const RwcP& p, const RwoIn& in, RwoIn& nxt, volatile LAS unsigned* nextw, int& nx, bool& has_next, bf16* Ob, int tid, int lane, int wave) {
    const int bi = wave >> 1, bj0 = 2 * (wave & 1), fr = lane & 15, fq = lane >> 4, row = tid >> 3, pc = tid & 7, h = p.h;
    LAS float* Y = (LAS float*)(lds + YT_Y);
    __syncthreads();
    *(LAS v4u*)(lds + YT_Q + row * 144 + pc * 16) = in.qe;
    *(LAS v4u*)(lds + YT_S + row * 144 + pc * 16) = in.sc;
    f32x4 c[2];
#pragma unroll
    for (int n = 0; n < 2; ++n)
#pragma unroll
        for (int rg = 0; rg < 4; ++rg) c[n][rg] = bf2f(in.yl[4 * n + rg]);
    __syncthreads();
    nx = (int)*nextw; has_next = nx < NTASK_RWC;
    if (has_next) { const int bh2 = nx / NCH; const RwcP pn{(const bf16*)(a.ws + WS_H) + (size_t)(bh2 / 6) * SEQ * NP, bh2 % 6, (nx % NCH) * 64, (size_t)nx}; rwkv_out_load(nxt, a, pn, tid, lane, wave); }
    mm_nt(c, lds + YT_Q, lds + YT_S, bi, bj0, fr, fq);
#pragma unroll
    for (int n = 0; n < 2; ++n)
#pragma unroll
        for (int rg = 0; rg < 4; ++rg) Y[(16 * bi + 4 * fq + rg) * 64 + 16 * (bj0 + n) + fr] = c[n][rg];
    __syncthreads();
    {
        const int tt = tid >> 3, e8 = (tid & 7) * 8, c8 = h * 64 + e8; const int trow = p.c0 + tt; const bool first = (trow == 0);
        const float* mu = a.in[I_MU];
        float y[8], sm = 0.f;
#pragma unroll
        for (int e = 0; e < 8; ++e) { y[e] = Y[tt * 64 + e8 + e]; sm += y[e]; }
        sm = sum8(sm) * (1.f / 64.f);
        float var = 0.f;
#pragma unroll
        for (int e = 0; e < 8; ++e) { const float d = y[e] - sm; var += d * d; }
        var = sum8(var) * (1.f / 64.f);
        const float rstd = frsq(var + GN_EPS);
        const float bn = in.bn;
        float vs[8], gs[8], cu[8], pv[8], mm[8], gw[8], gb[8];
        unpack8(in.vc, cu); unpack8(in.vp, pv); if (first) { _Pragma("unroll") for (int e = 0; e < 8; ++e) pv[e] = 0.f; }
        ld8(mu + 768 + c8, mm);
#pragma unroll
        for (int e = 0; e < 8; ++e) vs[e] = cu[e] + (pv[e] - cu[e]) * mm[e];
        unpack8(in.gc, cu); unpack8(in.gp, pv); if (first) { _Pragma("unroll") for (int e = 0; e < 8; ++e) pv[e] = 0.f; }
        ld8(mu + 1216 + c8, mm);
#pragma unroll
        for (int e = 0; e < 8; ++e) gs[e] = cu[e] + (pv[e] - cu[e]) * mm[e];
        ld8(a.in[I_GNW] + c8, gw); ld8(a.in[I_GNB] + c8, gb);
        float o[8];
#pragma unroll
        for (int e = 0; e < 8; ++e) o[e] = ((y[e] - sm) * rstd * gw[e] + gb[e] + bn * vs[e]) * siluf(gs[e]);
        v4u w_; w_.x = pk2(o[0], o[1]); w_.y = pk2(o[2], o[3]); w_.z = pk2(o[4], o[5]); w_.w = pk2(o[6], o[7]);
        *(v4u*)(Ob + ((size_t)(p.task / (6 * NCH)) * SEQ + trow) * DM + 384 + c8) = w_;
    }
}
constexpr int NQ_RW = 48 + 192, NQ_SM = 192 + 128;
__device__ __forceinline__ int q_next(const Ctx& F, int qi) {
    __syncthreads();
    if (F.tid == 0) F.MISC[0] = __hip_atomic_fetch_add(F.ctl + CW_Q + 64 * qi, 1u, __ATOMIC_RELAXED, __HIP_MEMORY_SCOPE_AGENT);
    __syncthreads();
    return (int)F.MISC[0];
}
template <bool FOX>
__device__ __forceinline__ void attn_queue(const Ctx& F, const Args& a, int qi, float Bb, float Bm) {
    bf16* H = (bf16*)(a.ws + WS_H); bf16* Ob = (bf16*)(a.ws + WS_XN); bf16* MKV = (bf16*)(a.ws + WS_MKV);
    const float* NCKP = (const float*)(a.ws + WS_NCKP); const float* NCKS = (const float*)(a.ws + WS_NCKS);
    LAS unsigned char* lds = F.lds + RING_OFF;
    constexpr int BASE = FOX ? 0 : 768, CNT = FOX ? 768 : 512;
    int tk = q_next(F, qi);
    if (tk >= CNT) return;
    tk += BASE;
    AttnPf pf, pfn; attn_prefetch(pf, a, tk, F.lane);
    for (;;) {
        if (F.tid == 0) { const unsigned r = __hip_atomic_fetch_add(F.ctl + CW_Q + 64 * qi, 1u, __ATOMIC_RELAXED, __HIP_MEMORY_SCOPE_AGENT); F.MISC[2] = (r < (unsigned)CNT) ? BASE + r : (unsigned)NQ_AT; }
        AttnP p;
        if constexpr (FOX) { const int u = tk, qb = 15 - (u & 15), bh = u >> 4, b = bh / 6, h = bh % 6; const size_t r0 = (size_t)b * SEQ + qb * 256;
            p = AttnP{H + r0 * NP + HC_FQ + h * 64, NP, H + (size_t)b * SEQ * NP + HC_FK + h * 64, NP, H + (size_t)b * SEQ * NP + HC_FV + h * 64, NP, NCKP + (size_t)bh * SEQ, NCKS + (size_t)bh * 64, a.in[I_FQG], a.in[I_FKG],
                      H + r0 * NP + HC_FG + h * 64, NP, Ob + r0 * DM + h * 64, DM, 4 * (qb + 1), qb * 256, 1};
        } else { const int u = tk - 768, b = u / 64, h = (u / 16) % 4, qb = u % 16; const size_t r0 = (size_t)b * SEQ + qb * 256;
            p = AttnP{H + r0 * NP + HC_MQ + h * 64, NP, MKV + (size_t)b * NMEM * 512 + h * 64, 512, MKV + (size_t)b * NMEM * 512 + 256 + h * 64, 512, nullptr, nullptr, nullptr, nullptr,
                      H + r0 * NP + HC_MG + h * 64, NP, Ob + r0 * DM + 768 + h * 64, DM, 4, 0, 0}; }
        int nx;
        attn_unit<FOX>(lds, p, a, pf, pfn, F.MISC + 2, nx, Bb, Bm, F.tid, F.lane, F.wave);
        if (nx >= NQ_AT) break;
        tk = nx; pf = pfn;
    }
}
__device__ __forceinline__ void p4_mixer(const Ctx& F, const Args& a, int qoff = 0) {
    bf16* H = (bf16*)(a.ws + WS_H); bf16* Ob = (bf16*)(a.ws + WS_XN); bf16* MKV = (bf16*)(a.ws + WS_MKV);
    const float* NCKP = (const float*)(a.ws + WS_NCKP); const float* NCKS = (const float*)(a.ws + WS_NCKS);
    LAS unsigned char* lds = F.lds + RING_OFF;
    for (;;) {
        const int tk = q_next(F, 0 + qoff); if (tk >= NQ_RW) break;
        RwkvP p;
        if (tk < 48) { rwkv_chain_task(lds, a, tk, F.tid, F.lane, F.wave);
            if (tk % 6 == 0) { const bf16* last = H + ((size_t)(tk / 6) * SEQ + SEQ - 1) * NP; float* sh = a.out + O_RHP + (size_t)(tk / 6) * 1600;
                for (int m = F.tid; m < 1600; m += 512) { const int c = (m < 1152) ? HC_RR + m : (m < 1184) ? HC_WD + (m - 1152) : (m < 1216) ? HC_AD + (m - 1184) : HC_RG + (m - 1216); sh[m] = bf2f(last[c]); } }
            continue; }
        { const int u = tk - 48, b = u / 6, h = u % 6;
            p = RwkvP{H + (size_t)(MP + b * DECS) * NP, Ob + (size_t)(MP + b * DECS) * DM, DECS, h, a.in[I_SRW] + (size_t)u * 4096, a.in[I_SSH] + (size_t)b * 1600,
                      a.out + O_RSS + (size_t)u * 4096, (h == 0) ? a.out + O_RHS + (size_t)b * 1600 : nullptr}; }
        rwkv_task(lds, a, p, F.tid);
    }
    float Bm;
    {
        float Bb = 0.f;
#if FOX_SKIP
        { const float gqm = wave_max(fabsf(a.in[I_FQG][F.lane])), gkm = wave_max(fabsf(a.in[I_FKG][F.lane])); Bb = 8.0f * gqm * gkm * LOG2E * 1.02f; }
#endif
        { const float gqm = wave_max(fabsf(a.in[I_MQG][F.lane])), gkm = wave_max(fabsf(a.in[I_MKG][F.lane])); Bm = __int_as_float(__builtin_amdgcn_readfirstlane(__float_as_int(8.0f * gqm * gkm * LOG2E * 1.02f))); }
#if !FOX_SKIP
        { const float gqm = wave_max(fabsf(a.in[I_FQG][F.lane])), gkm = wave_max(fabsf(a.in[I_FKG][F.lane])); Bb = 8.0f * gqm * gkm * LOG2E * 1.02f; }
#endif
        attn_queue<true>(F, a, 1 + qoff, Bb, Bm);
    }
    for (;;) {
        const int tk = q_next(F, 2 + qoff); if (tk >= NQ_SM) break;
        SmallP p;
        if (tk < 192) { const int u = tk, b = u / 6, h = u % 6; const size_t r0 = (size_t)MP + b * DECS;
            p = SmallP{H + r0 * NP + HC_FQ + h * 64, NP, a.in[I_CFK] + ((size_t)b * PAST * 6 + h) * 64, 384, a.in[I_CFV] + ((size_t)b * PAST * 6 + h) * 64, 384, PAST, a.in[I_CFL] + (size_t)b * PAST * 6 + h, a.out + O_FLS + (size_t)b * DECS * 6 + h,
                       H + r0 * NP + HC_FK + h * 64, H + r0 * NP + HC_FV + h * 64, NP, H + r0 * NP + HC_FG + h * 64, NP, Ob + r0 * DM + h * 64, DM};
        } else { const int u = tk - 192, b = u / 4, h = u % 4; const size_t r0 = (size_t)MP + b * DECS;
            p = SmallP{H + r0 * NP + HC_MQ + h * 64, NP, a.in[I_CMK] + ((size_t)b * NMEM * 4 + h) * 64, 256, a.in[I_CMV] + ((size_t)b * NMEM * 4 + h) * 64, 256, NMEM, nullptr, nullptr,
                       nullptr, nullptr, NP, H + r0 * NP + HC_MG + h * 64, NP, Ob + r0 * DM + 768 + h * 64, DM}; }
        sample_attn(lds, p, F.tid, F.lane, F.wave);
    }
    {
        attn_queue<false>(F, a, 21 + qoff, 0.f, Bm);
    }
}

__device__ __forceinline__ void p3b_rwkv_local(const Ctx& F, const Args& a, int qoff = 0) {
    const bf16* H = (const bf16*)(a.ws + WS_H); LAS unsigned char* lds = F.lds + RING_OFF;
    {
        int blk = q_next(F, 3 + qoff), par = 0;
        while (blk < NBLK_PREP) {
            if (F.tid == 0) F.MISC[2 + par] = __hip_atomic_fetch_add(F.ctl + CW_Q + 64 * (3 + qoff), 1u, __ATOMIC_RELAXED, __HIP_MEMORY_SCOPE_AGENT);
            prep_block_task(lds, a, blk, F.tid, F.lane, F.wave);
            blk = (int)F.MISC[2 + par]; par ^= 1;
        }
        __syncthreads();
    }
    int cur = RWC_Q0 + q_next(F, 4 + 5 + qoff);
    if (cur >= RWC_Q0 + NTASK_RWC) return;
    RwcIn in, nxt;
    { const int tk = cur - RWC_Q0, bh = tk / NCH; const RwcP p{H + (size_t)(bh / 6) * SEQ * NP, bh % 6, (tk % NCH) * 64, (size_t)tk}; rwkv_local_load(in, a, p, F.tid); }
    for (;;) {
        if (F.tid == 0) F.MISC[2] = RWC_Q0 + __hip_atomic_fetch_add(F.ctl + CW_Q + 64 * (4 + 5 + qoff), 1u, __ATOMIC_RELAXED, __HIP_MEMORY_SCOPE_AGENT);
        int nx; bool has_next = false;
        const int tk = cur - RWC_Q0, bh = tk / NCH; const RwcP p{H + (size_t)(bh / 6) * SEQ * NP, bh % 6, (tk % NCH) * 64, (size_t)tk};
        rwkv_local_task(lds, a, p, in, nxt, F.MISC + 2, nx, has_next, F.tid, F.lane, F.wave);
        if (!has_next) break;
        cur = nx; in = nxt;
    }
}
__device__ __forceinline__ void p5_rwkv_out(const Ctx& F, const Args& a, int qoff = 0) {
    const bf16* H = (const bf16*)(a.ws + WS_H); bf16* Ob = (bf16*)(a.ws + WS_XN); LAS unsigned char* lds = F.lds + RING_OFF;
    int cur = q_next(F, 4 + qoff);
    if (cur >= NTASK_RWC) return;
    RwoIn in, nxt;
    { const int bh = cur / NCH; const RwcP p{H + (size_t)(bh / 6) * SEQ * NP, bh % 6, (cur % NCH) * 64, (size_t)cur}; rwkv_out_load(in, a, p, F.tid, F.lane, F.wave); }
    for (;;) {
        if (F.tid == 0) F.MISC[2] = __hip_atomic_fetch_add(F.ctl + CW_Q + 64 * (4 + qoff), 1u, __ATOMIC_RELAXED, __HIP_MEMORY_SCOPE_AGENT);
        int nx; bool has_next = false;
        const int bh = cur / NCH; const RwcP p{H + (size_t)(bh / 6) * SEQ * NP, bh % 6, (cur % NCH) * 64, (size_t)cur};
        rwkv_out_task(lds, a, p, in, nxt, F.MISC + 2, nx, has_next, Ob, F.tid, F.lane, F.wave);
        if (!has_next) break;
        cur = nx; in = nxt;
    }
}


struct EpiRes {
    static constexpr bool PERM = true, AFTER_DRAIN = false;
    const float* xp; const float* xs; float* yp; float* ys;
    __device__ __forceinline__ void operator()(const pg8::f32x4 (&acc)[2][2][4][2], const pg8::Unit& u, int wr, int wc, int fr, int fq) const {
        const int row0 = u.pm * 256 + wr * 64 + fr, col0 = u.pn * 256 + wc * 32 + 8 * fq;
        const bool samp = u.pm >= (MP / 256);
        const float* xb = samp ? xs - (size_t)MP * DM : xp; float* yb = samp ? ys - (size_t)MP * DM : yp;
#pragma unroll
        for (int ai = 0; ai < 2; ++ai)
#pragma unroll
            for (int m = 0; m < 4; ++m) { const size_t ro = (size_t)(row0 + ai * 128 + m * 16) * DM + col0;
#pragma unroll
                for (int bj = 0; bj < 2; ++bj) {
                    const pg8::f32x4 x0 = *(const pg8::f32x4*)(xb + ro + bj * 128), x1 = *(const pg8::f32x4*)(xb + ro + bj * 128 + 4);
                    *(pg8::f32x4*)(yb + ro + bj * 128) = acc[ai][bj][m][0] + x0; *(pg8::f32x4*)(yb + ro + bj * 128 + 4) = acc[ai][bj][m][1] + x1; } }
    }
};

struct OneUnit { int pm, pn;
    __device__ __forceinline__ bool next(int i, pg8::Unit& u) const { if (i > 0) return false; u.pm = pm; u.pn = pn; return true; }
    __device__ __forceinline__ void a_ready(const pg8::Unit&) const {}
    __device__ __forceinline__ void done(const pg8::Unit&) const {} };
__global__ void __launch_bounds__(NWAVES * 64, 2) fwd_kernel(Args args) {
    extern __shared__ __attribute__((aligned(16))) unsigned char lds[];
    Ctx F;
    F.lds = (LAS unsigned char*)lds;
    F.MISC = (volatile LAS unsigned*)(F.lds + MISC_OFF);
    F.tid = threadIdx.x; F.lane = F.tid & 63; F.wave = __builtin_amdgcn_readfirstlane(F.tid >> 6);
    F.G = gridDim.x; { const int bx = blockIdx.x; F.vcu = (F.G % 8 == 0) ? (bx % 8) * (F.G / 8) + bx / 8 : bx; }
    F.ctl = (gu32*)(args.ws + WS_CTL);
    for (int u = F.tid; u < (LDS_BYTES - LDSCTL_OFF) / 4; u += NWAVES * 64) ((LAS unsigned*)(F.lds + LDSCTL_OFF))[u] = 0u;
    __syncthreads();
    XcdBarrier bar; bar.bar = (unsigned*)(F.ctl + CW_BAR); bar.x = 0; bar.st = nullptr;
#if MK_ONE_LAUNCH
    bar = xcd_barrier_post((unsigned*)(F.ctl + CW_BAR), F.MISC + 8);
#define GRID_BAR() xcd_barrier(bar)
#else
#define GRID_BAR() do {} while (0)
#endif
    const int lo = args.ph_lo, hi = args.ph_hi;
#define IN(k) (lo <= (k) && (k) < hi)
#define BOTH(k) (IN(k) && IN((k) + 1))
    bf16* H = (bf16*)(args.ws + WS_H);
    if (IN(0)) { p0_prologue(F, args); if (BOTH(0)) GRID_BAR(); }
    if (IN(1)) {
        { pg8::Gemm g{(const bf16*)(args.ws + WS_XN), (const bf16*)(args.ws + WS_WIN), MT, NP, DM}; pg8::StaticOrder S; S.init(MT, NP, F.G, (int)blockIdx.x);
          pg8::EpiBf16<0> E{H, NP, nullptr, 0, 0, 1.f};
          pg8::gemm_phase<pg8::EpiBf16<0>, pg8::StaticOrder, PG8_ALIGN, PG8_SP2>(F.lds + RING_OFF, g, S, E); }
        { pg8::Gemm g{(const bf16*)(args.ws + WS_MEMN), (const bf16*)(args.ws + WS_WMEM), BATCH * NMEM, 512, DM}; pg8::StaticOrder S; S.init(BATCH * NMEM, 512, F.G, (int)((blockIdx.x + 16u) % (unsigned)F.G))    ;
          pg8::EpiBf16<0> E{(bf16*)(args.ws + WS_MKV), 512, nullptr, 0, 0, 1.f};
          pg8::gemm_phase<pg8::EpiBf16<0>, pg8::StaticOrder, PG8_ALIGN, PG8_SP2>(F.lds + RING_OFF, g, S, E); }
        if (IN(1) && IN(3)) GRID_BAR();
    }
    if (IN(3)) { p3b_rwkv_local(F, args); if (BOTH(3)) GRID_BAR(); }
    if (IN(4)) { p4_mixer(F, args); if (BOTH(4)) GRID_BAR(); }
    if (IN(5)) {
        if (F.vcu < 8) {
            pg8::Gemm g{(const bf16*)(args.ws + WS_XN), (const bf16*)(args.ws + WS_WOUT), MT, DM, DM}; OneUnit S{MP / 256 + (F.vcu >> 2), F.vcu & 3};
            EpiRes E{args.in[I_XP], args.in[I_XS], args.out + O_YP, args.out + O_YS};
            pg8::gemm_phase<EpiRes, OneUnit, PG8_ALIGN, PG8_SP2>(F.lds + RING_OFF, g, S, E);
        }
        p5_rwkv_out(F, args); if (BOTH(5)) GRID_BAR(); }
    if (IN(6)) {
        pg8::Gemm g{(const bf16*)(args.ws + WS_XN), (const bf16*)(args.ws + WS_WOUT), MP, DM, DM}; pg8::StaticOrder S; S.init(MP, DM, F.G, (int)blockIdx.x);
        EpiRes E{args.in[I_XP], args.in[I_XS], args.out + O_YP, args.out + O_YS};
        pg8::gemm_phase<EpiRes, pg8::StaticOrder, PG8_ALIGN, PG8_SP2>(F.lds + RING_OFF, g, S, E);
    }
#undef IN
#undef BOTH
}

extern "C" void kernel_launch(void* const* d_in, const int* in_sizes, int n_in, void* d_out, int out_size, void* d_ws, size_t ws_size, hipStream_t stream) {
    static int grid = 0;
    if (grid == 0) {
        if (n_in != 30 || out_size != (int)O_END || ws_size < WS_END2) { fprintf(stderr, "kernel_launch: unexpected shapes (n_in %d out %d ws %zu)\n", n_in, out_size, ws_size); grid = -1; return; }
        int dev = 0, cus = 0;
        if (hipGetDevice(&dev) != hipSuccess || hipDeviceGetAttribute(&cus, hipDeviceAttributeMultiprocessorCount, dev) != hipSuccess) { grid = -1; return; }
        if (hipFuncSetAttribute((const void*)fwd_kernel, hipFuncAttributeMaxDynamicSharedMemorySize, LDS_BYTES) != hipSuccess) { fprintf(stderr, "kernel_launch: hipFuncSetAttribute failed\n"); grid = -1; return; }
        (void)hipGetLastError();
        grid = cus;
    }
    if (grid < 0) return;
    (void)hipMemsetAsync((char*)d_ws + WS_CTL, 0, CTL_ZERO_BYTES, stream);
    Args a{};
    for (int i = 0; i < 30; ++i) a.in[i] = (const float*)d_in[i];
    a.out = (float*)d_out; a.ws = (unsigned char*)d_ws; a.pad = PROBE_PAD;
#if MK_ONE_LAUNCH
    a.ph_lo = 0; a.ph_hi = N_PHASES; a.li = 0;
    hipLaunchKernelGGL(fwd_kernel, dim3(grid), dim3(NWAVES * 64), LDS_BYTES, stream, a);
#else
    for (int li = 0; li < N_PHASES; ++li) { a.ph_lo = li; a.ph_hi = li + 1; a.li = li;
        hipLaunchKernelGGL(fwd_kernel, dim3(grid), dim3(NWAVES * 64), LDS_BYTES, stream, a); }
#endif
}
```

```cpp
#include <hip/hip_runtime.h>
#include <cstdio>
#include <cstdint>
#include <cmath>

#define PROBE_PAD 0
namespace pg8 {
#define PG8_LAS __attribute__((address_space(3)))
typedef unsigned short bf16_t;
typedef short bf16x8 __attribute__((ext_vector_type(8)));
typedef float f32x4 __attribute__((ext_vector_type(4)));
typedef unsigned u32x4 __attribute__((ext_vector_type(4)));
constexpr int BM = 256, BK = 64, HALF = 128, HTB = HALF * BK * 2  , STAGE_BYTES = 8 * HTB, NXCD = 8, WGM = 8;

__host__ __device__ __forceinline__ int lds_byte(int r, int c) { const int st = (r >> 4) * 2 + (c >> 5), rr = r & 15, cc = c & 31, ob = rr * 64 + cc * 2; return st * 1024 + (ob ^ (((ob >> 9) & 1) << 5)); }
__host__ __device__ __forceinline__ void stage_rc(int b, int& R, int& C) { const int st = b / 1024, sb = b % 1024, swz = sb ^ (((sb >> 9) & 1) << 5); R = (st >> 1) * 16 + swz / 64; C = (st & 1) * 32 + (swz % 64) / 2; }
__host__ __device__ __forceinline__ int perm32(int rho) { const int n = rho >> 4, i = rho & 15; return 8 * (i >> 2) + 4 * n + (i & 3); }

struct Unit { int pm, pn; };
struct Gemm { const bf16_t* A; const bf16_t* Bt; int M, N, K; };

struct StaticOrder {
    int nM, nN, nwg, G, c;
    __host__ __device__ void init(int M, int N, int G_, int c_) { nM = M / BM; nN = N / BM; nwg = nM * nN; G = G_; c = c_; }
    __host__ __device__ bool next(int i, Unit& u) const {
        const long L = (long)i * G + c; if (L >= nwg) return false;
        int wgid = (int)L; { const int q = nwg / NXCD, r = nwg % NXCD, xcd = wgid % NXCD, off = wgid / NXCD; wgid = (xcd < r ? xcd * (q + 1) : r * (q + 1) + (xcd - r) * q) + off; }
        const int nig = WGM * nN, gid = wgid / nig, fm = gid * WGM, gsz = (nM - fm) < WGM ? (nM - fm) : WGM;
        u.pm = fm + ((wgid % nig) % gsz); u.pn = (wgid % nig) / gsz; return true;
    }
    __device__ __forceinline__ void a_ready(const Unit&) const {}
    __device__ __forceinline__ void done(const Unit&) const {}
};

__device__ __forceinline__ unsigned cvt_pk_bf16(float lo, float hi) { unsigned r; asm volatile("v_cvt_pk_bf16_f32 %0, %1, %2" : "=v"(r) : "v"(lo), "v"(hi)); return r; }
typedef float f32x2 __attribute__((ext_vector_type(2)));
__device__ __forceinline__ f32x2 gelu_pk(f32x2 v) {
    const f32x2 av = __builtin_elementwise_abs(v), d = av * 0.2316418882f + 1.0f;
    f32x2 t; t.x = __builtin_amdgcn_rcpf(d.x); t.y = __builtin_amdgcn_rcpf(d.y);
    f32x2 q = t * 0.5307027145f + (-0.7265760135f); q = q * t + 0.7107068705f; q = q * t + (-0.142248368f); q = q * t + 0.127414796f; q = q * t;
    const f32x2 s = (v * v) * (-0.72134752044f);
    f32x2 e; e.x = __builtin_amdgcn_exp2f(s.x); e.y = __builtin_amdgcn_exp2f(s.y);
    const f32x2 m = v * (q * e), r = v - m;
    f32x2 o; o.x = v.x < 0.f ? m.x : r.x; o.y = v.y < 0.f ? m.y : r.y; return o;
}

template <int ACT  > struct EpiBf16 {
    static constexpr bool PERM = true, AFTER_DRAIN = false; static_assert(ACT == 0 || ACT == 1, "EpiBf16: ACT is 0 (none) or 1 (gelu_pk)");
    bf16_t* O; int ldc; const float* bias; int split_cols; size_t split_stride; float scale0;
    __device__ __forceinline__ void operator()(const f32x4 (&acc)[2][2][4][2], const Unit& u, int wr, int wc, int fr, int fq) const {
        const int row0 = u.pm * BM + wr * 64 + fr; int colt = u.pn * BM; bf16_t* base = O;
        float sc = 1.f; if (split_cols) { const int t = colt / split_cols; base += (size_t)t * split_stride; colt -= t * split_cols; if (t == 0) sc = scale0; }
        const int col0 = colt + wc * 32 + 8 * fq, bcol0 = u.pn * BM + wc * 32 + 8 * fq;
        f32x4 bv[2][2];
#pragma unroll
        for (int bj = 0; bj < 2; ++bj)
#pragma unroll
            for (int n = 0; n < 2; ++n) bv[bj][n] = bias ? *(const f32x4*)(bias + bcol0 + bj * HALF + 4 * n) : (f32x4){0.f, 0.f, 0.f, 0.f};
#pragma unroll
        for (int ai = 0; ai < 2; ++ai)
#pragma unroll
            for (int m = 0; m < 4; ++m) { bf16_t* rowp = base + (size_t)(row0 + ai * HALF + m * 16) * ldc + col0;
#pragma unroll
                for (int bj = 0; bj < 2; ++bj) { f32x4 v0 = acc[ai][bj][m][0] + bv[bj][0], v1 = acc[ai][bj][m][1] + bv[bj][1];
                    if (ACT == 1) { f32x2 a = gelu_pk((f32x2){v0[0], v0[1]}), b = gelu_pk((f32x2){v0[2], v0[3]}), c = gelu_pk((f32x2){v1[0], v1[1]}), d = gelu_pk((f32x2){v1[2], v1[3]});
                        v0 = (f32x4){a.x, a.y, b.x, b.y}; v1 = (f32x4){c.x, c.y, d.x, d.y}; }
                    v0 = v0 * sc; v1 = v1 * sc; u32x4 w; w.x = cvt_pk_bf16(v0[0], v0[1]); w.y = cvt_pk_bf16(v0[2], v0[3]); w.z = cvt_pk_bf16(v1[0], v1[1]); w.w = cvt_pk_bf16(v1[2], v1[3]);
                    *(u32x4*)(rowp + bj * HALF) = w; } }
    }
};


template <class Epi, class Sched, bool ALIGN_EPI = false, bool SP2 = false>
__device__ __forceinline__ void gemm_phase(PG8_LAS unsigned char* lds, const Gemm g, const Sched& S, const Epi& E) {
    const int tid = threadIdx.x, wid = __builtin_amdgcn_readfirstlane(tid >> 6), lane = tid & 63, wr = wid >> 2, wc = wid & 3, fr = lane & 15, fq = lane >> 4;
    const int K = g.K, nt = K / BK;
    unsigned voffA[2], voffB[2];
#pragma unroll
    for (int i = 0; i < 2; ++i) { int R, C; stage_rc(tid * 16 + i * 8192, R, C); const int Rb = Epi::PERM ? ((R & ~31) + perm32(R & 31)) : R;
        voffA[i] = (unsigned)(R * K + C) * 2u; voffB[i] = (unsigned)(Rb * K + C) * 2u; }
    const size_t kstep = (size_t)(BK * 2);
    const size_t hstep = (size_t)HALF * K * 2;
    const size_t tstep = 2 * hstep;
    const unsigned ldsw = (unsigned)wid * 1024u;
    const int aoff = lds_byte(wr * 64 + fr, fq * 8), boff = lds_byte(wc * 32 + fr, fq * 8);
#define PG8_SA(b, h) (((b) * 2 + (h)) * HTB)
#define PG8_SB(b, h) ((4 + (b) * 2 + (h)) * HTB)
#define PG8_STAGE(bufoff, gbase, voff) do { _Pragma("unroll") for (int _i = 0; _i < 2; ++_i) \
        __builtin_amdgcn_global_load_lds((const unsigned*)((const char*)(gbase) + (voff)[_i]), (PG8_LAS unsigned*)(lds + (bufoff) + ldsw + _i * 8192), 16, 0, 0); } while (0)
#define PG8_LDA(dst, b, h) do { _Pragma("unroll") for (int m = 0; m < 4; ++m) _Pragma("unroll") for (int k = 0; k < 2; ++k) dst[m][k] = *(const PG8_LAS bf16x8*)(lds + PG8_SA(b, h) + aoff + m * 2048 + k * 1024); } while (0)
#define PG8_LDB(dst, b, h) do { _Pragma("unroll") for (int n = 0; n < 2; ++n) _Pragma("unroll") for (int k = 0; k < 2; ++k) dst[n][k] = *(const PG8_LAS bf16x8*)(lds + PG8_SB(b, h) + boff + n * 2048 + k * 1024); } while (0)
#define PG8_MMA(ai, bj, At, Bt) do { __builtin_amdgcn_s_setprio(1); _Pragma("unroll") for (int m = 0; m < 4; ++m) _Pragma("unroll") for (int n = 0; n < 2; ++n) _Pragma("unroll") for (int k = 0; k < 2; ++k) \
        acc[ai][bj][m][n] = __builtin_amdgcn_mfma_f32_16x16x32_bf16(Bt[n][k], At[m][k], acc[ai][bj][m][n], 0, 0, 0); __builtin_amdgcn_s_setprio(0); } while (0)
#define PG8_WAIT_V(n) asm volatile("s_waitcnt vmcnt(" #n ")" ::: "memory")
#define PG8_WAIT_L(n) asm volatile("s_waitcnt lgkmcnt(" #n ")" ::: "memory")
#define PG8_BAR __builtin_amdgcn_s_barrier()
#define PG8_SCHED __builtin_amdgcn_sched_barrier(0)
    Unit cur, nxt; int ui = 0;
    if (!S.next(0, cur)) return;
    f32x4 acc[2][2][4][2];
#pragma unroll
    for (int a = 0; a < 2; ++a)
#pragma unroll
        for (int b = 0; b < 2; ++b)
#pragma unroll
            for (int m = 0; m < 4; ++m)
#pragma unroll
                for (int n = 0; n < 2; ++n) acc[a][b][m][n] = (f32x4){0.f, 0.f, 0.f, 0.f};
    bf16x8 At[4][2], B0[2][2], B1[2][2];
    const char* cA = (const char*)g.A + (size_t)cur.pm * tstep; const char* cB = (const char*)g.Bt + (size_t)cur.pn * tstep;
    S.a_ready(cur);
    if constexpr (SP2) {
        PG8_STAGE(PG8_SB(0, 0), cB, voffB); PG8_STAGE(PG8_SB(0, 1), cB + hstep, voffB); PG8_STAGE(PG8_SA(0, 0), cA, voffA); PG8_STAGE(PG8_SA(0, 1), cA + hstep, voffA);
        if (wr == 1) PG8_BAR;
        PG8_WAIT_V(2); PG8_BAR;
        PG8_STAGE(PG8_SB(1, 0), cB + kstep, voffB); PG8_STAGE(PG8_SA(1, 0), cA + kstep, voffA); PG8_STAGE(PG8_SB(1, 1), cB + hstep + kstep, voffB);
        PG8_WAIT_V(6); PG8_BAR;
    } else {
        PG8_STAGE(PG8_SB(0, 0), cB, voffB); PG8_STAGE(PG8_SA(0, 0), cA, voffA); PG8_STAGE(PG8_SB(0, 1), cB + hstep, voffB); PG8_STAGE(PG8_SA(0, 1), cA + hstep, voffA);
        if (wr == 1) PG8_BAR;
        PG8_WAIT_V(4); PG8_BAR;
        PG8_STAGE(PG8_SB(1, 0), cB + kstep, voffB); PG8_STAGE(PG8_SA(1, 0), cA + kstep, voffA); PG8_STAGE(PG8_SB(1, 1), cB + hstep + kstep, voffB);
        PG8_WAIT_V(6); PG8_BAR;
    }
    for (;;) {
        const bool has_next = S.next(ui + 1, nxt);
        const char* nA = has_next ? (const char*)g.A + (size_t)nxt.pm * tstep : cA; const char* nB = has_next ? (const char*)g.Bt + (size_t)nxt.pn * tstep : cB;
        for (int t = 0; t < nt; t += 2) {
            const bool last = (t == nt - 2);
            const char* a1 = cA + (size_t)(t + 1) * kstep;
            const char* a2 = last ? nA : cA + (size_t)(t + 2) * kstep; const char* b2 = last ? nB : cB + (size_t)(t + 2) * kstep;
            const char* a3 = a2 + kstep; const char* b3 = b2 + kstep;
            if (last && has_next) S.a_ready(nxt);
            if constexpr (SP2) {
            PG8_LDB(B0, 0, 0); PG8_LDB(B1, 0, 1); PG8_SCHED; PG8_LDA(At, 0, 0); PG8_STAGE(PG8_SA(1, 1), a1 + hstep, voffA);
            PG8_WAIT_V(8); PG8_WAIT_L(0); PG8_BAR; PG8_MMA(0, 0, At, B0); PG8_MMA(0, 1, At, B1); PG8_BAR; PG8_SCHED;
            PG8_LDA(At, 0, 1); PG8_STAGE(PG8_SB(0, 0), b2, voffB); PG8_STAGE(PG8_SB(0, 1), b2 + hstep, voffB); PG8_STAGE(PG8_SA(0, 0), a2, voffA);
            PG8_WAIT_V(8); PG8_WAIT_L(0); PG8_BAR; PG8_MMA(1, 0, At, B0); PG8_MMA(1, 1, At, B1); PG8_BAR; PG8_SCHED;
            PG8_LDB(B0, 1, 0); PG8_LDB(B1, 1, 1); PG8_SCHED; PG8_LDA(At, 1, 0); PG8_STAGE(PG8_SA(0, 1), a2 + hstep, voffA);
            PG8_WAIT_V(8); PG8_WAIT_L(0); PG8_BAR; PG8_MMA(0, 0, At, B0); PG8_MMA(0, 1, At, B1); PG8_BAR; PG8_SCHED;
            PG8_LDA(At, 1, 1); PG8_STAGE(PG8_SB(1, 0), b3, voffB); PG8_STAGE(PG8_SB(1, 1), b3 + hstep, voffB); PG8_STAGE(PG8_SA(1, 0), a3, voffA);
            PG8_WAIT_V(8); PG8_WAIT_L(0); PG8_BAR; PG8_MMA(1, 0, At, B0); PG8_MMA(1, 1, At, B1); PG8_BAR; PG8_SCHED;
            } else {
            PG8_LDB(B0, 0, 0); PG8_SCHED; PG8_LDA(At, 0, 0); PG8_STAGE(PG8_SA(1, 1), a1 + hstep, voffA);
            PG8_WAIT_L(8); PG8_BAR; PG8_WAIT_L(0); PG8_MMA(0, 0, At, B0); PG8_BAR; PG8_SCHED;
            PG8_LDB(B1, 0, 1); PG8_STAGE(PG8_SB(0, 0), b2, voffB);
            PG8_BAR; PG8_WAIT_L(0); PG8_MMA(0, 1, At, B1); PG8_BAR;
            PG8_LDA(At, 0, 1); PG8_STAGE(PG8_SA(0, 0), a2, voffA);
            PG8_BAR; PG8_WAIT_L(0); PG8_MMA(1, 0, At, B0); PG8_BAR; PG8_SCHED;
            PG8_STAGE(PG8_SB(0, 1), b2 + hstep, voffB);
            PG8_WAIT_V(6); PG8_BAR; PG8_MMA(1, 1, At, B1); PG8_BAR;
            PG8_LDB(B0, 1, 0); PG8_SCHED; PG8_LDA(At, 1, 0); PG8_STAGE(PG8_SA(0, 1), a2 + hstep, voffA);
            PG8_WAIT_L(8); PG8_BAR; PG8_WAIT_L(0); PG8_MMA(0, 0, At, B0); PG8_BAR; PG8_SCHED;
            PG8_LDB(B1, 1, 1); PG8_STAGE(PG8_SB(1, 0), b3, voffB);
            PG8_BAR; PG8_WAIT_L(0); PG8_MMA(0, 1, At, B1); PG8_BAR;
            PG8_LDA(At, 1, 1); PG8_STAGE(PG8_SA(1, 0), a3, voffA);
            PG8_BAR; PG8_WAIT_L(0); PG8_MMA(1, 0, At, B0); PG8_BAR; PG8_SCHED;
            PG8_STAGE(PG8_SB(1, 1), b3 + hstep, voffB);
            PG8_WAIT_V(6); PG8_BAR; PG8_MMA(1, 1, At, B1); PG8_BAR;
            }
        }
        if constexpr (ALIGN_EPI) { if (wr == 0) PG8_BAR; }
        if constexpr (!Epi::AFTER_DRAIN) { E(acc, cur, wr, wc, fr, fq); S.done(cur); }
        if (!has_next) break;
#pragma unroll
        for (int a = 0; a < 2; ++a)
#pragma unroll
            for (int b = 0; b < 2; ++b)
#pragma unroll
                for (int m = 0; m < 4; ++m)
#pragma unroll
                    for (int n = 0; n < 2; ++n) acc[a][b][m][n] = (f32x4){0.f, 0.f, 0.f, 0.f};
        cur = nxt; cA = nA; cB = nB; ++ui;
        if constexpr (ALIGN_EPI) { if (wr == 1) PG8_BAR; }
    }
    PG8_WAIT_V(0);
    if constexpr (!ALIGN_EPI) { if (wr == 0) PG8_BAR; }
    PG8_BAR;
    if constexpr (Epi::AFTER_DRAIN) { E.fused(acc, cur, wr, wc, fr, fq, lds, wid, lane); S.done(cur); }
#undef PG8_SA
#undef PG8_SB
#undef PG8_STAGE
#undef PG8_LDA
#undef PG8_LDB
#undef PG8_MMA
#undef PG8_WAIT_V
#undef PG8_WAIT_L
#undef PG8_BAR
#undef PG8_SCHED
}
}
#ifndef PG8_SP2
#define PG8_SP2 true
#endif
#ifndef PG8_ALIGN
#define PG8_ALIGN true
#endif
#define GAS __attribute__((address_space(1)))
#define LAS __attribute__((address_space(3)))
typedef unsigned short bf16;
typedef unsigned v4u __attribute__((ext_vector_type(4)));
typedef float f32x4 __attribute__((ext_vector_type(4)));
typedef short bf16x8 __attribute__((ext_vector_type(8)));
typedef GAS unsigned gu32;
typedef GAS unsigned long long gu64;
#define RLX_AGENT __ATOMIC_RELAXED, __HIP_MEMORY_SCOPE_AGENT
#define LDS_WAIT() asm volatile("s_waitcnt lgkmcnt(0)" ::: "memory")
#define VM_WAIT() asm volatile("s_waitcnt vmcnt(0)" ::: "memory")
__device__ __forceinline__ unsigned long long rt() { return __builtin_amdgcn_s_memrealtime(); }
typedef float f32x2_t __attribute__((ext_vector_type(2))); typedef __bf16 bf16x2_t __attribute__((ext_vector_type(2)));
__device__ __forceinline__ unsigned pk2(float lo, float hi) { const f32x2_t v = {lo, hi}; const bf16x2_t b = __builtin_convertvector(v, bf16x2_t); return __builtin_bit_cast(unsigned, b); }
__device__ __forceinline__ unsigned f2bf(float f) { return pk2(f, 0.f) & 0xffffu; }

#define XB_TMO      128
#define XB_XCNT(j)  (256  + 64 * (j))
#define XB_XSUB(j)  (1280 + 64 * (j))
#define XB_XGEN(j)  (2304 + 64 * (j))
#define XB_TOP      3328
#define XB_TOPGEN   3392
#define XCD_BAR_WORDS 3456
#define XB_SPIN_CAP (1u << 18)

__device__ __forceinline__ unsigned xb_ld(unsigned* p)              { return __hip_atomic_load(p, __ATOMIC_RELAXED, __HIP_MEMORY_SCOPE_AGENT); }
__device__ __forceinline__ unsigned xb_add(unsigned* p, unsigned v) { return __hip_atomic_fetch_add(p, v, __ATOMIC_RELAXED, __HIP_MEMORY_SCOPE_AGENT); }
__device__ __forceinline__ unsigned xb_xcc_id() { return (unsigned)__builtin_amdgcn_s_getreg((3 << 11) | 20) & 0xFu; }
#define XB_SPIN(cond, bar) do { unsigned _sp = 0; while (cond) { __builtin_amdgcn_s_sleep(1); \
    if ((++_sp & 255u) == 0u) { if (xb_ld(&(bar)[XB_TMO])) break; if (_sp > XB_SPIN_CAP) { atomicAdd(&(bar)[XB_TMO], 1u); break; } } } } while (0)

struct XcdBarrier {
    unsigned* bar; unsigned x;
    volatile LAS unsigned* st;
};

__device__ __forceinline__ XcdBarrier xcd_barrier_post(unsigned* bar, volatile LAS unsigned* st) {
    XcdBarrier b; b.bar = bar; b.x = xb_xcc_id(); b.st = st;
    if (threadIdx.x == 0) (void)xb_add(&bar[XB_XCNT(b.x)], 1u);
    return b;
}
__device__ __forceinline__ void xcd_barrier_complete(unsigned* bar, unsigned x, unsigned& nloc, unsigned& nx) {
    const unsigned G = gridDim.x * gridDim.y * gridDim.z;
    unsigned sum, cnt, mine, sp = 0u;
    for (;;) {
        sum = 0u; cnt = 0u; mine = 0u;
#pragma unroll
        for (unsigned j = 0; j < 16; ++j) { const unsigned c = xb_ld(&bar[XB_XCNT(j)]); sum += c; cnt += (c > 0u) ? 1u : 0u; mine = (j == x) ? c : mine; }
        if (sum == G) break;
        __builtin_amdgcn_s_sleep(1);
        if ((++sp & 255u) == 0u) { if (xb_ld(&bar[XB_TMO])) break; if (sp > XB_SPIN_CAP) { atomicAdd(&bar[XB_TMO], 1u); break; } }
    }
    nloc = mine > 0u ? mine : 1u; nx = cnt > 0u ? cnt : 1u;
}

__device__ __forceinline__ void xcd_barrier(const XcdBarrier& b) {
    asm volatile("s_waitcnt vmcnt(0)" ::: "memory");
    __syncthreads();
    if (threadIdx.x == 0) {
        unsigned* bar = b.bar;
        __builtin_amdgcn_s_waitcnt(0);
        unsigned nloc = b.st[0], nx = b.st[1];
        if (nloc == 0u) { xcd_barrier_complete(bar, b.x, nloc, nx); b.st[0] = nloc; b.st[1] = nx; }
        const unsigned old = xb_add(&bar[XB_XSUB(b.x)], 1u);
        const unsigned gen = old / nloc;
        if (old + 1u == (gen + 1u) * nloc) {
            __builtin_amdgcn_fence(__ATOMIC_RELEASE, "agent");
            asm volatile("s_waitcnt vmcnt(0)" ::: "memory");
            const unsigned og = xb_add(&bar[XB_TOP], 1u);
            const unsigned tg = og / nx;
            if (og + 1u == (tg + 1u) * nx) xb_add(&bar[XB_TOPGEN], 1u);
            else XB_SPIN(xb_ld(&bar[XB_TOPGEN]) == tg, bar);
            __builtin_amdgcn_fence(__ATOMIC_ACQUIRE, "agent");
            xb_add(&bar[XB_XGEN(b.x)], 1u);
            asm volatile("s_waitcnt vmcnt(0)" ::: "memory");
        } else {
            XB_SPIN(xb_ld(&bar[XB_XGEN(b.x)]) == gen, bar);
            __builtin_amdgcn_fence(__ATOMIC_ACQUIRE, "agent");
            asm volatile("s_waitcnt vmcnt(0)" ::: "memory");
        }
    }
    __syncthreads();
}

constexpr int NWAVES = 8;
#ifndef FOX_SKIP
#define FOX_SKIP 1
#endif
#ifndef MK_ONE_LAUNCH
#define MK_ONE_LAUNCH 1
#endif
constexpr int N_PHASES = 7;

constexpr int DM = 1024, BATCH = 8, SEQ = 4096, DECB = 32, DECS = 16, PAST = 1024, NMEM = 256;
constexpr int MP = BATCH * SEQ, MS = DECB * DECS, MT = MP + MS;
constexpr int NIN = 3654, NP = 3840;
constexpr int HC_FQ = 0, HC_FK = 384, HC_FV = 768, HC_FG = 1152, HC_RR = 1536, HC_RK = 1920, HC_RV = 2304, HC_RG = 2688,
              HC_MQ = 3072, HC_MG = 3328, HC_WD = 3584, HC_AD = 3616, HC_FF = 3648;
constexpr float NORM_EPS = 1e-6f, GN_EPS = 64e-5f, LOG2E = 1.4426950408889634f, C2 = 0.125f * 1.4426950408889634f;

constexpr size_t O_YP = 0, O_YS = O_YP + (size_t)MP * DM, O_FKP = O_YS + (size_t)MS * DM, O_FVP = O_FKP + (size_t)MP * 384, O_FLP = O_FVP + (size_t)MP * 384,
                 O_MKP = O_FLP + (size_t)MP * 6, O_MVP = O_MKP + (size_t)BATCH * NMEM * 256, O_RSP = O_MVP + (size_t)BATCH * NMEM * 256, O_RHP = O_RSP + (size_t)BATCH * 6 * 4096,
                 O_FKS = O_RHP + (size_t)BATCH * 1600, O_FVS = O_FKS + (size_t)MS * 384, O_FLS = O_FVS + (size_t)MS * 384, O_RSS = O_FLS + (size_t)MS * 6,
                 O_RHS = O_RSS + (size_t)DECB * 6 * 4096, O_END = O_RHS + (size_t)DECB * 1600;
static_assert(O_END == 61933056, "d_out map");

constexpr size_t MiB = 1u << 20;
constexpr size_t WS_CTL = 0, CTL_ZERO_BYTES = 1 * MiB;
constexpr size_t WS_WIN = 2 * MiB, WS_WOUT = 10 * MiB, WS_WMEM = 12 * MiB, WS_MEMN = 13 * MiB, WS_MKV = 17 * MiB, WS_NCKP = 19 * MiB, WS_NCKS = 20 * MiB;
constexpr size_t WS_XN = 24 * MiB;
constexpr size_t WS_H = 96 * MiB;
constexpr size_t WS_END = WS_H + (size_t)MT * NP * 2;
static_assert(WS_XN + (size_t)MT * DM * 2 <= WS_H && WS_END <= 400 * MiB, "d_ws map");
constexpr int CW_BAR = 4096, CW_Q = 64;

constexpr int RING_OFF = 0, RING_BYTES = 131072;
constexpr int LDS_BYTES = 147456;
constexpr int LDSCTL_OFF = LDS_BYTES - 448, MISC_OFF = LDSCTL_OFF + 320;

struct Args { const float* in[30]; float* out; unsigned char* ws; int ph_lo, ph_hi, li, pad; };
enum { I_XP = 0, I_XS, I_MEMP, I_CFK, I_CFV, I_CFL, I_CMK, I_CMV, I_SRW, I_SSH, I_NG, I_WIN, I_FQG, I_FKG, I_FBF, I_MU, I_W0, I_WUP, I_A0, I_AUP,
       I_KK, I_KA, I_RK, I_GNW, I_GNB, I_MNG, I_WMKV, I_MQG, I_MKG, I_WOUT };

struct Ctx { LAS unsigned char* lds; volatile LAS unsigned* MISC; gu32* ctl; int tid, lane, wave, vcu, G; };

__device__ __forceinline__ float bf2f(bf16 u) { return __uint_as_float((unsigned)u << 16); }
__device__ __forceinline__ float wave_sum(float v) {
#pragma unroll
    for (int o = 1; o < 64; o <<= 1) v += __shfl_xor(v, o);
    return v;
}
__device__ __forceinline__ float wave_max(float v) {
#pragma unroll
    for (int o = 1; o < 64; o <<= 1) v = fmaxf(v, __shfl_xor(v, o));
    return v;
}
__device__ __forceinline__ float sum8(float v) { v += __shfl_xor(v, 1); v += __shfl_xor(v, 2); v += __shfl_xor(v, 4); return v; }
__device__ __forceinline__ void unpack8(const v4u w, float (&f)[8]) {
    f[0] = __uint_as_float(w.x << 16); f[1] = __uint_as_float(w.x & 0xffff0000u); f[2] = __uint_as_float(w.y << 16); f[3] = __uint_as_float(w.y & 0xffff0000u);
    f[4] = __uint_as_float(w.z << 16); f[5] = __uint_as_float(w.z & 0xffff0000u); f[6] = __uint_as_float(w.w << 16); f[7] = __uint_as_float(w.w & 0xffff0000u); }
__device__ __forceinline__ void ld8(const float* p, float (&f)[8]) { const f32x4 a = *(const f32x4*)p, b = *(const f32x4*)(p + 4);
    f[0] = a.x; f[1] = a.y; f[2] = a.z; f[3] = a.w; f[4] = b.x; f[5] = b.y; f[6] = b.z; f[7] = b.w; }
__device__ __forceinline__ float fexp(float x) { return __builtin_amdgcn_exp2f(x * LOG2E); }
__device__ __forceinline__ float frcp(float x) { return __builtin_amdgcn_rcpf(x); }
__device__ __forceinline__ float frsq(float x) { return __builtin_amdgcn_rsqf(x); }
__device__ __forceinline__ float flog(float x) { return __builtin_amdgcn_logf(x) * 0.6931471805599453f; }
__device__ __forceinline__ float siluf(float g) { return g * frcp(1.f + fexp(-g)); }
__device__ __forceinline__ float sigmf(float x) { return frcp(1.f + fexp(-x)); }
__device__ __forceinline__ float softplusf(float z) { return fmaxf(z, 0.f) + flog(1.f + fexp(-fabsf(z))); }
__device__ __forceinline__ float ftanh(float x) { return 1.f - 2.f * frcp(fexp(2.f * x) + 1.f); }

__device__ __forceinline__ int colmap_in(int n) {
    if (n < 1152) return n;
    if (n < 1158) return HC_FF + (n - 1152);
    if (n < 1542) return HC_FG + (n - 1158);
    if (n < 3142) { const int m = n - 1542;
        if (m < 1152) return HC_RR + m;
        if (m < 1184) return HC_WD + (m - 1152);
        if (m < 1216) return HC_AD + (m - 1184);
        return HC_RG + (m - 1216); }
    return HC_MQ + (n - 3142);
}
template <int MODE>
__device__ __forceinline__ void transpose_item(const float* W, int K, int N, bf16* WT, LAS float* scr, int item, int lane) {
    const int nblk = (N + 31) / 32, kb = item / nblk, nb = item % nblk, k0 = 64 * kb, n0 = 32 * nb;
    const int nl0 = lane & 31; const bool okn = (n0 + nl0) < N;
#pragma unroll 8
    for (int i = 0; i < 32; ++i) { const int kk = 2 * i + (lane >> 5); scr[kk * 33 + nl0] = okn ? W[(size_t)(k0 + kk) * N + n0 + nl0] : 0.f; }
    LDS_WAIT(); asm volatile("" ::: "memory");
    const int c = lane & 7;
#pragma unroll
    for (int j = 0; j < 4; ++j) { const int nl = (lane >> 3) + 8 * j, n = n0 + nl; const LAS float* s = scr + (8 * c) * 33 + nl;
        v4u o; o.x = pk2(s[0 * 33], s[1 * 33]); o.y = pk2(s[2 * 33], s[3 * 33]); o.z = pk2(s[4 * 33], s[5 * 33]); o.w = pk2(s[6 * 33], s[7 * 33]);
        if (n < N) { const int row = (MODE == 0) ? colmap_in(n) : n; *(v4u*)(WT + (size_t)row * K + k0 + 8 * c) = o; } }
    LDS_WAIT(); asm volatile("" ::: "memory");
}
__device__ __forceinline__ void rms_row_to_bf16(const float* xrow, const float* g, bf16* orow, int lane) {
    const f32x4* xr = (const f32x4*)xrow + lane; const f32x4* gr = (const f32x4*)g + lane;
    f32x4 v[4]; float s = 0.f;
#pragma unroll
    for (int j = 0; j < 4; ++j) { v[j] = xr[64 * j]; s += (v[j].x * v[j].x + v[j].y * v[j].y) + (v[j].z * v[j].z + v[j].w * v[j].w); }
    const float rstd = frsq(wave_sum(s) * (1.f / DM) + NORM_EPS);
    unsigned long long* o8 = (unsigned long long*)orow + lane;
#pragma unroll
    for (int j = 0; j < 4; ++j) { const f32x4 gg = gr[64 * j]; const f32x4 y = v[j] * rstd * gg;
        o8[64 * j] = (unsigned long long)pk2(y.x, y.y) | ((unsigned long long)pk2(y.z, y.w) << 32); }
}
__device__ __forceinline__ void p0_prologue(const Ctx& F, const Args& a) {
    LAS float* scr = (LAS float*)(F.lds + RING_OFF + F.wave * 16384);
    const int gw = F.vcu * NWAVES + F.wave, NGW = F.G * NWAVES;
    bf16* WinT = (bf16*)(a.ws + WS_WIN); bf16* WoutT = (bf16*)(a.ws + WS_WOUT); bf16* WmemT = (bf16*)(a.ws + WS_WMEM);
    constexpr int I_IN = (DM / 64) * ((NIN + 31) / 32), I_OUT = (DM / 64) * (DM / 32), I_MEM = (DM / 64) * (512 / 32);
    for (int it = gw; it < I_IN + I_OUT + I_MEM; it += NGW) {
        int r = it;
        if (r < I_IN) { transpose_item<0>(a.in[I_WIN], DM, NIN, WinT, scr, r, F.lane); continue; } r -= I_IN;
        if (r < I_OUT) { transpose_item<1>(a.in[I_WOUT], DM, DM, WoutT, scr, r, F.lane); continue; } r -= I_OUT;
        transpose_item<1>(a.in[I_WMKV], DM, 512, WmemT, scr, r, F.lane);
    }
    for (int r = NIN + gw; r < NP; r += NGW) { v4u z = {0u, 0u, 0u, 0u}; v4u* p = (v4u*)(WinT + (size_t)r * DM); p[F.lane] = z; p[F.lane + 64] = z; }
    bf16* XN = (bf16*)(a.ws + WS_XN); bf16* MEMN = (bf16*)(a.ws + WS_MEMN);
    for (int m0 = 2 * gw; m0 < MT + BATCH * NMEM; m0 += 2 * NGW) {
        const float* xr = (m0 < MP) ? a.in[I_XP] + (size_t)m0 * DM : (m0 < MT) ? a.in[I_XS] + (size_t)(m0 - MP) * DM : a.in[I_MEMP] + (size_t)(m0 - MT) * DM;
        const f32x4* gr = (const f32x4*)((m0 < MT) ? a.in[I_NG] : a.in[I_MNG]) + F.lane;
        unsigned long long* o8 = (unsigned long long*)((m0 < MT) ? XN + (size_t)m0 * DM : MEMN + (size_t)(m0 - MT) * DM) + F.lane;
        f32x4 v0[4], v1[4]; float s0 = 0.f, s1 = 0.f;
#pragma unroll
        for (int j = 0; j < 4; ++j) { v0[j] = ((const f32x4*)xr)[F.lane + 64 * j]; v1[j] = ((const f32x4*)xr)[256 + F.lane + 64 * j]; }
#pragma unroll
        for (int j = 0; j < 4; ++j) { s0 += (v0[j].x * v0[j].x + v0[j].y * v0[j].y) + (v0[j].z * v0[j].z + v0[j].w * v0[j].w); s1 += (v1[j].x * v1[j].x + v1[j].y * v1[j].y) + (v1[j].z * v1[j].z + v1[j].w * v1[j].w); }
#pragma unroll
        for (int o = 1; o < 64; o <<= 1) { s0 += __shfl_xor(s0, o); s1 += __shfl_xor(s1, o); }
        const float r0 = frsq(s0 * (1.f / DM) + NORM_EPS), r1 = frsq(s1 * (1.f / DM) + NORM_EPS);
#pragma unroll
        for (int j = 0; j < 4; ++j) { const f32x4 gg = gr[64 * j]; const f32x4 y0 = v0[j] * r0 * gg, y1 = v1[j] * r1 * gg;
            o8[64 * j] = (unsigned long long)pk2(y0.x, y0.y) | ((unsigned long long)pk2(y0.z, y0.w) << 32);
            o8[256 + 64 * j] = (unsigned long long)pk2(y1.x, y1.y) | ((unsigned long long)pk2(y1.z, y1.w) << 32); }
    }
}

__device__ __forceinline__ float wave_incl_scan(float v, int lane) {
#pragma unroll
    for (int o = 1; o < 64; o <<= 1) { const float n = __shfl_up(v, o); if (lane >= o) v += n; }
    return v;
}
constexpr int NBLK_PREP = MT / 64 + BATCH * NMEM / 64;
__device__ __forceinline__ void prep_block_task(LAS unsigned char* lds, const Args& a, int blk, int tid, int lane, int wave) {
    bf16* H = (bf16*)(a.ws + WS_H); bf16* MKV = (bf16*)(a.ws + WS_MKV); float* out = a.out;
    LAS float* LF = (LAS float*)lds;
    const int l8 = (lane & 7) * 8;
    __syncthreads();
    if (blk < MT / 64) {
        float gq[8], gk[8], gm[8];
        ld8(a.in[I_FQG] + l8, gq); ld8(a.in[I_FKG] + l8, gk); ld8(a.in[I_MQG] + l8, gm);
#pragma unroll
        for (int e = 0; e < 8; ++e) { gq[e] *= C2; gm[e] *= C2; }
        { constexpr int i0 = 0;
            v4u rq4[8], rk4[8], rv4[8], rm4[8]; float rf[8];
#pragma unroll
            for (int i = 0; i < 8; ++i) { const bf16* hr = H + (size_t)(blk * 64 + wave * 8 + i0 + i) * NP;
                if (lane < 48) { rq4[i] = *(const v4u*)(hr + HC_FQ + lane * 8); rk4[i] = *(const v4u*)(hr + HC_FK + lane * 8); rv4[i] = *(const v4u*)(hr + HC_FV + lane * 8); }
                if (lane < 32) rm4[i] = *(const v4u*)(hr + HC_MQ + lane * 8);
                rf[i] = (lane < 6) ? bf2f(hr[HC_FF + lane]) : 0.f; }
#pragma unroll
            for (int i = 0; i < 8; ++i) {
                const int rl = wave * 8 + i0 + i, m = blk * 64 + rl; bf16* hr = H + (size_t)m * NP;
                float* ok = (m < MP) ? out + O_FKP + (size_t)m * 384 : out + O_FKS + (size_t)(m - MP) * 384;
                float* ov = (m < MP) ? out + O_FVP + (size_t)m * 384 : out + O_FVS + (size_t)(m - MP) * 384;
                float* ol = (m < MP) ? out + O_FLP + (size_t)m * 6 : out + O_FLS + (size_t)(m - MP) * 6;
                if (lane < 48) {
                    float q[8], k[8], v[8];
                    unpack8(rq4[i], q); unpack8(rk4[i], k); unpack8(rv4[i], v);
                    float sq = 0.f, sk = 0.f;
#pragma unroll
                    for (int e = 0; e < 8; ++e) { sq += q[e] * q[e]; sk += k[e] * k[e]; }
                    sq = sum8(sq); sk = sum8(sk);
                    const float rq = frsq(sq * (1.f / 64.f) + NORM_EPS), rk = frsq(sk * (1.f / 64.f) + NORM_EPS);
#pragma unroll
                    for (int e = 0; e < 8; ++e) { q[e] = q[e] * rq * gq[e]; k[e] = k[e] * rk * gk[e]; }
                    v4u wq, wk; wq.x = pk2(q[0], q[1]); wq.y = pk2(q[2], q[3]); wq.z = pk2(q[4], q[5]); wq.w = pk2(q[6], q[7]);
                    wk.x = pk2(k[0], k[1]); wk.y = pk2(k[2], k[3]); wk.z = pk2(k[4], k[5]); wk.w = pk2(k[6], k[7]);
                    *(v4u*)(hr + HC_FQ + lane * 8) = wq; *(v4u*)(hr + HC_FK + lane * 8) = wk;
                    __builtin_nontemporal_store((f32x4){k[0], k[1], k[2], k[3]}, (f32x4*)(ok + lane * 8)); __builtin_nontemporal_store((f32x4){k[4], k[5], k[6], k[7]}, (f32x4*)(ok + lane * 8 + 4));
                    __builtin_nontemporal_store((f32x4){v[0], v[1], v[2], v[3]}, (f32x4*)(ov + lane * 8)); __builtin_nontemporal_store((f32x4){v[4], v[5], v[6], v[7]}, (f32x4*)(ov + lane * 8 + 4));
                }
                if (lane < 32) {
                    float q[8]; unpack8(rm4[i], q);
                    float sq = 0.f;
#pragma unroll
                    for (int e = 0; e < 8; ++e) sq += q[e] * q[e];
                    sq = sum8(sq); const float rq = frsq(sq * (1.f / 64.f) + NORM_EPS);
                    v4u wq; wq.x = pk2(q[0] * rq * gm[0], q[1] * rq * gm[1]); wq.y = pk2(q[2] * rq * gm[2], q[3] * rq * gm[3]); wq.z = pk2(q[4] * rq * gm[4], q[5] * rq * gm[5]); wq.w = pk2(q[6] * rq * gm[6], q[7] * rq * gm[7]);
                    *(v4u*)(hr + HC_MQ + lane * 8) = wq;
                }
                if (lane < 6) { const float z = rf[i] + a.in[I_FBF][lane]; const float lf = -softplusf(-z); ol[lane] = lf; LF[rl * 8 + lane] = lf; }
            }
        }
        __syncthreads();
        if (blk < MP / 64 && wave < 6) {
            const int b = blk / (SEQ / 64), kb = blk % (SEQ / 64);
            const float incl = wave_incl_scan(LF[lane * 8 + wave], lane);
            ((float*)(a.ws + WS_NCKP))[(size_t)(b * 6 + wave) * SEQ + kb * 64 + lane] = incl;
            if (lane == 63) ((float*)(a.ws + WS_NCKS))[(b * 6 + wave) * 64 + kb] = incl;
        }
    } else {
        float gk[8]; ld8(a.in[I_MKG] + l8, gk);
#pragma unroll 2
        for (int i = 0; i < 8; ++i) {
            const int mm = (blk - MT / 64) * 64 + wave * 8 + i; bf16* kr = MKV + (size_t)mm * 512;
            if (lane < 32) {
                float k[8], v[8]; unpack8(*(const v4u*)(kr + lane * 8), k); unpack8(*(const v4u*)(kr + 256 + lane * 8), v);
                float sk = 0.f;
#pragma unroll
                for (int e = 0; e < 8; ++e) sk += k[e] * k[e];
                sk = sum8(sk); const float rk = frsq(sk * (1.f / 64.f) + NORM_EPS);
#pragma unroll
                for (int e = 0; e < 8; ++e) k[e] = k[e] * rk * gk[e];
                v4u wk; wk.x = pk2(k[0], k[1]); wk.y = pk2(k[2], k[3]); wk.z = pk2(k[4], k[5]); wk.w = pk2(k[6], k[7]);
                *(v4u*)(kr + lane * 8) = wk;
                float* okm = out + O_MKP + (size_t)mm * 256 + lane * 8; float* ovm = out + O_MVP + (size_t)mm * 256 + lane * 8;
                *(f32x4*)okm = (f32x4){k[0], k[1], k[2], k[3]}; *(f32x4*)(okm + 4) = (f32x4){k[4], k[5], k[6], k[7]};
                *(f32x4*)ovm = (f32x4){v[0], v[1], v[2], v[3]}; *(f32x4*)(ovm + 4) = (f32x4){v[4], v[5], v[6], v[7]};
            }
        }
    }
}

typedef float f32x16 __attribute__((ext_vector_type(16)));
typedef unsigned u32x2 __attribute__((ext_vector_type(2)));
__device__ __forceinline__ int crow(int r, int hi) { return (r & 3) + 8 * (r >> 2) + 4 * hi; }

struct AttnP { const bf16* Q; int qpitch; const bf16* K; int kpitch; const bf16* V; int vpitch; const float* nck; const float* bt; const float* gq; const float* gk; const bf16* Gt; int gpitch; bf16* O; int opitch; int nt; int q0; int causal; };
constexpr int AT_KS = 0, AT_VT = 9216, AT_NK = 18432, AT_BUF = 18688, AT_PS = 2 * AT_BUF, AT_AL = AT_PS + 8 * 4608;
constexpr int NQ_AT = 768 + 512;
struct AttnPf { float btv, nq0; };
__device__ __forceinline__ void attn_prefetch(AttnPf& pf, const Args& a, int tk, int lane) {
    pf.btv = 0.f; pf.nq0 = 0.f;
    if (tk < 768) { const int qb = 15 - (tk & 15), bh = tk >> 4;
        pf.btv = (lane < 4 * (qb + 1)) ? ((const float*)(a.ws + WS_NCKS))[(size_t)bh * 64 + lane] : 0.f;
        pf.nq0 = ((const float*)(a.ws + WS_NCKP))[(size_t)bh * SEQ + qb * 256]; }
}
constexpr int A6_SLOTB = 8192, A6_K = 0, A6_V = 3 * A6_SLOTB, A6_WS = 6 * A6_SLOTB, A6_OST = A6_WS + 8 * 256, A6_NK = A6_OST + 8 * 8192, A6_END = A6_NK + 3 * 2048;
static_assert(A6_END <= RING_BYTES, "attention LDS map");
typedef short s16x4 __attribute__((ext_vector_type(4)));
typedef LAS const char* lds_cptr;
#define A6_SBAR() __builtin_amdgcn_sched_barrier(0)
#define A6_PIN(x) asm volatile("" : "+v"(x))
#define A6_MFMA(a, b, c) __builtin_amdgcn_mfma_f32_32x32x16_bf16(a, b, c, 0, 0, 0)
#define A6_WAIT_BAR(N) asm volatile("s_waitcnt vmcnt(" #N ") lgkmcnt(0)\n\ts_barrier" ::: "memory")
__device__ __forceinline__ void a6_glds16(const void* g, unsigned lds_base) {
    unsigned sv; asm volatile("s_mov_b32 %0, m0\n\ts_mov_b32 m0, %2\n\ts_nop 0\n\tglobal_load_lds_dwordx4 %1, off\n\ts_mov_b32 m0, %0" : "=&s"(sv) : "v"(g), "s"(lds_base) : "memory"); }
__device__ __forceinline__ void a6_glds4(const void* g, unsigned lds_base) {
    unsigned sv; asm volatile("s_mov_b32 %0, m0\n\ts_mov_b32 m0, %2\n\ts_nop 0\n\tglobal_load_lds_dword %1, off\n\ts_mov_b32 m0, %0" : "=&s"(sv) : "v"(g), "s"(lds_base) : "memory"); }
__device__ __forceinline__ void a6_kload2(bf16x8* kf, lds_cptr kp, int d0) { kf[2 * d0] = *(LAS const bf16x8*)(kp + d0 * 2048); kf[2 * d0 + 1] = *(LAS const bf16x8*)(kp + d0 * 2048 + 512); }
__device__ __forceinline__ s16x4 a6_vtr(lds_cptr p) { return __builtin_bit_cast(s16x4, __builtin_amdgcn_ds_read_tr16_b64_v4i16((LAS s16x4*)p)); }
#define A6_MX3(a, b, c) __builtin_fmaxf(__builtin_fmaxf((a), (b)), (c))
__device__ __forceinline__ float a6_rowmax(const f32x16& p0, const f32x16& p1) {
    float a = A6_MX3(p0[0], p0[1], p1[0]), b = A6_MX3(p0[2], p0[3], p1[1]); a = A6_MX3(a, p1[2], p1[3]);
#pragma unroll
    for (int r = 4; r < 16; r += 4) { a = A6_MX3(a, p0[r], p0[r + 1]); b = A6_MX3(b, p0[r + 2], p0[r + 3]); a = A6_MX3(a, p1[r], p1[r + 1]); b = A6_MX3(b, p1[r + 2], p1[r + 3]); }
    float m = __builtin_fmaxf(a, b); auto rr = __builtin_amdgcn_permlane32_swap(__float_as_uint(m), __float_as_uint(m), false, false);
    return __builtin_fmaxf(__uint_as_float(rr[0]), __uint_as_float(rr[1])); }
__device__ __forceinline__ void a6_cmask(f32x16& p0, f32x16& p1, int jb, int qrel, int hi) {
    const int qk = qrel - 64 * jb - 4 * hi;
#pragma unroll
    for (int r = 0; r < 16; ++r) { const int kc = (r & 3) + 8 * (r >> 2); if (kc > qk) p0[r] = -INFINITY; if (kc + 32 > qk) p1[r] = -INFINITY; } }

template <bool BIAS, bool CAUSAL>
__device__ __forceinline__ void attn64_unit(LAS unsigned char* lds, const bf16* Qw, int qpitch, const bf16* K, int kpitch, const bf16* V, int vpitch, const float* nck, float pre, int t0, float cq0, float mhat0,
                                            int NT, const bf16* Gw, int gpitch, bf16* Ow, int opitch, const Args& a, AttnPf& pfn, volatile LAS unsigned* nextw, int& nx, int tid, int lane, int wid) {
    asm volatile("" : "+v"(lane));
    const int r32 = lane & 31, hi = lane >> 5;
    const unsigned lds0 = (unsigned)(size_t)lds; LAS float* wsf = (LAS float*)(lds + A6_WS) + wid * 64; LAS float* wsfh = wsf + 4 * hi;
    const bf16* ksrc = K + (size_t)lane * kpitch + wid * 8;
    const bf16* vsrc = V + (size_t)(16 * (wid & 3) + (lane >> 2)) * vpitch + (wid >> 2) * 32 + (lane & 3) * 8;
    const float* nsrc = nck + lane;
    const unsigned kdst = lds0 + A6_K + wid * 1024, vdst = lds0 + A6_V + wid * 1024, ndst = lds0 + A6_NK + wid * 256;
#define DMA_K(t, slot) do { a6_glds16(ksrc + (size_t)(t) * 64 * kpitch, (unsigned)__builtin_amdgcn_readfirstlane(kdst + (slot))); \
                            if (BIAS) a6_glds4(nsrc + (t) * 64, (unsigned)__builtin_amdgcn_readfirstlane(ndst + ((slot) >> 2))); } while (0)
#define DMA_V(t, slot) a6_glds16(vsrc + (size_t)(t) * 64 * vpitch, (unsigned)__builtin_amdgcn_readfirstlane(vdst + (slot)))
    const lds_cptr vp0 = (lds_cptr)lds + A6_V + ((lane >> 4) & 1) * 32 + (lane & 3) * 8 + (4 * hi + ((lane & 15) >> 2)) * 64;
    const lds_cptr kp0 = (lds_cptr)lds + A6_K + hi * 1024 + r32 * 16;
    const lds_cptr np0 = (lds_cptr)lds + A6_NK + wid * 256 + hi * 16;
    bf16x8 qr[4];
#pragma unroll
    for (int d0 = 0; d0 < 4; ++d0) qr[d0] = *reinterpret_cast<const bf16x8*>(&Qw[(size_t)r32 * qpitch + d0 * 16 + hi * 8]);
    float mhat = mhat0, l_reg = 0.f; asm volatile("" : "+v"(mhat));
    DMA_K(0, 0); DMA_V(0, 0); DMA_K(1, A6_SLOTB); DMA_K(2, 2 * A6_SLOTB);
    f32x16 o[2]; o[0] = f32x16{}; o[1] = f32x16{};
    const int qrel = wid * 32 + r32; bool resc = false;
    f32x16 pA0, pA1, pB0, pB1; bf16x8 kf[8]; s16x4 vlo[8], vhi[8]; v4u pw0, pw1, pw2, pw3;
    int sl_prev = 0, sl_cur = 0, sl_next = A6_SLOTB;
#define ROT() do { sl_prev = sl_cur; sl_cur = sl_next; sl_next = (sl_next == 2 * A6_SLOTB) ? 0 : sl_next + A6_SLOTB; } while (0)
#define CTV(tt) (BIAS ? (cq0 - __int_as_float(__builtin_amdgcn_readlane(__float_as_int(pre), t0 + (tt)))) * LOG2E - mhat : -mhat)
#define BIASF(y, ct) (BIAS ? __builtin_fmaf((y), -LOG2E, (ct)) : (ct))
#define NKRD(P0, P1, slot) do { if (BIAS) { _Pragma("unroll") for (int g_ = 0; g_ < 4; ++g_) { const f32x4 a0_ = *(LAS const f32x4*)(np0 + ((slot) >> 2) + g_ * 32), a1_ = *(LAS const f32x4*)(np0 + ((slot) >> 2) + 128 + g_ * 32); \
        P0[4 * g_] = a0_.x; P0[4 * g_ + 1] = a0_.y; P0[4 * g_ + 2] = a0_.z; P0[4 * g_ + 3] = a0_.w; P1[4 * g_] = a1_.x; P1[4 * g_ + 1] = a1_.y; P1[4 * g_ + 2] = a1_.z; P1[4 * g_ + 3] = a1_.w; } } } while (0)
#define EX(v) __builtin_amdgcn_exp2f(v)
#define RESC() do { if (resc) { _Pragma("unroll") for (int d_ = 0; d_ < 2; ++d_) _Pragma("unroll") for (int r = 0; r < 16; ++r) o[d_][r] *= wsfh[(r & 3) + 8 * (r >> 2)]; } } while (0)
#define DECIDE(C0, C1, WITH_L) do { const float rm_ = a6_rowmax(C0, C1); resc = false; \
      if (__builtin_expect(__any(rm_ > 8.f), 0)) { const float dl_ = __builtin_fmaxf(rm_, 0.f); mhat += dl_; \
          _Pragma("unroll") for (int r = 0; r < 16; ++r) { C0[r] -= dl_; C1[r] -= dl_; } \
          if (WITH_L) { const float f_ = __builtin_amdgcn_exp2f(-dl_); l_reg *= f_; if (hi == 0) wsf[r32] = f_; resc = true; } } } while (0)
    if (BIAS) { A6_WAIT_BAR(5); } else { A6_WAIT_BAR(3); }
    nx = (int)*nextw; if (nx < NQ_AT) attn_prefetch(pfn, a, nx, lane);
    NKRD(pA0, pA1, 0);
    { const float ct = CTV(0);
#pragma unroll
      for (int r = 0; r < 16; ++r) { pA0[r] = BIASF(pA0[r], ct); pA1[r] = BIASF(pA1[r], ct); } }
    _Pragma("unroll") for (int d0 = 0; d0 < 4; ++d0) a6_kload2(kf, kp0, d0);
    pA0 = A6_MFMA(kf[0], qr[0], pA0); pA1 = A6_MFMA(kf[1], qr[0], pA1); pA0 = A6_MFMA(kf[2], qr[1], pA0); pA1 = A6_MFMA(kf[3], qr[1], pA1);
    pA0 = A6_MFMA(kf[4], qr[2], pA0); pA1 = A6_MFMA(kf[5], qr[2], pA1); pA0 = A6_MFMA(kf[6], qr[3], pA0); pA1 = A6_MFMA(kf[7], qr[3], pA1);
    if (CAUSAL && NT == 4) a6_cmask(pA0, pA1, 0, qrel, hi);
    DECIDE(pA0, pA1, false);
#pragma unroll
    for (int r = 0; r < 16; ++r) { pA0[r] = EX(pA0[r]); pA1[r] = EX(pA1[r]); }
    A6_WAIT_BAR(0);
    DMA_K(3, 0); DMA_V(1, A6_SLOTB); ROT();
    _Pragma("unroll") for (int d0 = 0; d0 < 4; ++d0) a6_kload2(kf, kp0 + sl_cur, d0);
    NKRD(pB0, pB1, sl_cur);
    { const float ct = CTV(1);
#pragma unroll
      for (int r = 0; r < 16; ++r) { pB0[r] = BIASF(pB0[r], ct); pB1[r] = BIASF(pB1[r], ct); } }
    if (BIAS) { A6_WAIT_BAR(3); } else { A6_WAIT_BAR(2); }
#define PKW(P, i) pk2(P[i], P[i + 1])
#define PAF(k) __builtin_bit_cast(bf16x8, pw##k)
#define VFR(i) (bf16x8){vlo[i][0], vlo[i][1], vlo[i][2], vlo[i][3], vhi[i][0], vhi[i][1], vhi[i][2], vhi[i][3]}
#define VRD(i) do { vlo[i] = a6_vtr(vp_ + (((i) >> 2) * 4096 + ((i) & 3) * 1024)); vhi[i] = a6_vtr(vp_ + (((i) >> 2) * 4096 + ((i) & 3) * 1024 + 512)); } while (0)
#define KRD(G, d0) do { if (G) { a6_kload2(kf, kp0 + sl_next, d0); A6_SBAR(); } } while (0)
#define GAPA(MF, a0, a1, a2, a3, W0, W1, PW) do { MF; sacc += a0; sacc += a1; sacc += a2; sacc += a3; W0; W1; A6_PIN(PW); A6_PIN(sacc); A6_SBAR(); } while (0)
#define GAPB(MF, X, i, G, Y) do { MF; X[i] = EX(X[i]); X[i + 1] = EX(X[i + 1]); X[i + 2] = EX(X[i + 2]); X[i + 3] = EX(X[i + 3]); \
        if (G) { Y[i] = BIASF(Y[i], ctn); Y[i + 1] = BIASF(Y[i + 1], ctn); Y[i + 2] = BIASF(Y[i + 2], ctn); Y[i + 3] = BIASF(Y[i + 3], ctn); A6_PIN(Y); } A6_PIN(X); A6_SBAR(); } while (0)
#define STEP(C0, C1, P0, P1, t, MASK, GK, GV, GL) do { A6_SBAR(); \
    const lds_cptr vp_ = vp0 + sl_prev; \
    VRD(0); A6_SBAR(); float sacc = P0[0] + P0[1]; \
                       GAPA(C0 = A6_MFMA(kf[0], qr[0], C0), P0[2], P0[3], P0[4], P0[5],     pw0[0] = PKW(P0, 0),  pw0[1] = PKW(P0, 2),  pw0); \
    VRD(4); A6_SBAR(); GAPA(C1 = A6_MFMA(kf[1], qr[0], C1), P0[6], P0[7], P0[8], P0[9],     pw0[2] = PKW(P0, 4),  pw0[3] = PKW(P0, 6),  pw0); \
    VRD(1); A6_SBAR(); GAPA(C0 = A6_MFMA(kf[2], qr[1], C0), P0[10], P0[11], P0[12], P0[13], pw1[0] = PKW(P0, 8),  pw1[1] = PKW(P0, 10), pw1); \
    VRD(5); A6_SBAR(); GAPA(C1 = A6_MFMA(kf[3], qr[1], C1), P0[14], P0[15], P1[0], P1[1],   pw1[2] = PKW(P0, 12), pw1[3] = PKW(P0, 14), pw1); \
    VRD(2); A6_SBAR(); GAPA(C0 = A6_MFMA(kf[4], qr[2], C0), P1[2], P1[3], P1[4], P1[5],     pw2[0] = PKW(P1, 0),  pw2[1] = PKW(P1, 2),  pw2); \
    VRD(6); A6_SBAR(); GAPA(C1 = A6_MFMA(kf[5], qr[2], C1), P1[6], P1[7], P1[8], P1[9],     pw2[2] = PKW(P1, 4),  pw2[3] = PKW(P1, 6),  pw2); \
    VRD(3); A6_SBAR(); GAPA(C0 = A6_MFMA(kf[6], qr[3], C0), P1[10], P1[11], P1[12], P1[13], pw3[0] = PKW(P1, 8),  pw3[1] = PKW(P1, 10), pw3); \
    VRD(7); A6_SBAR(); GAPA(C1 = A6_MFMA(kf[7], qr[3], C1), P1[14], P1[15], 0.f, 0.f,       pw3[2] = PKW(P1, 12), pw3[3] = PKW(P1, 14), pw3); \
    l_reg += sacc; \
    if (GK) DMA_K((t) + 3, sl_cur); if (GV) DMA_V((t) + 1, sl_next); \
    if (GL) NKRD(P0, P1, sl_next);                                                       \
    if (MASK && CAUSAL) a6_cmask(C0, C1, (t) - (NT - 4), qrel, hi); \
    DECIDE(C0, C1, true); \
    const float ctn = CTV((t) + 1); A6_SBAR(); \
    GAPB(o[0] = A6_MFMA(PAF(0), VFR(0), o[0]), C0, 0, GL, P0);              GAPB(o[1] = A6_MFMA(PAF(0), VFR(4), o[1]), C0, 4, GL, P0); \
    KRD(GL, 0); GAPB(o[0] = A6_MFMA(PAF(1), VFR(1), o[0]), C0, 8, GL, P0);  KRD(GL, 1); GAPB(o[1] = A6_MFMA(PAF(1), VFR(5), o[1]), C0, 12, GL, P0); \
    KRD(GL, 2); GAPB(o[0] = A6_MFMA(PAF(2), VFR(2), o[0]), C1, 0, GL, P1);  KRD(GL, 3); GAPB(o[1] = A6_MFMA(PAF(2), VFR(6), o[1]), C1, 4, GL, P1); \
    GAPB(o[0] = A6_MFMA(PAF(3), VFR(3), o[0]), C1, 8, GL, P1);              GAPB(o[1] = A6_MFMA(PAF(3), VFR(7), o[1]), C1, 12, GL, P1); \
    } while (0)
#define STEADYW() do { if (BIAS) { A6_WAIT_BAR(3); } else { A6_WAIT_BAR(2); } } while (0)
    int t = 1;
    for (; t + 5 < NT; t += 2) {
        STEP(pB0, pB1, pA0, pA1, t, false, true, true, true);     STEADYW(); RESC(); ROT();
        STEP(pA0, pA1, pB0, pB1, t + 1, false, true, true, true); STEADYW(); RESC(); ROT();
    }
#define ENDW(tt) do { if ((tt) + 3 < NT) { STEADYW(); } else if ((tt) + 2 < NT) { A6_WAIT_BAR(1); } else { A6_WAIT_BAR(0); } } while (0)
    for (; t + 1 < NT; t += 2) {
        STEP(pB0, pB1, pA0, pA1, t, true, (t + 3 < NT), (t + 1 < NT), (t + 1 < NT));         ENDW(t);     RESC(); ROT();
        STEP(pA0, pA1, pB0, pB1, t + 1, true, (t + 4 < NT), (t + 2 < NT), (t + 2 < NT));     ENDW(t + 1); RESC(); ROT();
    }
    const int erow = lane >> 3, ech = lane & 7;
    v4u gt[4];
#pragma unroll
    for (int i = 0; i < 4; ++i) gt[i] = *(const v4u*)(Gw + (size_t)(i * 8 + erow) * gpitch + ech * 8);
    STEP(pB0, pB1, pA0, pA1, NT - 1, true, false, false, false); RESC();
    { float sacc = pB0[0] + pB0[1];
#pragma unroll
      for (int r = 2; r < 16; ++r) sacc += pB0[r];
#pragma unroll
      for (int r = 0; r < 16; ++r) sacc += pB1[r];
      l_reg += sacc;
      pw0 = (v4u){PKW(pB0, 0), PKW(pB0, 2), PKW(pB0, 4), PKW(pB0, 6)}; pw1 = (v4u){PKW(pB0, 8), PKW(pB0, 10), PKW(pB0, 12), PKW(pB0, 14)};
      pw2 = (v4u){PKW(pB1, 0), PKW(pB1, 2), PKW(pB1, 4), PKW(pB1, 6)}; pw3 = (v4u){PKW(pB1, 8), PKW(pB1, 10), PKW(pB1, 12), PKW(pB1, 14)};
      const lds_cptr vp_ = vp0 + sl_cur; _Pragma("unroll") for (int i = 0; i < 8; ++i) VRD(i);
      o[0] = A6_MFMA(PAF(0), VFR(0), o[0]); o[1] = A6_MFMA(PAF(0), VFR(4), o[1]); o[0] = A6_MFMA(PAF(1), VFR(1), o[0]); o[1] = A6_MFMA(PAF(1), VFR(5), o[1]);
      o[0] = A6_MFMA(PAF(2), VFR(2), o[0]); o[1] = A6_MFMA(PAF(2), VFR(6), o[1]); o[0] = A6_MFMA(PAF(3), VFR(3), o[0]); o[1] = A6_MFMA(PAF(3), VFR(7), o[1]); }
    { auto rr = __builtin_amdgcn_permlane32_swap(__float_as_uint(l_reg), __float_as_uint(l_reg), false, false); l_reg = __uint_as_float(rr[0]) + __uint_as_float(rr[1]); }
    if (hi == 0) wsf[32 + r32] = l_reg;
    asm volatile("s_waitcnt lgkmcnt(0)" ::: "memory"); __builtin_amdgcn_wave_barrier();
    LAS float* stg = (LAS float*)(lds + A6_OST) + wid * 2048; LAS float* stgh = stg + 4 * hi * 64 + r32;
#pragma unroll
    for (int r = 0; r < 16; ++r) { const int oc = (r & 3) + 8 * (r >> 2); const float rl = __builtin_amdgcn_rcpf(wsfh[32 + oc]);
        stgh[oc * 64] = o[0][r] * rl; stgh[oc * 64 + 32] = o[1][r] * rl; }
    asm volatile("s_waitcnt lgkmcnt(0)" ::: "memory"); __builtin_amdgcn_wave_barrier();
#pragma unroll
    for (int i = 0; i < 4; ++i) { const int row = i * 8 + erow;
        const f32x4 x0 = *(LAS const f32x4*)(stg + row * 64 + ech * 8), x1 = *(LAS const f32x4*)(stg + row * 64 + ech * 8 + 4); const v4u g = gt[i]; v4u w;
        w.x = pk2(x0.x * siluf(__uint_as_float(g.x << 16)), x0.y * siluf(__uint_as_float(g.x & 0xffff0000u)));
        w.y = pk2(x0.z * siluf(__uint_as_float(g.y << 16)), x0.w * siluf(__uint_as_float(g.y & 0xffff0000u)));
        w.z = pk2(x1.x * siluf(__uint_as_float(g.z << 16)), x1.y * siluf(__uint_as_float(g.z & 0xffff0000u)));
        w.w = pk2(x1.z * siluf(__uint_as_float(g.w << 16)), x1.w * siluf(__uint_as_float(g.w & 0xffff0000u)));
        *(v4u*)(Ow + (size_t)row * opitch + ech * 8) = w; }
    asm volatile("s_waitcnt lgkmcnt(0)\n\ts_barrier" ::: "memory");
#undef DMA_K
#undef DMA_V
#undef ROT
#undef CTV
#undef BIASF
#undef NKRD
#undef EX
#undef RESC
#undef DECIDE
#undef PKW
#undef PAF
#undef VFR
#undef VRD
#undef KRD
#undef ENDW
#undef STEADYW
#undef GAPA
#undef GAPB
#undef STEP
}

template <bool FOX>
__device__ __forceinline__ void attn_unit(LAS unsigned char* lds, const AttnP& p, const Args& a, const AttnPf& pf, AttnPf& pfn, volatile LAS unsigned* nextw, int& nx, float Bb, float Bm, int tid, int lane, int wave) {
    const int r32 = lane & 31;
    const bf16* Qw = p.Q + (size_t)(wave * 32) * p.qpitch; const bf16* Gw = p.Gt + (size_t)(wave * 32) * p.gpitch; bf16* Ow = p.O + (size_t)(wave * 32) * p.opitch;
    if constexpr (FOX) {
        const float btv = pf.btv; const float incl = wave_incl_scan(btv, lane); const float pre = incl - btv;
        const float cq0 = __shfl(pre, p.q0 >> 6) + pf.nq0;
        int t0 = 0;
#if FOX_SKIP
        const bool skip = (lane < (p.q0 >> 6)) && ((cq0 - incl) * LOG2E + 2.f * Bb < -150.f);
        t0 = __builtin_popcountll(__ballot(skip)) & ~1;
#endif
        const int qi = p.q0 + wave * 32 + r32;
        const float ci = __shfl(pre, qi >> 6) + p.nck[qi];
        const float mhat0 = (cq0 - ci) * LOG2E - fmaxf(Bb - 60.f, 0.f);
        attn64_unit<true, true>(lds, Qw, p.qpitch, p.K + (size_t)t0 * 64 * p.kpitch, p.kpitch, p.V + (size_t)t0 * 64 * p.vpitch, p.vpitch, p.nck + t0 * 64, pre, t0, cq0, mhat0, p.nt - t0,
                                Gw, p.gpitch, Ow, p.opitch, a, pfn, nextw, nx, tid, lane, wave);
    } else {
        attn64_unit<false, false>(lds, Qw, p.qpitch, p.K, p.kpitch, p.V, p.vpitch, nullptr, 0.f, 0, 0.f, -fmaxf(Bm - 60.f, 0.f), p.nt, Gw, p.gpitch, Ow, p.opitch, a, pfn, nextw, nx, tid, lane, wave);
    }
}

struct SmallP { const bf16* Q; int qpitch; const float* Kc; int kpitch; const float* Vc; int vpitch; int P; const float* lfp; const float* lfn; const bf16* Kn; const bf16* Vn; int npitch; const bf16* Gt; int gpitch; bf16* O; int opitch; };
__device__ __forceinline__ bf16x8 cvt8(const f32x4 a, const f32x4 b) { v4u w; w.x = pk2(a.x, a.y); w.y = pk2(a.z, a.w); w.z = pk2(b.x, b.y); w.w = pk2(b.z, b.w); return __builtin_bit_cast(bf16x8, w); }
constexpr int SA_M = 0, SA_L = 512, SA_O = 1024, SA_NCK = 33792;
__device__ __forceinline__ void sample_attn(LAS unsigned char* lds, const SmallP& p, int tid, int lane, int wave) {
    const int r32 = lane & 31, hi = lane >> 5, qrow = r32 & 15;
    bf16x8 qr[4];
    { const bf16* qp = p.Q + (size_t)qrow * p.qpitch;
#pragma unroll
      for (int d0 = 0; d0 < 4; ++d0) qr[d0] = *(const bf16x8*)(qp + 16 * d0 + 8 * hi); }
    f32x16 o0, o1;
#pragma unroll
    for (int r = 0; r < 16; ++r) { o0[r] = 0.f; o1[r] = 0.f; }
    float m_run = -INFINITY, l_run = 0.f;
    const int npast = p.P / 64, nt = npast + (p.Kn ? 1 : 0);
    LAS float* NCK = (LAS float*)(lds + SA_NCK);
    if (p.lfp) {
        LAS float* WTOT = (LAS float*)(lds + SA_NCK + 4608);
        __syncthreads();
        const float x0 = p.lfp[(size_t)(2 * tid) * 6], x1 = p.lfp[(size_t)(2 * tid + 1) * 6];
        const float incl = wave_incl_scan(x0 + x1, lane);
        if (lane == 63) WTOT[wave] = incl;
        __syncthreads();
        float before = 0.f, total = 0.f;
#pragma unroll
        for (int w = 0; w < 8; ++w) { const float tv = WTOT[w]; total += tv; before += (w < wave) ? tv : 0.f; }
        const float s1 = total - (before + incl);
        NCK[2 * tid + 1] = s1 * LOG2E; NCK[2 * tid] = (s1 + x1) * LOG2E;
        if (tid < 64) { float cum = 0.f; for (int i = 0; i <= tid && i < 16; ++i) cum += p.lfn[(size_t)i * 6]; NCK[1024 + tid] = (tid < 16) ? -cum * LOG2E : 0.f; }
        __syncthreads();
    }
    for (int t = wave; t < nt; t += 8) {
        const bool isnew = (t >= npast);
        f32x16 c0, c1;
        if (p.lfp) {
#pragma unroll
            for (int g = 0; g < 4; ++g) { const f32x4 a0 = *(const LAS f32x4*)(NCK + t * 64 + 8 * g + 4 * hi), a1 = *(const LAS f32x4*)(NCK + t * 64 + 32 + 8 * g + 4 * hi);
                c0[4 * g] = a0.x; c0[4 * g + 1] = a0.y; c0[4 * g + 2] = a0.z; c0[4 * g + 3] = a0.w; c1[4 * g] = a1.x; c1[4 * g + 1] = a1.y; c1[4 * g + 2] = a1.z; c1[4 * g + 3] = a1.w; }
        } else {
#pragma unroll
            for (int r = 0; r < 16; ++r) { c0[r] = 0.f; c1[r] = 0.f; }
        }
        if (!isnew) {
            const float* k0p = p.Kc + (size_t)(t * 64 + r32) * p.kpitch + 8 * hi; const float* k1p = k0p + (size_t)32 * p.kpitch;
#pragma unroll
            for (int d0 = 0; d0 < 4; ++d0) {
                const bf16x8 k0 = cvt8(*(const f32x4*)(k0p + 16 * d0), *(const f32x4*)(k0p + 16 * d0 + 4));
                const bf16x8 k1 = cvt8(*(const f32x4*)(k1p + 16 * d0), *(const f32x4*)(k1p + 16 * d0 + 4));
                c0 = __builtin_amdgcn_mfma_f32_32x32x16_bf16(k0, qr[d0], c0, 0, 0, 0);
                c1 = __builtin_amdgcn_mfma_f32_32x32x16_bf16(k1, qr[d0], c1, 0, 0, 0);
            }
        } else {
            const bf16* k0p = p.Kn + (size_t)(r32 & 15) * p.npitch + 8 * hi;
#pragma unroll
            for (int d0 = 0; d0 < 4; ++d0) {
                const bf16x8 k0 = *(const bf16x8*)(k0p + 16 * d0);
                c0 = __builtin_amdgcn_mfma_f32_32x32x16_bf16(k0, qr[d0], c0, 0, 0, 0);
            }
#pragma unroll
            for (int r = 0; r < 16; ++r) { const int kv = 4 * hi + (r & 3) + 8 * (r >> 2); if (kv > qrow) c0[r] = -INFINITY; c1[r] = -INFINITY; }
        }
        float mx = fmaxf(c0[0], c1[0]);
#pragma unroll
        for (int r = 1; r < 16; ++r) mx = fmaxf(mx, fmaxf(c0[r], c1[r]));
        mx = fmaxf(mx, __shfl_xor(mx, 32));
        const float mn = fmaxf(m_run, mx);
        const float alpha = __builtin_amdgcn_exp2f(m_run - mn);
        m_run = mn;
        float sum = 0.f;
#pragma unroll
        for (int r = 0; r < 16; ++r) { c0[r] = __builtin_amdgcn_exp2f(c0[r] - mn); c1[r] = __builtin_amdgcn_exp2f(c1[r] - mn); sum += c0[r] + c1[r]; }
        l_run = l_run * alpha + sum;
#pragma unroll
        for (int r = 0; r < 8; ++r) { const float al = __shfl(alpha, crow(r, hi)); o0[r] *= al; o1[r] *= al; }
#pragma unroll
        for (int blk = 0; blk < 2; ++blk) {
            if (isnew && blk == 1) break;
#pragma unroll
            for (int s = 0; s < 2; ++s) {
                v4u pw;
                if (blk == 0) { pw.x = pk2(c0[8 * s], c0[8 * s + 1]); pw.y = pk2(c0[8 * s + 2], c0[8 * s + 3]); pw.z = pk2(c0[8 * s + 4], c0[8 * s + 5]); pw.w = pk2(c0[8 * s + 6], c0[8 * s + 7]); }
                else          { pw.x = pk2(c1[8 * s], c1[8 * s + 1]); pw.y = pk2(c1[8 * s + 2], c1[8 * s + 3]); pw.z = pk2(c1[8 * s + 4], c1[8 * s + 5]); pw.w = pk2(c1[8 * s + 6], c1[8 * s + 7]); }
                const bf16x8 pa = __builtin_bit_cast(bf16x8, pw);
                float va[8], vb[8];
#pragma unroll
                for (int j = 0; j < 8; ++j) { const int kvl = 32 * blk + 16 * s + 8 * (j >> 2) + 4 * hi + (j & 3);
                    if (!isnew) { const float* vp = p.Vc + (size_t)(t * 64 + kvl) * p.vpitch; va[j] = vp[r32]; vb[j] = vp[32 + r32]; }
                    else { const bf16* vp = p.Vn + (size_t)(kvl & 15) * p.npitch; va[j] = bf2f(vp[r32]); vb[j] = bf2f(vp[32 + r32]); } }
                const bf16x8 v0 = cvt8((f32x4){va[0], va[1], va[2], va[3]}, (f32x4){va[4], va[5], va[6], va[7]});
                const bf16x8 v1 = cvt8((f32x4){vb[0], vb[1], vb[2], vb[3]}, (f32x4){vb[4], vb[5], vb[6], vb[7]});
                o0 = __builtin_amdgcn_mfma_f32_32x32x16_bf16(pa, v0, o0, 0, 0, 0);
                o1 = __builtin_amdgcn_mfma_f32_32x32x16_bf16(pa, v1, o1, 0, 0, 0);
            }
        }
    }
    l_run += __shfl_xor(l_run, 32);
    LAS float* MW = (LAS float*)(lds + SA_M); LAS float* LW = (LAS float*)(lds + SA_L); LAS float* OW = (LAS float*)(lds + SA_O);
    __syncthreads();
    if (lane < 16) { MW[wave * 16 + lane] = m_run; LW[wave * 16 + lane] = l_run; }
#pragma unroll
    for (int r = 0; r < 8; ++r) { const int q = crow(r, hi); OW[(wave * 16 + q) * 64 + r32] = o0[r]; OW[(wave * 16 + q) * 64 + 32 + r32] = o1[r]; }
    __syncthreads();
    { const int q = tid >> 5, d = tid & 31;
      float M = MW[q];
#pragma unroll
      for (int w = 1; w < 8; ++w) M = fmaxf(M, MW[w * 16 + q]);
      float L = 0.f, a0 = 0.f, a1 = 0.f;
#pragma unroll
      for (int w = 0; w < 8; ++w) { const float f = __builtin_amdgcn_exp2f(MW[w * 16 + q] - M); L += f * LW[w * 16 + q]; a0 += f * OW[(w * 16 + q) * 64 + d]; a1 += f * OW[(w * 16 + q) * 64 + 32 + d]; }
      const float g0 = bf2f(p.Gt[(size_t)q * p.gpitch + d]), g1 = bf2f(p.Gt[(size_t)q * p.gpitch + 32 + d]);
      p.O[(size_t)q * p.opitch + d] = (bf16)f2bf(a0 / L * siluf(g0)); p.O[(size_t)q * p.opitch + 32 + d] = (bf16)f2bf(a1 / L * siluf(g1)); }
}

constexpr int RW_R = 0, RW_W = 16384, RW_KT = 32768, RW_V = 49152, RW_KK = 65536, RW_KA = 81920, RW_G = 98304, RW_X = 114688;
struct RwkvP { const bf16* Hs; bf16* Os; int T; int h; const float* s0; const float* prev0; float* s_out; float* sh_out; };
__device__ __forceinline__ void rwkv_task(LAS unsigned char* lds, const Args& a, const RwkvP& p, int tid) {
    LAS float* AR = (LAS float*)(lds + RW_R); LAS float* AW = (LAS float*)(lds + RW_W); LAS float* AKT = (LAS float*)(lds + RW_KT); LAS float* AV = (LAS float*)(lds + RW_V);
    LAS float* AKK = (LAS float*)(lds + RW_KK); LAS float* AKA = (LAS float*)(lds + RW_KA); LAS float* AG = (LAS float*)(lds + RW_G); LAS float* AX = (LAS float*)(lds + RW_X);
    const int tt = tid >> 3, e8 = (tid & 7) * 8, h = p.h;
    const float* mu = a.in[I_MU];
    float S[8];
    if (p.s0) {
#pragma unroll
        for (int e = 0; e < 8; ++e) S[e] = p.s0[tt * 64 + e8 + e];
    } else {
#pragma unroll
        for (int e = 0; e < 8; ++e) S[e] = 0.f;
    }
    for (int c0 = 0; c0 < p.T; c0 += 64) {
        const int n = (p.T - c0) < 64 ? (p.T - c0) : 64;
        const bool act = tt < n; const int trow = c0 + tt;
        const bf16* cur = p.Hs + (size_t)trow * NP; const bf16* prv = cur - NP; const bool first = (trow == 0);
        if (act) {
#pragma unroll
            for (int e = 0; e < 8; ++e) { const int col = e8 + e; const float c = bf2f(cur[HC_WD + col]);
                const float pv = first ? (p.prev0 ? p.prev0[1152 + col] : 0.f) : bf2f(prv[HC_WD + col]);
                const float xs = c + (pv - c) * mu[1152 + col];
                AX[tt * 64 + col] = (col < 32) ? ftanh(xs) : xs; }
        }
        __syncthreads();
        if (act) {
            float lw[8], la[8];
            { const f32x4 w0a = *(const f32x4*)(a.in[I_W0] + h * 64 + e8), w0b = *(const f32x4*)(a.in[I_W0] + h * 64 + e8 + 4);
              const f32x4 a0a = *(const f32x4*)(a.in[I_A0] + h * 64 + e8), a0b = *(const f32x4*)(a.in[I_A0] + h * 64 + e8 + 4);
              lw[0] = w0a.x; lw[1] = w0a.y; lw[2] = w0a.z; lw[3] = w0a.w; lw[4] = w0b.x; lw[5] = w0b.y; lw[6] = w0b.z; lw[7] = w0b.w;
              la[0] = a0a.x; la[1] = a0a.y; la[2] = a0a.z; la[3] = a0a.w; la[4] = a0b.x; la[5] = a0b.y; la[6] = a0b.z; la[7] = a0b.w; }
#pragma unroll 2
            for (int j = 0; j < 32; ++j) {
                const float tw = AX[tt * 64 + j], ta = AX[tt * 64 + 32 + j];
                const f32x4 u0 = *(const f32x4*)(a.in[I_WUP] + j * 384 + h * 64 + e8), u1 = *(const f32x4*)(a.in[I_WUP] + j * 384 + h * 64 + e8 + 4);
                const f32x4 p0 = *(const f32x4*)(a.in[I_AUP] + j * 384 + h * 64 + e8), p1 = *(const f32x4*)(a.in[I_AUP] + j * 384 + h * 64 + e8 + 4);
                lw[0] += tw * u0.x; lw[1] += tw * u0.y; lw[2] += tw * u0.z; lw[3] += tw * u0.w; lw[4] += tw * u1.x; lw[5] += tw * u1.y; lw[6] += tw * u1.z; lw[7] += tw * u1.w;
                la[0] += ta * p0.x; la[1] += ta * p0.y; la[2] += ta * p0.z; la[3] += ta * p0.w; la[4] += ta * p1.x; la[5] += ta * p1.y; la[6] += ta * p1.z; la[7] += ta * p1.w;
            }
            float kk[8], aa[8]; float ss = 0.f;
            const int c8 = h * 64 + e8;
            float rs[8], ks[8], vs[8], gs[8];
            { float cu[8], pv[8], mm[8];
#define RW_SHIFT(dst, HC, MUOFF) do { unpack8(*(const v4u*)(cur + (HC) + c8), cu); \
                if (first) { if (p.prev0) ld8(p.prev0 + (MUOFF) + c8, pv); else { _Pragma("unroll") for (int e = 0; e < 8; ++e) pv[e] = 0.f; } } \
                else unpack8(*(const v4u*)(prv + (HC) + c8), pv); \
                ld8(mu + (MUOFF) + c8, mm); \
                _Pragma("unroll") for (int e = 0; e < 8; ++e) dst[e] = cu[e] + (pv[e] - cu[e]) * mm[e]; } while (0)
              RW_SHIFT(rs, HC_RR, 0); RW_SHIFT(ks, HC_RK, 384); RW_SHIFT(vs, HC_RV, 768); RW_SHIFT(gs, HC_RG, 1216);
#undef RW_SHIFT
            }
            float kkw[8], kaw[8];
            ld8(a.in[I_KK] + c8, kkw); ld8(a.in[I_KA] + c8, kaw);
#pragma unroll
            for (int e = 0; e < 8; ++e) { const int d = e8 + e;
                const float wraw = -softplusf(-lw[e]) - 0.5f; const float dec = fexp(-fexp(wraw));
                const float av = sigmf(la[e]);
                kk[e] = ks[e] * kkw[e]; ss += kk[e] * kk[e]; aa[e] = av;
                AR[tt * 64 + d] = rs[e]; AW[tt * 64 + d] = dec; AKT[tt * 64 + d] = ks[e] * (1.f + (av - 1.f) * kaw[e]); AV[tt * 64 + d] = vs[e]; AG[tt * 64 + d] = gs[e];
            }
            ss = sum8(ss); const float rn = frsq(fmaxf(ss, 1e-24f));
#pragma unroll
            for (int e = 0; e < 8; ++e) { const float k2 = kk[e] * rn; AKK[tt * 64 + e8 + e] = k2; AKA[tt * 64 + e8 + e] = k2 * aa[e]; }
        }
        __syncthreads();
        for (int t = 0; t < n; ++t) {
            const f32x4 k0 = *(const LAS f32x4*)(AKK + t * 64 + e8), k1 = *(const LAS f32x4*)(AKK + t * 64 + e8 + 4);
            const f32x4 w0 = *(const LAS f32x4*)(AW + t * 64 + e8), w1 = *(const LAS f32x4*)(AW + t * 64 + e8 + 4);
            const f32x4 b0 = *(const LAS f32x4*)(AKA + t * 64 + e8), b1 = *(const LAS f32x4*)(AKA + t * 64 + e8 + 4);
            const f32x4 x0 = *(const LAS f32x4*)(AKT + t * 64 + e8), x1 = *(const LAS f32x4*)(AKT + t * 64 + e8 + 4);
            const f32x4 r0 = *(const LAS f32x4*)(AR + t * 64 + e8), r1 = *(const LAS f32x4*)(AR + t * 64 + e8 + 4);
            const float vv = AV[t * 64 + tt];
            float sa = S[0] * k0.x + S[1] * k0.y + S[2] * k0.z + S[3] * k0.w + S[4] * k1.x + S[5] * k1.y + S[6] * k1.z + S[7] * k1.w;
            sa = -sum8(sa);
            S[0] = S[0] * w0.x + sa * b0.x + vv * x0.x; S[1] = S[1] * w0.y + sa * b0.y + vv * x0.y; S[2] = S[2] * w0.z + sa * b0.z + vv * x0.z; S[3] = S[3] * w0.w + sa * b0.w + vv * x0.w;
            S[4] = S[4] * w1.x + sa * b1.x + vv * x1.x; S[5] = S[5] * w1.y + sa * b1.y + vv * x1.y; S[6] = S[6] * w1.z + sa * b1.z + vv * x1.z; S[7] = S[7] * w1.w + sa * b1.w + vv * x1.w;
            float y = S[0] * r0.x + S[1] * r0.y + S[2] * r0.z + S[3] * r0.w + S[4] * r1.x + S[5] * r1.y + S[6] * r1.z + S[7] * r1.w;
            y = sum8(y);
            if ((tid & 7) == 0) AX[t * 64 + tt] = y;
        }
        __syncthreads();
        {
            float y[8], sm = 0.f, bn = 0.f;
#pragma unroll
            for (int e = 0; e < 8; ++e) { y[e] = AX[tt * 64 + e8 + e]; sm += y[e]; bn += AR[tt * 64 + e8 + e] * AKT[tt * 64 + e8 + e] * a.in[I_RK][h * 64 + e8 + e]; }
            sm = sum8(sm) * (1.f / 64.f); bn = sum8(bn);
            float var = 0.f;
#pragma unroll
            for (int e = 0; e < 8; ++e) { const float d = y[e] - sm; var += d * d; }
            var = sum8(var) * (1.f / 64.f);
            const float rstd = frsq(var + GN_EPS);
            if (act) {
                v4u o; unsigned w[4];
#pragma unroll
                for (int e = 0; e < 8; e += 2) { const int c = h * 64 + e8 + e;
                    const float o0 = ((y[e] - sm) * rstd * a.in[I_GNW][c] + a.in[I_GNB][c] + bn * AV[tt * 64 + e8 + e]) * siluf(AG[tt * 64 + e8 + e]);
                    const float o1 = ((y[e + 1] - sm) * rstd * a.in[I_GNW][c + 1] + a.in[I_GNB][c + 1] + bn * AV[tt * 64 + e8 + e + 1]) * siluf(AG[tt * 64 + e8 + e + 1]);
                    w[e >> 1] = pk2(o0, o1); }
                o.x = w[0]; o.y = w[1]; o.z = w[2]; o.w = w[3];
                *(v4u*)(p.Os + (size_t)trow * DM + 384 + h * 64 + e8) = o;
            }
        }
        __syncthreads();
    }
#pragma unroll
    for (int e = 0; e < 8; ++e) p.s_out[tt * 64 + e8 + e] = S[e];
    if (p.sh_out) { const bf16* last = p.Hs + (size_t)(p.T - 1) * NP;
        for (int m = tid; m < 1600; m += 512) { const int c = (m < 1152) ? HC_RR + m : (m < 1184) ? HC_WD + (m - 1152) : (m < 1216) ? HC_AD + (m - 1184) : HC_RG + (m - 1216);
            p.sh_out[m] = bf2f(last[c]); } }
}


constexpr int NCH = SEQ / 64;
constexpr int NTASK_RWC = BATCH * 6 * NCH;
constexpr size_t WS_QE = 344 * MiB;
constexpr size_t WS_YL = WS_QE + (size_t)NTASK_RWC * 8192;
constexpr size_t WS_PT = WS_YL + (size_t)NTASK_RWC * 8192;
constexpr size_t WS_SC = WS_PT + (size_t)NTASK_RWC * 8192;
constexpr size_t WS_SL = WS_SC + (size_t)NTASK_RWC * 8192;
constexpr size_t WS_BON = WS_SL + (size_t)NTASK_RWC * 16384;
constexpr size_t WS_END2 = WS_BON + (size_t)NTASK_RWC * 256;
static_assert(WS_END2 <= 512 * MiB, "d_ws map (chunked RWKV)");

constexpr int LC_AX = 0, LC_G = 16384, LC_AT = 32768, LC_M0 = 49152, LC_MS = 9216, LC_GAM = LC_M0 + 10 * LC_MS;
#define LC_M(i) (LC_M0 + (i) * LC_MS)
typedef float f32x4v __attribute__((ext_vector_type(4)));

__device__ __forceinline__ void mm_nt(f32x4 (&acc)[2], const LAS unsigned char* X, const LAS unsigned char* Y, int bi, int bj0, int fr, int fq) {
#pragma unroll
    for (int ks = 0; ks < 2; ++ks) {
        const bf16x8 a = *(const LAS bf16x8*)(X + (16 * bi + fr) * 144 + 64 * ks + 16 * fq);
#pragma unroll
        for (int n = 0; n < 2; ++n) {
            const bf16x8 b = *(const LAS bf16x8*)(Y + (16 * (bj0 + n) + fr) * 144 + 64 * ks + 16 * fq);
            acc[n] = __builtin_amdgcn_mfma_f32_16x16x32_bf16(a, b, acc[n], 0, 0, 0);
        }
    }
}
#define ACC_ZERO(a) do { a[0] = (f32x4){0.f, 0.f, 0.f, 0.f}; a[1] = (f32x4){0.f, 0.f, 0.f, 0.f}; } while (0)
__device__ __forceinline__ void st_bf16_tile(LAS unsigned char* M, const f32x4 (&acc)[2], int bi, int bj0, int fr, int fq) {
#pragma unroll
    for (int n = 0; n < 2; ++n)
#pragma unroll
        for (int rg = 0; rg < 4; ++rg) *(LAS unsigned short*)(M + (16 * bi + 4 * fq + rg) * 144 + (16 * (bj0 + n) + fr) * 2) = (unsigned short)f2bf(acc[n][rg]);
}
__device__ __forceinline__ void copy_tile_bf16(bf16* dst, const LAS unsigned char* M, int tid) {
    const int row = tid >> 3, pc = tid & 7;
    *(v4u*)(dst + row * 64 + pc * 8) = *(const LAS v4u*)(M + row * 144 + pc * 16);
}

struct RwcP { const bf16* Hs; int h; int c0; size_t task; };
constexpr int RWC_Q0 = MT / 64 + BATCH * NMEM / 64;
struct RwcIn { v4u wdc, wdp, rc, rp, kc, kp, vc, vp; f32x4 wu, au; };
__device__ __forceinline__ void rwkv_local_load(RwcIn& in, const Args& a, const RwcP& p, int tid) {
    const int tt = tid >> 3, e8 = (tid & 7) * 8, c8 = p.h * 64 + e8; const int trow = p.c0 + tt;
    const bf16* cur = p.Hs + (size_t)trow * NP; const bf16* prv = (trow == 0) ? cur : cur - NP;
    in.wdc = *(const v4u*)(cur + HC_WD + e8); in.wdp = *(const v4u*)(prv + HC_WD + e8);
    in.rc = *(const v4u*)(cur + HC_RR + c8); in.rp = *(const v4u*)(prv + HC_RR + c8);
    in.kc = *(const v4u*)(cur + HC_RK + c8); in.kp = *(const v4u*)(prv + HC_RK + c8);
    in.vc = *(const v4u*)(cur + HC_RV + c8); in.vp = *(const v4u*)(prv + HC_RV + c8);
    const int j = tid >> 4, c4 = (tid & 15) * 4;
    in.wu = *(const f32x4*)(a.in[I_WUP] + j * 384 + p.h * 64 + c4); in.au = *(const f32x4*)(a.in[I_AUP] + j * 384 + p.h * 64 + c4);
}
__device__ __forceinline__ void rwkv_local_task(LAS unsigned char* lds, const Args& a, const RwcP& p, const RwcIn& in, RwcIn& nxt, volatile LAS unsigned* nextw, int& nx, bool& has_next, int tid, int lane, int wave) {
    asm volatile("" : "+v"(tid), "+v"(lane));
    LAS float* AX = (LAS float*)(lds + LC_AX); LAS float* G = (LAS float*)(lds + LC_G); LAS float* AT = (LAS float*)(lds + LC_AT); LAS float* GAM = (LAS float*)(lds + LC_GAM);
    const int tt = tid >> 3, e8 = (tid & 7) * 8, h = p.h, c8 = h * 64 + e8;
    const float* mu = a.in[I_MU];
    const int trow = p.c0 + tt; const bool first = (trow == 0);
    {
        { const int j = tid >> 4, c4 = (tid & 15) * 4; LAS unsigned short* ww = (LAS unsigned short*)(lds + LC_AT) + c4 * 40 + j; LAS unsigned short* wa = ww + 64 * 40;
          ww[0] = (unsigned short)f2bf(in.wu.x); ww[40] = (unsigned short)f2bf(in.wu.y); ww[80] = (unsigned short)f2bf(in.wu.z); ww[120] = (unsigned short)f2bf(in.wu.w);
          wa[0] = (unsigned short)f2bf(in.au.x); wa[40] = (unsigned short)f2bf(in.au.y); wa[80] = (unsigned short)f2bf(in.au.z); wa[120] = (unsigned short)f2bf(in.au.w); }
        float cu[8], pv[8], mm[8];
        unpack8(in.wdc, cu); unpack8(in.wdp, pv);
        if (first) { _Pragma("unroll") for (int e = 0; e < 8; ++e) pv[e] = 0.f; }
        ld8(mu + 1152 + e8, mm);
        float xs[8];
#pragma unroll
        for (int e = 0; e < 8; ++e) { xs[e] = cu[e] + (pv[e] - cu[e]) * mm[e]; if (e8 < 32) xs[e] = ftanh(xs[e]); }
        v4u w_; w_.x = pk2(xs[0], xs[1]); w_.y = pk2(xs[2], xs[3]); w_.z = pk2(xs[4], xs[5]); w_.w = pk2(xs[6], xs[7]);
        *(LAS v4u*)(lds + LC_AX + (e8 < 32 ? 0 : 5120) + tt * 80 + (e8 & 31) * 2) = w_;
    }
    __syncthreads();
    {
        const int bi_ = wave >> 1, bj_ = 2 * (wave & 1), fr_ = lane & 15, fq_ = lane >> 4;
        const bf16x8 xw = *(const LAS bf16x8*)(lds + LC_AX + (16 * bi_ + fr_) * 80 + 16 * fq_), xa = *(const LAS bf16x8*)(lds + LC_AX + 5120 + (16 * bi_ + fr_) * 80 + 16 * fq_);
        LAS float* LAO = (LAS float*)(lds + LC_M(8));
#pragma unroll
        for (int n = 0; n < 2; ++n) {
            const bf16x8 bw = *(const LAS bf16x8*)(lds + LC_AT + (16 * (bj_ + n) + fr_) * 80 + 16 * fq_), ba = *(const LAS bf16x8*)(lds + LC_AT + 5120 + (16 * (bj_ + n) + fr_) * 80 + 16 * fq_);
            f32x4 cw = {0.f, 0.f, 0.f, 0.f}, ca = {0.f, 0.f, 0.f, 0.f};
            cw = __builtin_amdgcn_mfma_f32_16x16x32_bf16(xw, bw, cw, 0, 0, 0); ca = __builtin_amdgcn_mfma_f32_16x16x32_bf16(xa, ba, ca, 0, 0, 0);
#pragma unroll
            for (int rg = 0; rg < 4; ++rg) { G[(16 * bi_ + 4 * fq_ + rg) * 64 + 16 * (bj_ + n) + fr_] = cw[rg]; LAO[(16 * bi_ + 4 * fq_ + rg) * 64 + 16 * (bj_ + n) + fr_] = ca[rg]; }
        }
    }
    __syncthreads();
    float rs[8], ks[8], vs[8], kk[8], be[8], lwv[8];
    {
        float lw[8], la[8];
        { float t8[8]; ld8(a.in[I_W0] + c8, lw); ld8(a.in[I_A0] + c8, la);
          const f32x4 g0 = *(const LAS f32x4*)(G + tt * 64 + e8), g1 = *(const LAS f32x4*)(G + tt * 64 + e8 + 4);
          const f32x4 h0 = *(const LAS f32x4*)((LAS float*)(lds + LC_M(8)) + tt * 64 + e8), h1 = *(const LAS f32x4*)((LAS float*)(lds + LC_M(8)) + tt * 64 + e8 + 4);
          lw[0] += g0.x; lw[1] += g0.y; lw[2] += g0.z; lw[3] += g0.w; lw[4] += g1.x; lw[5] += g1.y; lw[6] += g1.z; lw[7] += g1.w;
          la[0] += h0.x; la[1] += h0.y; la[2] += h0.z; la[3] += h0.w; la[4] += h1.x; la[5] += h1.y; la[6] += h1.z; la[7] += h1.w; (void)t8; }
        { float cu[8], pv[8], mm[8];
#define RW_SHIFT(dst, CW, PW, MUOFF) do { unpack8(CW, cu); unpack8(PW, pv); \
            if (first) { _Pragma("unroll") for (int e = 0; e < 8; ++e) pv[e] = 0.f; } \
            ld8(mu + (MUOFF) + c8, mm); \
            _Pragma("unroll") for (int e = 0; e < 8; ++e) dst[e] = cu[e] + (pv[e] - cu[e]) * mm[e]; } while (0)
          RW_SHIFT(rs, in.rc, in.rp, 0); RW_SHIFT(ks, in.kc, in.kp, 384); RW_SHIFT(vs, in.vc, in.vp, 768);
#undef RW_SHIFT
        }
        float kkw[8], kaw[8], rkw[8]; ld8(a.in[I_KK] + c8, kkw); ld8(a.in[I_KA] + c8, kaw); ld8(a.in[I_RK] + c8, rkw);
        float ss = 0.f, bn = 0.f;
#pragma unroll
        for (int e = 0; e < 8; ++e) {
            const float wraw = -softplusf(-lw[e]) - 0.5f; lwv[e] = -fexp(wraw);
            const float av = sigmf(la[e]);
            kk[e] = ks[e] * kkw[e]; ss += kk[e] * kk[e]; be[e] = av;
            ks[e] = ks[e] * (1.f + (av - 1.f) * kaw[e]);
            bn += rs[e] * ks[e] * rkw[e];
        }
        ss = sum8(ss); bn = sum8(bn); const float rn = frsq(fmaxf(ss, 1e-24f));
#pragma unroll
        for (int e = 0; e < 8; ++e) { kk[e] *= rn; be[e] *= kk[e]; }
        if ((tid & 7) == 0) ((float*)(a.ws + WS_BON))[p.task * 64 + tt] = bn;
        *(LAS f32x4*)(G + tt * 64 + e8) = (f32x4){lwv[0], lwv[1], lwv[2], lwv[3]}; *(LAS f32x4*)(G + tt * 64 + e8 + 4) = (f32x4){lwv[4], lwv[5], lwv[6], lwv[7]};
    }
    nx = (int)*nextw; has_next = (nx >= RWC_Q0) && (nx < RWC_Q0 + NTASK_RWC);
    if (has_next) { const int t2 = nx - RWC_Q0, bh2 = t2 / NCH; const RwcP pn{(const bf16*)(a.ws + WS_H) + (size_t)(bh2 / 6) * SEQ * NP, bh2 % 6, (t2 % NCH) * 64, (size_t)t2}; rwkv_local_load(nxt, a, pn, tid); }
    __syncthreads();
    { const int d = tid & 63, sg = tid >> 6; float loc[8]; float run = 0.f;
#pragma unroll
      for (int i = 0; i < 8; ++i) { run += G[(8 * sg + i) * 64 + d]; loc[i] = run; }
      AX[sg * 64 + d] = run;
      __syncthreads();
      float pre = 0.f;
#pragma unroll
      for (int j = 0; j < 8; ++j) { const float sv = AX[j * 64 + d]; pre += (j < sg) ? sv : 0.f; }
#pragma unroll
      for (int i = 0; i < 8; ++i) G[(8 * sg + i) * 64 + d] = pre + loc[i];
    }
    __syncthreads();
    {
        float g[8], gm[8], g63[8];
        { const f32x4 x0 = *(const LAS f32x4*)(G + tt * 64 + e8), x1 = *(const LAS f32x4*)(G + tt * 64 + e8 + 4);
          g[0] = x0.x; g[1] = x0.y; g[2] = x0.z; g[3] = x0.w; g[4] = x1.x; g[5] = x1.y; g[6] = x1.z; g[7] = x1.w; }
        { const f32x4 x0 = *(const LAS f32x4*)(G + 63 * 64 + e8), x1 = *(const LAS f32x4*)(G + 63 * 64 + e8 + 4);
          g63[0] = x0.x; g63[1] = x0.y; g63[2] = x0.z; g63[3] = x0.w; g63[4] = x1.x; g63[5] = x1.y; g63[6] = x1.z; g63[7] = x1.w; }
#pragma unroll
        for (int e = 0; e < 8; ++e) gm[e] = g[e] - lwv[e];
        float at[8], qt[8], bh[8], kh[8], bb[8], kb[8];
#pragma unroll
        for (int e = 0; e < 8; ++e) { const float e1 = fexp(gm[e]), e2 = fexp(g[e]), e3 = fexp(-g[e]), e4 = fexp(g63[e] - g[e]);
            at[e] = -kk[e] * e1; qt[e] = rs[e] * e2; bh[e] = be[e] * e3; kh[e] = ks[e] * e3; bb[e] = be[e] * e4; kb[e] = ks[e] * e4; }
        *(LAS f32x4*)(AT + tt * 64 + e8) = (f32x4){at[0], at[1], at[2], at[3]}; *(LAS f32x4*)(AT + tt * 64 + e8 + 4) = (f32x4){at[4], at[5], at[6], at[7]};
#define ST8(i, arr) do { v4u w_; w_.x = pk2(arr[0], arr[1]); w_.y = pk2(arr[2], arr[3]); w_.z = pk2(arr[4], arr[5]); w_.w = pk2(arr[6], arr[7]); *(LAS v4u*)(lds + LC_M(i) + tt * 144 + e8 * 2) = w_; } while (0)
        ST8(0, at); ST8(1, qt); ST8(2, bh); ST8(3, kh);
#undef ST8
#pragma unroll
        for (int e = 0; e < 8; ++e) {
            *(LAS unsigned short*)(lds + LC_M(4) + (e8 + e) * 144 + tt * 2) = (unsigned short)f2bf(bb[e]);
            *(LAS unsigned short*)(lds + LC_M(5) + (e8 + e) * 144 + tt * 2) = (unsigned short)f2bf(kb[e]);
            *(LAS unsigned short*)(lds + LC_M(6) + (e8 + e) * 144 + tt * 2) = (unsigned short)f2bf(vs[e]);
        }
        if (tt == 63) {
#pragma unroll
            for (int e = 0; e < 8; ++e) GAM[e8 + e] = fexp(g63[e]);
        }
    }
    __syncthreads();
    const int bi = wave >> 1, bj0 = 2 * (wave & 1), fr = lane & 15, fq = lane >> 4;
    {
        f32x4 cab[2], cak[2], cqb[2], cqk[2]; ACC_ZERO(cab); ACC_ZERO(cak); ACC_ZERO(cqb); ACC_ZERO(cqk);
        mm_nt(cab, lds + LC_M(0), lds + LC_M(2), bi, bj0, fr, fq); mm_nt(cak, lds + LC_M(0), lds + LC_M(3), bi, bj0, fr, fq);
        mm_nt(cqb, lds + LC_M(1), lds + LC_M(2), bi, bj0, fr, fq); mm_nt(cqk, lds + LC_M(1), lds + LC_M(3), bi, bj0, fr, fq);
#pragma unroll
        for (int n = 0; n < 2; ++n)
#pragma unroll
            for (int rg = 0; rg < 4; ++rg) { const int t = 16 * bi + 4 * fq + rg, s = 16 * (bj0 + n) + fr;
                cab[n][rg] = (s < t) ? cab[n][rg] : 0.f;
                AX[s * 64 + t] = cab[n][rg];
                *(LAS unsigned short*)(lds + LC_M(7) + t * 144 + s * 2) = (unsigned short)f2bf((s < t) ? cak[n][rg] : 0.f);
                *(LAS unsigned short*)(lds + LC_M(8) + t * 144 + s * 2) = (unsigned short)f2bf((s <= t) ? cqb[n][rg] : 0.f);
                *(LAS unsigned short*)(lds + LC_M(9) + t * 144 + s * 2) = (unsigned short)f2bf((s <= t) ? cqk[n][rg] : 0.f); }
        __syncthreads();
        st_bf16_tile(lds + LC_M(0), cab, bi, bj0, fr, fq);
        { const v4u z = {0u, 0u, 0u, 0u};
          *(LAS v4u*)(lds + LC_M(2) + tid * 16) = z; *(LAS v4u*)(lds + LC_M(3) + tid * 16) = z;
          if (tid < 64) { *(LAS v4u*)(lds + LC_M(2) + 8192 + tid * 16) = z; *(LAS v4u*)(lds + LC_M(3) + 8192 + tid * 16) = z; } }
    }
    {
        f32x4 c[2]; ACC_ZERO(c); mm_nt(c, lds + LC_M(7), lds + LC_M(6), bi, bj0, fr, fq);
#pragma unroll
        for (int n = 0; n < 2; ++n)
#pragma unroll
            for (int rg = 0; rg < 4; ++rg) G[(16 * bi + 4 * fq + rg) * 64 + 16 * (bj0 + n) + fr] = c[n][rg];
    }
    __syncthreads();
    {
        LAS float* R = (tid < 64) ? AT : G; const int col = tid & 63;
        LAS unsigned char* XT = lds + ((tid < 64) ? LC_M(2) : LC_M(3)) + col * 144;
#pragma unroll
        for (int b4 = 0; b4 < 4; ++b4) {
            if (b4 > 0) {
                f32x4 acc = {0.f, 0.f, 0.f, 0.f};
                const LAS unsigned char* Yb = lds + ((wave < 4) ? LC_M(2) : LC_M(3)) + (16 * (wave & 3) + fr) * 144;
#pragma unroll
                for (int ks = 0; ks < (b4 + 1) / 2; ++ks) {
                    const bf16x8 av = *(const LAS bf16x8*)(lds + LC_M(0) + (16 * b4 + fr) * 144 + 64 * ks + 16 * fq);
                    const bf16x8 bv = *(const LAS bf16x8*)(Yb + 64 * ks + 16 * fq);
                    acc = __builtin_amdgcn_mfma_f32_16x16x32_bf16(av, bv, acc, 0, 0, 0);
                }
                LAS float* Rw = ((wave < 4) ? AT : G) + 16 * (wave & 3) + fr;
#pragma unroll
                for (int rg = 0; rg < 4; ++rg) Rw[(16 * b4 + 4 * fq + rg) * 64] += acc[rg];
                __syncthreads();
            }
            if (tid < 128) {
                float r[16];
#pragma unroll
                for (int i = 0; i < 16; ++i) r[i] = R[(16 * b4 + i) * 64 + col];
#pragma unroll
                for (int j = 0; j < 15; ++j) {
#pragma unroll
                    for (int i4 = (j + 1) / 4; i4 < 4; ++i4) { const f32x4 a4 = *(const LAS f32x4*)(AX + (16 * b4 + j) * 64 + 16 * b4 + 4 * i4);
                        if (4 * i4 > j) r[4 * i4] += a4.x * r[j]; if (4 * i4 + 1 > j) r[4 * i4 + 1] += a4.y * r[j]; if (4 * i4 + 2 > j) r[4 * i4 + 2] += a4.z * r[j]; if (4 * i4 + 3 > j) r[4 * i4 + 3] += a4.w * r[j]; }
                }
                v4u w0, w1; w0.x = pk2(r[0], r[1]); w0.y = pk2(r[2], r[3]); w0.z = pk2(r[4], r[5]); w0.w = pk2(r[6], r[7]);
                w1.x = pk2(r[8], r[9]); w1.y = pk2(r[10], r[11]); w1.z = pk2(r[12], r[13]); w1.w = pk2(r[14], r[15]);
                *(LAS v4u*)(XT + 32 * b4) = w0; *(LAS v4u*)(XT + 32 * b4 + 16) = w1;
            }
            __syncthreads();
        }
    }
    {
        const LAS unsigned char* WT = lds + LC_M(2); const LAS unsigned char* WUT = lds + LC_M(3);
        f32x4 c[2];
#pragma unroll
        for (int n = 0; n < 2; ++n)
#pragma unroll
            for (int rg = 0; rg < 4; ++rg) c[n][rg] = bf2f(*(const LAS unsigned short*)(lds + LC_M(1) + (16 * bi + 4 * fq + rg) * 144 + (16 * (bj0 + n) + fr) * 2));
        mm_nt(c, lds + LC_M(8), WT, bi, bj0, fr, fq);
        st_bf16_tile(lds + LC_G, c, bi, bj0, fr, fq);
        ACC_ZERO(c); mm_nt(c, lds + LC_M(8), WUT, bi, bj0, fr, fq); mm_nt(c, lds + LC_M(9), lds + LC_M(6), bi, bj0, fr, fq);
        st_bf16_tile(lds + LC_AT, c, bi, bj0, fr, fq);
        ACC_ZERO(c); mm_nt(c, lds + LC_M(4), WT, bi, bj0, fr, fq);
#pragma unroll
        for (int n = 0; n < 2; ++n)
#pragma unroll
            for (int rg = 0; rg < 4; ++rg) { const int kp = 16 * bi + 4 * fq + rg, k = 16 * (bj0 + n) + fr; if (kp == k) c[n][rg] += GAM[k]; }
        st_bf16_tile(lds + LC_M(0), c, bi, bj0, fr, fq);
        ACC_ZERO(c); mm_nt(c, WUT, lds + LC_M(4), bi, bj0, fr, fq); mm_nt(c, lds + LC_M(6), lds + LC_M(5), bi, bj0, fr, fq);
#pragma unroll
        for (int n = 0; n < 2; ++n)
#pragma unroll
            for (int rg = 0; rg < 4; ++rg) AX[(16 * bi + 4 * fq + rg) * 64 + 16 * (bj0 + n) + fr] = c[n][rg];
    }
    __syncthreads();
    copy_tile_bf16((bf16*)(a.ws + WS_QE) + p.task * 4096, lds + LC_G, tid);
    copy_tile_bf16((bf16*)(a.ws + WS_YL) + p.task * 4096, lds + LC_AT, tid);
    copy_tile_bf16((bf16*)(a.ws + WS_PT) + p.task * 4096, lds + LC_M(0), tid);
    { float* sl = (float*)(a.ws + WS_SL) + p.task * 4096; *(f32x4*)(sl + tid * 4) = *(const LAS f32x4*)(AX + tid * 4); *(f32x4*)(sl + 2048 + tid * 4) = *(const LAS f32x4*)(AX + 2048 + tid * 4); }
    __syncthreads();
}

constexpr int CH_S = 0, CH_P = 9216;
__device__ __forceinline__ void rwkv_chain_task(LAS unsigned char* lds, const Args& a, int bh, int tid, int lane, int wave) {
    const int bi = wave >> 1, bj0 = 2 * (wave & 1), fr = lane & 15, fq = lane >> 4;
    const bf16* PT = (const bf16*)(a.ws + WS_PT) + (size_t)bh * NCH * 4096; const float* SL = (const float*)(a.ws + WS_SL) + (size_t)bh * NCH * 4096;
    bf16* SC = (bf16*)(a.ws + WS_SC) + (size_t)bh * NCH * 4096;
    f32x4 s[2]; ACC_ZERO(s);
    const int row = tid >> 3, pc = tid & 7;
    v4u preg = *(const v4u*)(PT + row * 64 + pc * 8);
    for (int c = 0; c < NCH; ++c) {
        __syncthreads();
        st_bf16_tile(lds + CH_S, s, bi, bj0, fr, fq);
        *(LAS v4u*)(lds + CH_P + row * 144 + pc * 16) = preg;
        __syncthreads();
        copy_tile_bf16(SC + (size_t)c * 4096, lds + CH_S, tid);
        if (c + 1 < NCH) preg = *(const v4u*)(PT + (size_t)(c + 1) * 4096 + row * 64 + pc * 8);
        f32x4 n_[2];
#pragma unroll
        for (int n = 0; n < 2; ++n)
#pragma unroll
            for (int rg = 0; rg < 4; ++rg) n_[n][rg] = SL[(size_t)c * 4096 + (16 * bi + 4 * fq + rg) * 64 + 16 * (bj0 + n) + fr];
        mm_nt(n_, lds + CH_S, lds + CH_P, bi, bj0, fr, fq);
        s[0] = n_[0]; s[1] = n_[1];
    }
    float* so = a.out + O_RSP + (size_t)bh * 4096;
#pragma unroll
    for (int n = 0; n < 2; ++n)
#pragma unroll
        for (int rg = 0; rg < 4; ++rg) so[(16 * bi + 4 * fq + rg) * 64 + 16 * (bj0 + n) + fr] = s[n][rg];
}

constexpr int YT_Q = 0, YT_S = 9216, YT_Y = 18432;
struct RwoIn { v4u qe, sc, vc, vp, gc, gp; unsigned short yl[8]; float bn; };
__device__ __forceinline__ void rwkv_out_load(RwoIn& in, const Args& a, const RwcP& p, int tid, int lane, int wave) {
    const int bi = wave >> 1, bj0 = 2 * (wave & 1), fr = lane & 15, fq = lane >> 4, row = tid >> 3, pc = tid & 7;
    in.qe = *(const v4u*)((const bf16*)(a.ws + WS_QE) + p.task * 4096 + row * 64 + pc * 8);
    in.sc = *(const v4u*)((const bf16*)(a.ws + WS_SC) + p.task * 4096 + row * 64 + pc * 8);
    const bf16* yl = (const bf16*)(a.ws + WS_YL) + p.task * 4096;
#pragma unroll
    for (int n = 0; n < 2; ++n)
#pragma unroll
        for (int rg = 0; rg < 4; ++rg) in.yl[4 * n + rg] = yl[(16 * bi + 4 * fq + rg) * 64 + 16 * (bj0 + n) + fr];
    const int tt = tid >> 3, e8 = (tid & 7) * 8, c8 = p.h * 64 + e8, trow = p.c0 + tt;
    const bf16* cur = p.Hs + (size_t)trow * NP; const bf16* prv = (trow == 0) ? cur : cur - NP;
    in.vc = *(const v4u*)(cur + HC_RV + c8); in.vp = *(const v4u*)(prv + HC_RV + c8); in.gc = *(const v4u*)(cur + HC_RG + c8); in.gp = *(const v4u*)(prv + HC_RG + c8);
    in.bn = ((const float*)(a.ws + WS_BON))[p.task * 64 + tt];
}
__device__ __forceinline__ void rwkv_out_task(LAS unsigned char* lds, const Args& a, const RwcP& p, const RwoIn& in, RwoIn& nxt, volatile LAS unsigned* nextw, int& nx, bool& has_next, bf16* Ob, int tid, int lane, int wave) {
    const int bi = wave >> 1, bj0 = 2 * (wave & 1), fr = lane & 15, fq = lane >> 4, row = tid >> 3, pc = tid & 7, h = p.h;
    LAS float* Y = (LAS float*)(lds + YT_Y);
    __syncthreads();
    *(LAS v4u*)(lds + YT_Q + row * 144 + pc * 16) = in.qe;
    *(LAS v4u*)(lds + YT_S + row * 144 + pc * 16) = in.sc;
    f32x4 c[2];
#pragma unroll
    for (int n = 0; n < 2; ++n)
#pragma unroll
        for (int rg = 0; rg < 4; ++rg) c[n][rg] = bf2f(in.yl[4 * n + rg]);
    __syncthreads();
    nx = (int)*nextw; has_next = nx < NTASK_RWC;
    if (has_next) { const int bh2 = nx / NCH; const RwcP pn{(const bf16*)(a.ws + WS_H) + (size_t)(bh2 / 6) * SEQ * NP, bh2 % 6, (nx % NCH) * 64, (size_t)nx}; rwkv_out_load(nxt, a, pn, tid, lane, wave); }
    mm_nt(c, lds + YT_Q, lds + YT_S, bi, bj0, fr, fq);
#pragma unroll
    for (int n = 0; n < 2; ++n)
#pragma unroll
        for (int rg = 0; rg < 4; ++rg) Y[(16 * bi + 4 * fq + rg) * 64 + 16 * (bj0 + n) + fr] = c[n][rg];
    __syncthreads();
    {
        const int tt = tid >> 3, e8 = (tid & 7) * 8, c8 = h * 64 + e8; const int trow = p.c0 + tt; const bool first = (trow == 0);
        const float* mu = a.in[I_MU];
        float y[8], sm = 0.f;
#pragma unroll
        for (int e = 0; e < 8; ++e) { y[e] = Y[tt * 64 + e8 + e]; sm += y[e]; }
        sm = sum8(sm) * (1.f / 64.f);
        float var = 0.f;
#pragma unroll
        for (int e = 0; e < 8; ++e) { const float d = y[e] - sm; var += d * d; }
        var = sum8(var) * (1.f / 64.f);
        const float rstd = frsq(var + GN_EPS);
        const float bn = in.bn;
        float vs[8], gs[8], cu[8], pv[8], mm[8], gw[8], gb[8];
        unpack8(in.vc, cu); unpack8(in.vp, pv); if (first) { _Pragma("unroll") for (int e = 0; e < 8; ++e) pv[e] = 0.f; }
        ld8(mu + 768 + c8, mm);
#pragma unroll
        for (int e = 0; e < 8; ++e) vs[e] = cu[e] + (pv[e] - cu[e]) * mm[e];
        unpack8(in.gc, cu); unpack8(in.gp, pv); if (first) { _Pragma("unroll") for (int e = 0; e < 8; ++e) pv[e] = 0.f; }
        ld8(mu + 1216 + c8, mm);
#pragma unroll
        for (int e = 0; e < 8; ++e) gs[e] = cu[e] + (pv[e] - cu[e]) * mm[e];
        ld8(a.in[I_GNW] + c8, gw); ld8(a.in[I_GNB] + c8, gb);
        float o[8];
#pragma unroll
        for (int e = 0; e < 8; ++e) o[e] = ((y[e] - sm) * rstd * gw[e] + gb[e] + bn * vs[e]) * siluf(gs[e]);
        v4u w_; w_.x = pk2(o[0], o[1]); w_.y = pk2(o[2], o[3]); w_.z = pk2(o[4], o[5]); w_.w = pk2(o[6], o[7]);
        *(v4u*)(Ob + ((size_t)(p.task / (6 * NCH)) * SEQ + trow) * DM + 384 + c8) = w_;
    }
}
constexpr int NQ_RW = 48 + 192, NQ_SM = 192 + 128;
__device__ __forceinline__ int q_next(const Ctx& F, int qi) {
    __syncthreads();
    if (F.tid == 0) F.MISC[0] = __hip_atomic_fetch_add(F.ctl + CW_Q + 64 * qi, 1u, __ATOMIC_RELAXED, __HIP_MEMORY_SCOPE_AGENT);
    __syncthreads();
    return (int)F.MISC[0];
}
template <bool FOX>
__device__ __forceinline__ void attn_queue(const Ctx& F, const Args& a, int qi, float Bb, float Bm) {
    bf16* H = (bf16*)(a.ws + WS_H); bf16* Ob = (bf16*)(a.ws + WS_XN); bf16* MKV = (bf16*)(a.ws + WS_MKV);
    const float* NCKP = (const float*)(a.ws + WS_NCKP); const float* NCKS = (const float*)(a.ws + WS_NCKS);
    LAS unsigned char* lds = F.lds + RING_OFF;
    constexpr int BASE = FOX ? 0 : 768, CNT = FOX ? 768 : 512;
    int tk = q_next(F, qi);
    if (tk >= CNT) return;
    tk += BASE;
    AttnPf pf, pfn; attn_prefetch(pf, a, tk, F.lane);
    for (;;) {
        if (F.tid == 0) { const unsigned r = __hip_atomic_fetch_add(F.ctl + CW_Q + 64 * qi, 1u, __ATOMIC_RELAXED, __HIP_MEMORY_SCOPE_AGENT); F.MISC[2] = (r < (unsigned)CNT) ? BASE + r : (unsigned)NQ_AT; }
        AttnP p;
        if constexpr (FOX) { const int u = tk, qb = 15 - (u & 15), bh = u >> 4, b = bh / 6, h = bh % 6; const size_t r0 = (size_t)b * SEQ + qb * 256;
            p = AttnP{H + r0 * NP + HC_FQ + h * 64, NP, H + (size_t)b * SEQ * NP + HC_FK + h * 64, NP, H + (size_t)b * SEQ * NP + HC_FV + h * 64, NP, NCKP + (size_t)bh * SEQ, NCKS + (size_t)bh * 64, a.in[I_FQG], a.in[I_FKG],
                      H + r0 * NP + HC_FG + h * 64, NP, Ob + r0 * DM + h * 64, DM, 4 * (qb + 1), qb * 256, 1};
        } else { const int u = tk - 768, b = u / 64, h = (u / 16) % 4, qb = u % 16; const size_t r0 = (size_t)b * SEQ + qb * 256;
            p = AttnP{H + r0 * NP + HC_MQ + h * 64, NP, MKV + (size_t)b * NMEM * 512 + h * 64, 512, MKV + (size_t)b * NMEM * 512 + 256 + h * 64, 512, nullptr, nullptr, nullptr, nullptr,
                      H + r0 * NP + HC_MG + h * 64, NP, Ob + r0 * DM + 768 + h * 64, DM, 4, 0, 0}; }
        int nx;
        attn_unit<FOX>(lds, p, a, pf, pfn, F.MISC + 2, nx, Bb, Bm, F.tid, F.lane, F.wave);
        if (nx >= NQ_AT) break;
        tk = nx; pf = pfn;
    }
}
__device__ __forceinline__ void p4_mixer(const Ctx& F, const Args& a, int qoff = 0) {
    bf16* H = (bf16*)(a.ws + WS_H); bf16* Ob = (bf16*)(a.ws + WS_XN); bf16* MKV = (bf16*)(a.ws + WS_MKV);
    const float* NCKP = (const float*)(a.ws + WS_NCKP); const float* NCKS = (const float*)(a.ws + WS_NCKS);
    LAS unsigned char* lds = F.lds + RING_OFF;
    for (;;) {
        const int tk = q_next(F, 0 + qoff); if (tk >= NQ_RW) break;
        RwkvP p;
        if (tk < 48) { rwkv_chain_task(lds, a, tk, F.tid, F.lane, F.wave);
            if (tk % 6 == 0) { const bf16* last = H + ((size_t)(tk / 6) * SEQ + SEQ - 1) * NP; float* sh = a.out + O_RHP + (size_t)(tk / 6) * 1600;
                for (int m = F.tid; m < 1600; m += 512) { const int c = (m < 1152) ? HC_RR + m : (m < 1184) ? HC_WD + (m - 1152) : (m < 1216) ? HC_AD + (m - 1184) : HC_RG + (m - 1216); sh[m] = bf2f(last[c]); } }
            continue; }
        { const int u = tk - 48, b = u / 6, h = u % 6;
            p = RwkvP{H + (size_t)(MP + b * DECS) * NP, Ob + (size_t)(MP + b * DECS) * DM, DECS, h, a.in[I_SRW] + (size_t)u * 4096, a.in[I_SSH] + (size_t)b * 1600,
                      a.out + O_RSS + (size_t)u * 4096, (h == 0) ? a.out + O_RHS + (size_t)b * 1600 : nullptr}; }
        rwkv_task(lds, a, p, F.tid);
    }
    float Bm;
    {
        float Bb = 0.f;
#if FOX_SKIP
        { const float gqm = wave_max(fabsf(a.in[I_FQG][F.lane])), gkm = wave_max(fabsf(a.in[I_FKG][F.lane])); Bb = 8.0f * gqm * gkm * LOG2E * 1.02f; }
#endif
        { const float gqm = wave_max(fabsf(a.in[I_MQG][F.lane])), gkm = wave_max(fabsf(a.in[I_MKG][F.lane])); Bm = __int_as_float(__builtin_amdgcn_readfirstlane(__float_as_int(8.0f * gqm * gkm * LOG2E * 1.02f))); }
#if !FOX_SKIP
        { const float gqm = wave_max(fabsf(a.in[I_FQG][F.lane])), gkm = wave_max(fabsf(a.in[I_FKG][F.lane])); Bb = 8.0f * gqm * gkm * LOG2E * 1.02f; }
#endif
        attn_queue<true>(F, a, 1 + qoff, Bb, Bm);
    }
    for (;;) {
        const int tk = q_next(F, 2 + qoff); if (tk >= NQ_SM) break;
        SmallP p;
        if (tk < 192) { const int u = tk, b = u / 6, h = u % 6; const size_t r0 = (size_t)MP + b * DECS;
            p = SmallP{H + r0 * NP + HC_FQ + h * 64, NP, a.in[I_CFK] + ((size_t)b * PAST * 6 + h) * 64, 384, a.in[I_CFV] + ((size_t)b * PAST * 6 + h) * 64, 384, PAST, a.in[I_CFL] + (size_t)b * PAST * 6 + h, a.out + O_FLS + (size_t)b * DECS * 6 + h,
                       H + r0 * NP + HC_FK + h * 64, H + r0 * NP + HC_FV + h * 64, NP, H + r0 * NP + HC_FG + h * 64, NP, Ob + r0 * DM + h * 64, DM};
        } else { const int u = tk - 192, b = u / 4, h = u % 4; const size_t r0 = (size_t)MP + b * DECS;
            p = SmallP{H + r0 * NP + HC_MQ + h * 64, NP, a.in[I_CMK] + ((size_t)b * NMEM * 4 + h) * 64, 256, a.in[I_CMV] + ((size_t)b * NMEM * 4 + h) * 64, 256, NMEM, nullptr, nullptr,
                       nullptr, nullptr, NP, H + r0 * NP + HC_MG + h * 64, NP, Ob + r0 * DM + 768 + h * 64, DM}; }
        sample_attn(lds, p, F.tid, F.lane, F.wave);
    }
    {
        attn_queue<false>(F, a, 21 + qoff, 0.f, Bm);
    }
}

__device__ __forceinline__ void p3b_rwkv_local(const Ctx& F, const Args& a, int qoff = 0) {
    const bf16* H = (const bf16*)(a.ws + WS_H); LAS unsigned char* lds = F.lds + RING_OFF;
    {
        int blk = q_next(F, 3 + qoff), par = 0;
        while (blk < NBLK_PREP) {
            if (F.tid == 0) F.MISC[2 + par] = __hip_atomic_fetch_add(F.ctl + CW_Q + 64 * (3 + qoff), 1u, __ATOMIC_RELAXED, __HIP_MEMORY_SCOPE_AGENT);
            prep_block_task(lds, a, blk, F.tid, F.lane, F.wave);
            blk = (int)F.MISC[2 + par]; par ^= 1;
        }
        __syncthreads();
    }
    int cur = RWC_Q0 + q_next(F, 4 + 5 + qoff);
    if (cur >= RWC_Q0 + NTASK_RWC) return;
    RwcIn in, nxt;
    { const int tk = cur - RWC_Q0, bh = tk / NCH; const RwcP p{H + (size_t)(bh / 6) * SEQ * NP, bh % 6, (tk % NCH) * 64, (size_t)tk}; rwkv_local_load(in, a, p, F.tid); }
    for (;;) {
        if (F.tid == 0) F.MISC[2] = RWC_Q0 + __hip_atomic_fetch_add(F.ctl + CW_Q + 64 * (4 + 5 + qoff), 1u, __ATOMIC_RELAXED, __HIP_MEMORY_SCOPE_AGENT);
        int nx; bool has_next = false;
        const int tk = cur - RWC_Q0, bh = tk / NCH; const RwcP p{H + (size_t)(bh / 6) * SEQ * NP, bh % 6, (tk % NCH) * 64, (size_t)tk};
        rwkv_local_task(lds, a, p, in, nxt, F.MISC + 2, nx, has_next, F.tid, F.lane, F.wave);
        if (!has_next) break;
        cur = nx; in = nxt;
    }
}
__device__ __forceinline__ void p5_rwkv_out(const Ctx& F, const Args& a, int qoff = 0) {
    const bf16* H = (const bf16*)(a.ws + WS_H); bf16* Ob = (bf16*)(a.ws + WS_XN); LAS unsigned char* lds = F.lds + RING_OFF;
    int cur = q_next(F, 4 + qoff);
    if (cur >= NTASK_RWC) return;
    RwoIn in, nxt;
    { const int bh = cur / NCH; const RwcP p{H + (size_t)(bh / 6) * SEQ * NP, bh % 6, (cur % NCH) * 64, (size_t)cur}; rwkv_out_load(in, a, p, F.tid, F.lane, F.wave); }
    for (;;) {
        if (F.tid == 0) F.MISC[2] = __hip_atomic_fetch_add(F.ctl + CW_Q + 64 * (4 + qoff), 1u, __ATOMIC_RELAXED, __HIP_MEMORY_SCOPE_AGENT);
        int nx; bool has_next = false;
        const int bh = cur / NCH; const RwcP p{H + (size_t)(bh / 6) * SEQ * NP, bh % 6, (cur % NCH) * 64, (size_t)cur};
        rwkv_out_task(lds, a, p, in, nxt, F.MISC + 2, nx, has_next, Ob, F.tid, F.lane, F.wave);
        if (!has_next) break;
        cur = nx; in = nxt;
    }
}


struct EpiRes {
    static constexpr bool PERM = true, AFTER_DRAIN = false;
    const float* xp; const float* xs; float* yp; float* ys;
    __device__ __forceinline__ void operator()(const pg8::f32x4 (&acc)[2][2][4][2], const pg8::Unit& u, int wr, int wc, int fr, int fq) const {
        const int row0 = u.pm * 256 + wr * 64 + fr, col0 = u.pn * 256 + wc * 32 + 8 * fq;
        const bool samp = u.pm >= (MP / 256);
        const float* xb = samp ? xs - (size_t)MP * DM : xp; float* yb = samp ? ys - (size_t)MP * DM : yp;
#pragma unroll
        for (int ai = 0; ai < 2; ++ai)
#pragma unroll
            for (int m = 0; m < 4; ++m) { const size_t ro = (size_t)(row0 + ai * 128 + m * 16) * DM + col0;
#pragma unroll
                for (int bj = 0; bj < 2; ++bj) {
                    const pg8::f32x4 x0 = *(const pg8::f32x4*)(xb + ro + bj * 128), x1 = *(const pg8::f32x4*)(xb + ro + bj * 128 + 4);
                    *(pg8::f32x4*)(yb + ro + bj * 128) = acc[ai][bj][m][0] + x0; *(pg8::f32x4*)(yb + ro + bj * 128 + 4) = acc[ai][bj][m][1] + x1; } }
    }
};

struct OneUnit { int pm, pn;
    __device__ __forceinline__ bool next(int i, pg8::Unit& u) const { if (i > 0) return false; u.pm = pm; u.pn = pn; return true; }
    __device__ __forceinline__ void a_ready(const pg8::Unit&) const {}
    __device__ __forceinline__ void done(const pg8::Unit&) const {} };
__global__ void __launch_bounds__(NWAVES * 64, 2) fwd_kernel(Args args) {
    extern __shared__ __attribute__((aligned(16))) unsigned char lds[];
    Ctx F;
    F.lds = (LAS unsigned char*)lds;
    F.MISC = (volatile LAS unsigned*)(F.lds + MISC_OFF);
    F.tid = threadIdx.x; F.lane = F.tid & 63; F.wave = __builtin_amdgcn_readfirstlane(F.tid >> 6);
    F.G = gridDim.x; { const int bx = blockIdx.x; F.vcu = (F.G % 8 == 0) ? (bx % 8) * (F.G / 8) + bx / 8 : bx; }
    F.ctl = (gu32*)(args.ws + WS_CTL);
    for (int u = F.tid; u < (LDS_BYTES - LDSCTL_OFF) / 4; u += NWAVES * 64) ((LAS unsigned*)(F.lds + LDSCTL_OFF))[u] = 0u;
    __syncthreads();
    XcdBarrier bar; bar.bar = (unsigned*)(F.ctl + CW_BAR); bar.x = 0; bar.st = nullptr;
#if MK_ONE_LAUNCH
    bar = xcd_barrier_post((unsigned*)(F.ctl + CW_BAR), F.MISC + 8);
#define GRID_BAR() xcd_barrier(bar)
#else
#define GRID_BAR() do {} while (0)
#endif
    const int lo = args.ph_lo, hi = args.ph_hi;
#define IN(k) (lo <= (k) && (k) < hi)
#define BOTH(k) (IN(k) && IN((k) + 1))
    bf16* H = (bf16*)(args.ws + WS_H);
    if (IN(0)) { p0_prologue(F, args); if (BOTH(0)) GRID_BAR(); }
    if (IN(1)) {
        { pg8::Gemm g{(const bf16*)(args.ws + WS_XN), (const bf16*)(args.ws + WS_WIN), MT, NP, DM}; pg8::StaticOrder S; S.init(MT, NP, F.G, (int)blockIdx.x);
          pg8::EpiBf16<0> E{H, NP, nullptr, 0, 0, 1.f};
          pg8::gemm_phase<pg8::EpiBf16<0>, pg8::StaticOrder, PG8_ALIGN, PG8_SP2>(F.lds + RING_OFF, g, S, E); }
        { pg8::Gemm g{(const bf16*)(args.ws + WS_MEMN), (const bf16*)(args.ws + WS_WMEM), BATCH * NMEM, 512, DM}; pg8::StaticOrder S; S.init(BATCH * NMEM, 512, F.G, (int)((blockIdx.x + 16u) % (unsigned)F.G))    ;
          pg8::EpiBf16<0> E{(bf16*)(args.ws + WS_MKV), 512, nullptr, 0, 0, 1.f};
          pg8::gemm_phase<pg8::EpiBf16<0>, pg8::StaticOrder, PG8_ALIGN, PG8_SP2>(F.lds + RING_OFF, g, S, E); }
        if (IN(1) && IN(3)) GRID_BAR();
    }
    if (IN(3)) { p3b_rwkv_local(F, args); if (BOTH(3)) GRID_BAR(); }
    if (IN(4)) { p4_mixer(F, args); if (BOTH(4)) GRID_BAR(); }
    if (IN(5)) {
        if (F.vcu < 8) {
            pg8::Gemm g{(const bf16*)(args.ws + WS_XN), (const bf16*)(args.ws + WS_WOUT), MT, DM, DM}; OneUnit S{MP / 256 + (F.vcu >> 2), F.vcu & 3};
            EpiRes E{args.in[I_XP], args.in[I_XS], args.out + O_YP, args.out + O_YS};
            pg8::gemm_phase<EpiRes, OneUnit, PG8_ALIGN, PG8_SP2>(F.lds + RING_OFF, g, S, E);
        }
        p5_rwkv_out(F, args); if (BOTH(5)) GRID_BAR(); }
    if (IN(6)) {
        pg8::Gemm g{(const bf16*)(args.ws + WS_XN), (const bf16*)(args.ws + WS_WOUT), MP, DM, DM}; pg8::StaticOrder S; S.init(MP, DM, F.G, (int)blockIdx.x);
        EpiRes E{args.in[I_XP], args.in[I_XS], args.out + O_YP, args.out + O_YS};
        pg8::gemm_phase<EpiRes, pg8::StaticOrder, PG8_ALIGN, PG8_SP2>(F.lds + RING_OFF, g, S, E);
    }
#undef IN
#undef BOTH
}

extern "C" void kernel_launch(void* const* d_in, const int* in_sizes, int n_in, void* d_out, int out_size, void* d_ws, size_t ws_size, hipStream_t stream) {
    static int grid = 0;
    if (grid == 0) {
        if (n_in != 30 || out_size != (int)O_END || ws_size < WS_END2) { fprintf(stderr, "kernel_launch: unexpected shapes (n_in %d out %d ws %zu)\n", n_in, out_size, ws_size); grid = -1; return; }
        int dev = 0, cus = 0;
        if (hipGetDevice(&dev) != hipSuccess || hipDeviceGetAttribute(&cus, hipDeviceAttributeMultiprocessorCount, dev) != hipSuccess) { grid = -1; return; }
        if (hipFuncSetAttribute((const void*)fwd_kernel, hipFuncAttributeMaxDynamicSharedMemorySize, LDS_BYTES) != hipSuccess) { fprintf(stderr, "kernel_launch: hipFuncSetAttribute failed\n"); grid = -1; return; }
        (void)hipGetLastError();
        grid = cus;
    }
    if (grid < 0) return;
    (void)hipMemsetAsync((char*)d_ws + WS_CTL, 0, CTL_ZERO_BYTES, stream);
    Args a{};
    for (int i = 0; i < 30; ++i) a.in[i] = (const float*)d_in[i];
    a.out = (float*)d_out; a.ws = (unsigned char*)d_ws; a.pad = PROBE_PAD;
#if MK_ONE_LAUNCH
    a.ph_lo = 0; a.ph_hi = N_PHASES; a.li = 0;
    hipLaunchKernelGGL(fwd_kernel, dim3(grid), dim3(NWAVES * 64), LDS_BYTES, stream, a);
#else
    for (int li = 0; li < N_PHASES; ++li) { a.ph_lo = li; a.ph_hi = li + 1; a.li = li;
        hipLaunchKernelGGL(fwd_kernel, dim3(grid), dim3(NWAVES * 64), LDS_BYTES, stream, a); }
#endif
}
```

```cpp
#include <hip/hip_runtime.h>
#include <cstdio>
#include <cstdint>
#include <cmath>

#define PROBE_PAD 0
namespace pg8 {
#define PG8_LAS __attribute__((address_space(3)))
typedef unsigned short bf16_t;
typedef short bf16x8 __attribute__((ext_vector_type(8)));
typedef float f32x4 __attribute__((ext_vector_type(4)));
typedef unsigned u32x4 __attribute__((ext_vector_type(4)));
constexpr int BM = 256, BK = 64, HALF = 128, HTB = HALF * BK * 2  , STAGE_BYTES = 8 * HTB, NXCD = 8, WGM = 8;

__host__ __device__ __forceinline__ int lds_byte(int r, int c) { const int st = (r >> 4) * 2 + (c >> 5), rr = r & 15, cc = c & 31, ob = rr * 64 + cc * 2; return st * 1024 + (ob ^ (((ob >> 9) & 1) << 5)); }
__host__ __device__ __forceinline__ void stage_rc(int b, int& R, int& C) { const int st = b / 1024, sb = b % 1024, swz = sb ^ (((sb >> 9) & 1) << 5); R = (st >> 1) * 16 + swz / 64; C = (st & 1) * 32 + (swz % 64) / 2; }
__host__ __device__ __forceinline__ int perm32(int rho) { const int n = rho >> 4, i = rho & 15; return 8 * (i >> 2) + 4 * n + (i & 3); }

struct Unit { int pm, pn; };
struct Gemm { const bf16_t* A; const bf16_t* Bt; int M, N, K; };

struct StaticOrder {
    int nM, nN, nwg, G, c;
    __host__ __device__ void init(int M, int N, int G_, int c_) { nM = M / BM; nN = N / BM; nwg = nM * nN; G = G_; c = c_; }
    __host__ __device__ bool next(int i, Unit& u) const {
        const long L = (long)i * G + c; if (L >= nwg) return false;
        int wgid = (int)L; { const int q = nwg / NXCD, r = nwg % NXCD, xcd = wgid % NXCD, off = wgid / NXCD; wgid = (xcd < r ? xcd * (q + 1) : r * (q + 1) + (xcd - r) * q) + off; }
        const int nig = WGM * nN, gid = wgid / nig, fm = gid * WGM, gsz = (nM - fm) < WGM ? (nM - fm) : WGM;
        u.pm = fm + ((wgid % nig) % gsz); u.pn = (wgid % nig) / gsz; return true;
    }
    __device__ __forceinline__ void a_ready(const Unit&) const {}
    __device__ __forceinline__ void done(const Unit&) const {}
};

__device__ __forceinline__ unsigned cvt_pk_bf16(float lo, float hi) { unsigned r; asm volatile("v_cvt_pk_bf16_f32 %0, %1, %2" : "=v"(r) : "v"(lo), "v"(hi)); return r; }
typedef float f32x2 __attribute__((ext_vector_type(2)));
__device__ __forceinline__ f32x2 gelu_pk(f32x2 v) {
    const f32x2 av = __builtin_elementwise_abs(v), d = av * 0.2316418882f + 1.0f;
    f32x2 t; t.x = __builtin_amdgcn_rcpf(d.x); t.y = __builtin_amdgcn_rcpf(d.y);
    f32x2 q = t * 0.5307027145f + (-0.7265760135f); q = q * t + 0.7107068705f; q = q * t + (-0.142248368f); q = q * t + 0.127414796f; q = q * t;
    const f32x2 s = (v * v) * (-0.72134752044f);
    f32x2 e; e.x = __builtin_amdgcn_exp2f(s.x); e.y = __builtin_amdgcn_exp2f(s.y);
    const f32x2 m = v * (q * e), r = v - m;
    f32x2 o; o.x = v.x < 0.f ? m.x : r.x; o.y = v.y < 0.f ? m.y : r.y; return o;
}

template <int ACT  > struct EpiBf16 {
    static constexpr bool PERM = true, AFTER_DRAIN = false; static_assert(ACT == 0 || ACT == 1, "EpiBf16: ACT is 0 (none) or 1 (gelu_pk)");
    bf16_t* O; int ldc; const float* bias; int split_cols; size_t split_stride; float scale0;
    __device__ __forceinline__ void operator()(const f32x4 (&acc)[2][2][4][2], const Unit& u, int wr, int wc, int fr, int fq) const {
        const int row0 = u.pm * BM + wr * 64 + fr; int colt = u.pn * BM; bf16_t* base = O;
        float sc = 1.f; if (split_cols) { const int t = colt / split_cols; base += (size_t)t * split_stride; colt -= t * split_cols; if (t == 0) sc = scale0; }
        const int col0 = colt + wc * 32 + 8 * fq, bcol0 = u.pn * BM + wc * 32 + 8 * fq;
        f32x4 bv[2][2];
#pragma unroll
        for (int bj = 0; bj < 2; ++bj)
#pragma unroll
            for (int n = 0; n < 2; ++n) bv[bj][n] = bias ? *(const f32x4*)(bias + bcol0 + bj * HALF + 4 * n) : (f32x4){0.f, 0.f, 0.f, 0.f};
#pragma unroll
        for (int ai = 0; ai < 2; ++ai)
#pragma unroll
            for (int m = 0; m < 4; ++m) { bf16_t* rowp = base + (size_t)(row0 + ai * HALF + m * 16) * ldc + col0;
#pragma unroll
                for (int bj = 0; bj < 2; ++bj) { f32x4 v0 = acc[ai][bj][m][0] + bv[bj][0], v1 = acc[ai][bj][m][1] + bv[bj][1];
                    if (ACT == 1) { f32x2 a = gelu_pk((f32x2){v0[0], v0[1]}), b = gelu_pk((f32x2){v0[2], v0[3]}), c = gelu_pk((f32x2){v1[0], v1[1]}), d = gelu_pk((f32x2){v1[2], v1[3]});
                        v0 = (f32x4){a.x, a.y, b.x, b.y}; v1 = (f32x4){c.x, c.y, d.x, d.y}; }
                    v0 = v0 * sc; v1 = v1 * sc; u32x4 w; w.x = cvt_pk_bf16(v0[0], v0[1]); w.y = cvt_pk_bf16(v0[2], v0[3]); w.z = cvt_pk_bf16(v1[0], v1[1]); w.w = cvt_pk_bf16(v1[2], v1[3]);
                    *(u32x4*)(rowp + bj * HALF) = w; } }
    }
};


template <class Epi, class Sched, bool ALIGN_EPI = false, bool SP2 = false>
__device__ __forceinline__ void gemm_phase(PG8_LAS unsigned char* lds, const Gemm g, const Sched& S, const Epi& E) {
    const int tid = threadIdx.x, wid = __builtin_amdgcn_readfirstlane(tid >> 6), lane = tid & 63, wr = wid >> 2, wc = wid & 3, fr = lane & 15, fq = lane >> 4;
    const int K = g.K, nt = K / BK;
    unsigned voffA[2], voffB[2];
#pragma unroll
    for (int i = 0; i < 2; ++i) { int R, C; stage_rc(tid * 16 + i * 8192, R, C); const int Rb = Epi::PERM ? ((R & ~31) + perm32(R & 31)) : R;
        voffA[i] = (unsigned)(R * K + C) * 2u; voffB[i] = (unsigned)(Rb * K + C) * 2u; }
    const size_t kstep = (size_t)(BK * 2);
    const size_t hstep = (size_t)HALF * K * 2;
    const size_t tstep = 2 * hstep;
    const unsigned ldsw = (unsigned)wid * 1024u;
    const int aoff = lds_byte(wr * 64 + fr, fq * 8), boff = lds_byte(wc * 32 + fr, fq * 8);
#define PG8_SA(b, h) (((b) * 2 + (h)) * HTB)
#define PG8_SB(b, h) ((4 + (b) * 2 + (h)) * HTB)
#define PG8_STAGE(bufoff, gbase, voff) do { _Pragma("unroll") for (int _i = 0; _i < 2; ++_i) \
        __builtin_amdgcn_global_load_lds((const unsigned*)((const char*)(gbase) + (voff)[_i]), (PG8_LAS unsigned*)(lds + (bufoff) + ldsw + _i * 8192), 16, 0, 0); } while (0)
#define PG8_LDA(dst, b, h) do { _Pragma("unroll") for (int m = 0; m < 4; ++m) _Pragma("unroll") for (int k = 0; k < 2; ++k) dst[m][k] = *(const PG8_LAS bf16x8*)(lds + PG8_SA(b, h) + aoff + m * 2048 + k * 1024); } while (0)
#define PG8_LDB(dst, b, h) do { _Pragma("unroll") for (int n = 0; n < 2; ++n) _Pragma("unroll") for (int k = 0; k < 2; ++k) dst[n][k] = *(const PG8_LAS bf16x8*)(lds + PG8_SB(b, h) + boff + n * 2048 + k * 1024); } while (0)
#define PG8_MMA(ai, bj, At, Bt) do { __builtin_amdgcn_s_setprio(1); _Pragma("unroll") for (int m = 0; m < 4; ++m) _Pragma("unroll") for (int n = 0; n < 2; ++n) _Pragma("unroll") for (int k = 0; k < 2; ++k) \
        acc[ai][bj][m][n] = __builtin_amdgcn_mfma_f32_16x16x32_bf16(Bt[n][k], At[m][k], acc[ai][bj][m][n], 0, 0, 0); __builtin_amdgcn_s_setprio(0); } while (0)
#define PG8_WAIT_V(n) asm volatile("s_waitcnt vmcnt(" #n ")" ::: "memory")
#define PG8_WAIT_L(n) asm volatile("s_waitcnt lgkmcnt(" #n ")" ::: "memory")
#define PG8_BAR __builtin_amdgcn_s_barrier()
#define PG8_SCHED __builtin_amdgcn_sched_barrier(0)
    Unit cur, nxt; int ui = 0;
    if (!S.next(0, cur)) return;
    f32x4 acc[2][2][4][2];
#pragma unroll
    for (int a = 0; a < 2; ++a)
#pragma unroll
        for (int b = 0; b < 2; ++b)
#pragma unroll
            for (int m = 0; m < 4; ++m)
#pragma unroll
                for (int n = 0; n < 2; ++n) acc[a][b][m][n] = (f32x4){0.f, 0.f, 0.f, 0.f};
    bf16x8 At[4][2], B0[2][2], B1[2][2];
    const char* cA = (const char*)g.A + (size_t)cur.pm * tstep; const char* cB = (const char*)g.Bt + (size_t)cur.pn * tstep;
    S.a_ready(cur);
    if constexpr (SP2) {
        PG8_STAGE(PG8_SB(0, 0), cB, voffB); PG8_STAGE(PG8_SB(0, 1), cB + hstep, voffB); PG8_STAGE(PG8_SA(0, 0), cA, voffA); PG8_STAGE(PG8_SA(0, 1), cA + hstep, voffA);
        if (wr == 1) PG8_BAR;
        PG8_WAIT_V(2); PG8_BAR;
        PG8_STAGE(PG8_SB(1, 0), cB + kstep, voffB); PG8_STAGE(PG8_SA(1, 0), cA + kstep, voffA); PG8_STAGE(PG8_SB(1, 1), cB + hstep + kstep, voffB);
        PG8_WAIT_V(6); PG8_BAR;
    } else {
        PG8_STAGE(PG8_SB(0, 0), cB, voffB); PG8_STAGE(PG8_SA(0, 0), cA, voffA); PG8_STAGE(PG8_SB(0, 1), cB + hstep, voffB); PG8_STAGE(PG8_SA(0, 1), cA + hstep, voffA);
        if (wr == 1) PG8_BAR;
        PG8_WAIT_V(4); PG8_BAR;
        PG8_STAGE(PG8_SB(1, 0), cB + kstep, voffB); PG8_STAGE(PG8_SA(1, 0), cA + kstep, voffA); PG8_STAGE(PG8_SB(1, 1), cB + hstep + kstep, voffB);
        PG8_WAIT_V(6); PG8_BAR;
    }
    for (;;) {
        const bool has_next = S.next(ui + 1, nxt);
        const char* nA = has_next ? (const char*)g.A + (size_t)nxt.pm * tstep : cA; const char* nB = has_next ? (const char*)g.Bt + (size_t)nxt.pn * tstep : cB;
        for (int t = 0; t < nt; t += 2) {
            const bool last = (t == nt - 2);
            const char* a1 = cA + (size_t)(t + 1) * kstep;
            const char* a2 = last ? nA : cA + (size_t)(t + 2) * kstep; const char* b2 = last ? nB : cB + (size_t)(t + 2) * kstep;
            const char* a3 = a2 + kstep; const char* b3 = b2 + kstep;
            if (last && has_next) S.a_ready(nxt);
            if constexpr (SP2) {
            PG8_LDB(B0, 0, 0); PG8_LDB(B1, 0, 1); PG8_SCHED; PG8_LDA(At, 0, 0); PG8_STAGE(PG8_SA(1, 1), a1 + hstep, voffA);
            PG8_WAIT_V(8); PG8_WAIT_L(0); PG8_BAR; PG8_MMA(0, 0, At, B0); PG8_MMA(0, 1, At, B1); PG8_BAR; PG8_SCHED;
            PG8_LDA(At, 0, 1); PG8_STAGE(PG8_SB(0, 0), b2, voffB); PG8_STAGE(PG8_SB(0, 1), b2 + hstep, voffB); PG8_STAGE(PG8_SA(0, 0), a2, voffA);
            PG8_WAIT_V(8); PG8_WAIT_L(0); PG8_BAR; PG8_MMA(1, 0, At, B0); PG8_MMA(1, 1, At, B1); PG8_BAR; PG8_SCHED;
            PG8_LDB(B0, 1, 0); PG8_LDB(B1, 1, 1); PG8_SCHED; PG8_LDA(At, 1, 0); PG8_STAGE(PG8_SA(0, 1), a2 + hstep, voffA);
            PG8_WAIT_V(8); PG8_WAIT_L(0); PG8_BAR; PG8_MMA(0, 0, At, B0); PG8_MMA(0, 1, At, B1); PG8_BAR; PG8_SCHED;
            PG8_LDA(At, 1, 1); PG8_STAGE(PG8_SB(1, 0), b3, voffB); PG8_STAGE(PG8_SB(1, 1), b3 + hstep, voffB); PG8_STAGE(PG8_SA(1, 0), a3, voffA);
            PG8_WAIT_V(8); PG8_WAIT_L(0); PG8_BAR; PG8_MMA(1, 0, At, B0); PG8_MMA(1, 1, At, B1); PG8_BAR; PG8_SCHED;
            } else {
            PG8_LDB(B0, 0, 0); PG8_SCHED; PG8_LDA(At, 0, 0); PG8_STAGE(PG8_SA(1, 1), a1 + hstep, voffA);
            PG8_WAIT_L(8); PG8_BAR; PG8_WAIT_L(0); PG8_MMA(0, 0, At, B0); PG8_BAR; PG8_SCHED;
            PG8_LDB(B1, 0, 1); PG8_STAGE(PG8_SB(0, 0), b2, voffB);
            PG8_BAR; PG8_WAIT_L(0); PG8_MMA(0, 1, At, B1); PG8_BAR;
            PG8_LDA(At, 0, 1); PG8_STAGE(PG8_SA(0, 0), a2, voffA);
            PG8_BAR; PG8_WAIT_L(0); PG8_MMA(1, 0, At, B0); PG8_BAR; PG8_SCHED;
            PG8_STAGE(PG8_SB(0, 1), b2 + hstep, voffB);
            PG8_WAIT_V(6); PG8_BAR; PG8_MMA(1, 1, At, B1); PG8_BAR;
            PG8_LDB(B0, 1, 0); PG8_SCHED; PG8_LDA(At, 1, 0); PG8_STAGE(PG8_SA(0, 1), a2 + hstep, voffA);
            PG8_WAIT_L(8); PG8_BAR; PG8_WAIT_L(0); PG8_MMA(0, 0, At, B0); PG8_BAR; PG8_SCHED;
            PG8_LDB(B1, 1, 1); PG8_STAGE(PG8_SB(1, 0), b3, voffB);
            PG8_BAR; PG8_WAIT_L(0); PG8_MMA(0, 1, At, B1); PG8_BAR;
            PG8_LDA(At, 1, 1); PG8_STAGE(PG8_SA(1, 0), a3, voffA);
            PG8_BAR; PG8_WAIT_L(0); PG8_MMA(1, 0, At, B0); PG8_BAR; PG8_SCHED;
            PG8_STAGE(PG8_SB(1, 1), b3 + hstep, voffB);
            PG8_WAIT_V(6); PG8_BAR; PG8_MMA(1, 1, At, B1); PG8_BAR;
            }
        }
        if constexpr (ALIGN_EPI) { if (wr == 0) PG8_BAR; }
        if constexpr (!Epi::AFTER_DRAIN) { E(acc, cur, wr, wc, fr, fq); S.done(cur); }
        if (!has_next) break;
#pragma unroll
        for (int a = 0; a < 2; ++a)
#pragma unroll
            for (int b = 0; b < 2; ++b)
#pragma unroll
                for (int m = 0; m < 4; ++m)
#pragma unroll
                    for (int n = 0; n < 2; ++n) acc[a][b][m][n] = (f32x4){0.f, 0.f, 0.f, 0.f};
        cur = nxt; cA = nA; cB = nB; ++ui;
        if constexpr (ALIGN_EPI) { if (wr == 1) PG8_BAR; }
    }
    PG8_WAIT_V(0);
    if constexpr (!ALIGN_EPI) { if (wr == 0) PG8_BAR; }
    PG8_BAR;
    if constexpr (Epi::AFTER_DRAIN) { E.fused(acc, cur, wr, wc, fr, fq, lds, wid, lane); S.done(cur); }
#undef PG8_SA
#undef PG8_SB
#undef PG8_STAGE
#undef PG8_LDA
#undef PG8_LDB
#undef PG8_MMA
#undef PG8_WAIT_V
#undef PG8_WAIT_L
#undef PG8_BAR
#undef PG8_SCHED
}
}
#ifndef PG8_SP2
#define PG8_SP2 true
#endif
#ifndef PG8_ALIGN
#define PG8_ALIGN true
#endif
#define GAS __attribute__((address_space(1)))
#define LAS __attribute__((address_space(3)))
typedef unsigned short bf16;
typedef unsigned v4u __attribute__((ext_vector_type(4)));
typedef float f32x4 __attribute__((ext_vector_type(4)));
typedef short bf16x8 __attribute__((ext_vector_type(8)));
typedef GAS unsigned gu32;
typedef GAS unsigned long long gu64;
#define RLX_AGENT __ATOMIC_RELAXED, __HIP_MEMORY_SCOPE_AGENT
#define LDS_WAIT() asm volatile("s_waitcnt lgkmcnt(0)" ::: "memory")
#define VM_WAIT() asm volatile("s_waitcnt vmcnt(0)" ::: "memory")
__device__ __forceinline__ unsigned long long rt() { return __builtin_amdgcn_s_memrealtime(); }
typedef float f32x2_t __attribute__((ext_vector_type(2))); typedef __bf16 bf16x2_t __attribute__((ext_vector_type(2)));
__device__ __forceinline__ unsigned pk2(float lo, float hi) { const f32x2_t v = {lo, hi}; const bf16x2_t b = __builtin_convertvector(v, bf16x2_t); return __builtin_bit_cast(unsigned, b); }
__device__ __forceinline__ unsigned f2bf(float f) { return pk2(f, 0.f) & 0xffffu; }

#define XB_TMO      128
#define XB_XCNT(j)  (256  + 64 * (j))
#define XB_XSUB(j)  (1280 + 64 * (j))
#define XB_XGEN(j)  (2304 + 64 * (j))
#define XB_TOP      3328
#define XB_TOPGEN   3392
#define XCD_BAR_WORDS 3456
#define XB_SPIN_CAP (1u << 18)

__device__ __forceinline__ unsigned xb_ld(unsigned* p)              { return __hip_atomic_load(p, __ATOMIC_RELAXED, __HIP_MEMORY_SCOPE_AGENT); }
__device__ __forceinline__ unsigned xb_add(unsigned* p, unsigned v) { return __hip_atomic_fetch_add(p, v, __ATOMIC_RELAXED, __HIP_MEMORY_SCOPE_AGENT); }
__device__ __forceinline__ unsigned xb_xcc_id() { return (unsigned)__builtin_amdgcn_s_getreg((3 << 11) | 20) & 0xFu; }
#define XB_SPIN(cond, bar) do { unsigned _sp = 0; while (cond) { __builtin_amdgcn_s_sleep(1); \
    if ((++_sp & 255u) == 0u) { if (xb_ld(&(bar)[XB_TMO])) break; if (_sp > XB_SPIN_CAP) { atomicAdd(&(bar)[XB_TMO], 1u); break; } } } } while (0)

struct XcdBarrier {
    unsigned* bar; unsigned x;
    volatile LAS unsigned* st;
};

__device__ __forceinline__ XcdBarrier xcd_barrier_post(unsigned* bar, volatile LAS unsigned* st) {
    XcdBarrier b; b.bar = bar; b.x = xb_xcc_id(); b.st = st;
    if (threadIdx.x == 0) (void)xb_add(&bar[XB_XCNT(b.x)], 1u);
    return b;
}
__device__ __forceinline__ void xcd_barrier_complete(unsigned* bar, unsigned x, unsigned& nloc, unsigned& nx) {
    const unsigned G = gridDim.x * gridDim.y * gridDim.z;
    unsigned sum, cnt, mine, sp = 0u;
    for (;;) {
        sum = 0u; cnt = 0u; mine = 0u;
#pragma unroll
        for (unsigned j = 0; j < 16; ++j) { const unsigned c = xb_ld(&bar[XB_XCNT(j)]); sum += c; cnt += (c > 0u) ? 1u : 0u; mine = (j == x) ? c : mine; }
        if (sum == G) break;
        __builtin_amdgcn_s_sleep(1);
        if ((++sp & 255u) == 0u) { if (xb_ld(&bar[XB_TMO])) break; if (sp > XB_SPIN_CAP) { atomicAdd(&bar[XB_TMO], 1u); break; } }
    }
    nloc = mine > 0u ? mine : 1u; nx = cnt > 0u ? cnt : 1u;
}

__device__ __forceinline__ void xcd_barrier(const XcdBarrier& b) {
    asm volatile("s_waitcnt vmcnt(0)" ::: "memory");
    __syncthreads();
    if (threadIdx.x == 0) {
        unsigned* bar = b.bar;
        __builtin_amdgcn_s_waitcnt(0);
        unsigned nloc = b.st[0], nx = b.st[1];
        if (nloc == 0u) { xcd_barrier_complete(bar, b.x, nloc, nx); b.st[0] = nloc; b.st[1] = nx; }
        const unsigned old = xb_add(&bar[XB_XSUB(b.x)], 1u);
        const unsigned gen = old / nloc;
        if (old + 1u == (gen + 1u) * nloc) {
            __builtin_amdgcn_fence(__ATOMIC_RELEASE, "agent");
            asm volatile("s_waitcnt vmcnt(0)" ::: "memory");
            const unsigned og = xb_add(&bar[XB_TOP], 1u);
            const unsigned tg = og / nx;
            if (og + 1u == (tg + 1u) * nx) xb_add(&bar[XB_TOPGEN], 1u);
            else XB_SPIN(xb_ld(&bar[XB_TOPGEN]) == tg, bar);
            __builtin_amdgcn_fence(__ATOMIC_ACQUIRE, "agent");
            xb_add(&bar[XB_XGEN(b.x)], 1u);
            asm volatile("s_waitcnt vmcnt(0)" ::: "memory");
        } else {
            XB_SPIN(xb_ld(&bar[XB_XGEN(b.x)]) == gen, bar);
            __builtin_amdgcn_fence(__ATOMIC_ACQUIRE, "agent");
            asm volatile("s_waitcnt vmcnt(0)" ::: "memory");
        }
    }
    __syncthreads();
}

constexpr int NWAVES = 8;
#ifndef FOX_SKIP
#define FOX_SKIP 1
#endif
#ifndef MK_ONE_LAUNCH
#define MK_ONE_LAUNCH 1
#endif
constexpr int N_PHASES = 7;

constexpr int DM = 1024, BATCH = 8, SEQ = 4096, DECB = 32, DECS = 16, PAST = 1024, NMEM = 256;
constexpr int MP = BATCH * SEQ, MS = DECB * DECS, MT = MP + MS;
constexpr int NIN = 3654, NP = 3840;
constexpr int HC_FQ = 0, HC_FK = 384, HC_FV = 768, HC_FG = 1152, HC_RR = 1536, HC_RK = 1920, HC_RV = 2304, HC_RG = 2688,
              HC_MQ = 3072, HC_MG = 3328, HC_WD = 3584, HC_AD = 3616, HC_FF = 3648;
constexpr float NORM_EPS = 1e-6f, GN_EPS = 64e-5f, LOG2E = 1.4426950408889634f, C2 = 0.125f * 1.4426950408889634f;

constexpr size_t O_YP = 0, O_YS = O_YP + (size_t)MP * DM, O_FKP = O_YS + (size_t)MS * DM, O_FVP = O_FKP + (size_t)MP * 384, O_FLP = O_FVP + (size_t)MP * 384,
                 O_MKP = O_FLP + (size_t)MP * 6, O_MVP = O_MKP + (size_t)BATCH * NMEM * 256, O_RSP = O_MVP + (size_t)BATCH * NMEM * 256, O_RHP = O_RSP + (size_t)BATCH * 6 * 4096,
                 O_FKS = O_RHP + (size_t)BATCH * 1600, O_FVS = O_FKS + (size_t)MS * 384, O_FLS = O_FVS + (size_t)MS * 384, O_RSS = O_FLS + (size_t)MS * 6,
                 O_RHS = O_RSS + (size_t)DECB * 6 * 4096, O_END = O_RHS + (size_t)DECB * 1600;
static_assert(O_END == 61933056, "d_out map");

constexpr size_t MiB = 1u << 20;
constexpr size_t WS_CTL = 0, CTL_ZERO_BYTES = 1 * MiB;
constexpr size_t WS_WIN = 2 * MiB, WS_WOUT = 10 * MiB, WS_WMEM = 12 * MiB, WS_MEMN = 13 * MiB, WS_MKV = 17 * MiB, WS_NCKP = 19 * MiB, WS_NCKS = 20 * MiB;
constexpr size_t WS_XN = 24 * MiB;
constexpr size_t WS_H = 96 * MiB;
constexpr size_t WS_END = WS_H + (size_t)MT * NP * 2;
static_assert(WS_XN + (size_t)MT * DM * 2 <= WS_H && WS_END <= 400 * MiB, "d_ws map");
constexpr int CW_BAR = 4096, CW_Q = 64;

constexpr int RING_OFF = 0, RING_BYTES = 131072;
constexpr int LDS_BYTES = 147456;
constexpr int LDSCTL_OFF = LDS_BYTES - 448, MISC_OFF = LDSCTL_OFF + 320;

struct Args { const float* in[30]; float* out; unsigned char* ws; int ph_lo, ph_hi, li, pad; };
enum { I_XP = 0, I_XS, I_MEMP, I_CFK, I_CFV, I_CFL, I_CMK, I_CMV, I_SRW, I_SSH, I_NG, I_WIN, I_FQG, I_FKG, I_FBF, I_MU, I_W0, I_WUP, I_A0, I_AUP,
       I_KK, I_KA, I_RK, I_GNW, I_GNB, I_MNG, I_WMKV, I_MQG, I_MKG, I_WOUT };

struct Ctx { LAS unsigned char* lds; volatile LAS unsigned* MISC; gu32* ctl; int tid, lane, wave, vcu, G; };

__device__ __forceinline__ float bf2f(bf16 u) { return __uint_as_float((unsigned)u << 16); }
template <int CTRL> __device__ __forceinline__ float dpp_f(float v) { return __int_as_float(__builtin_amdgcn_mov_dpp(__float_as_int(v), CTRL, 0xF, 0xF, true)); }
#define XROW16(v, a_, b_) const auto x16_ = __builtin_amdgcn_permlane16_swap(__float_as_uint(v), __float_as_uint(v), false, false); const float a_ = __uint_as_float(x16_[0]), b_ = __uint_as_float(x16_[1])
#define XHALF32(v, a_, b_) const auto x32_ = __builtin_amdgcn_permlane32_swap(__float_as_uint(v), __float_as_uint(v), false, false); const float a_ = __uint_as_float(x32_[0]), b_ = __uint_as_float(x32_[1])
__device__ __forceinline__ float xsum16(float v) { XROW16(v, a, b); return a + b; }
__device__ __forceinline__ float xsum32(float v) { XHALF32(v, a, b); return a + b; }
__device__ __forceinline__ float wave_sum(float v) {
    v += dpp_f<0xB1>(v); v += dpp_f<0x4E>(v); v += dpp_f<0x141>(v); v += dpp_f<0x140>(v);
    return xsum32(xsum16(v));
}
__device__ __forceinline__ float wave_max(float v) {
    v = fmaxf(v, dpp_f<0xB1>(v)); v = fmaxf(v, dpp_f<0x4E>(v)); v = fmaxf(v, dpp_f<0x141>(v)); v = fmaxf(v, dpp_f<0x140>(v));
    { XROW16(v, a, b); v = fmaxf(a, b); }
    { XHALF32(v, a, b); v = fmaxf(a, b); }
    return v;
}
__device__ __forceinline__ float sum8(float v) {
    v += dpp_f<0xB1>(v);
    v += dpp_f<0x4E>(v);
    v += dpp_f<0x141>(v);
    return v; }
__device__ __forceinline__ void unpack8(const v4u w, float (&f)[8]) {
    f[0] = __uint_as_float(w.x << 16); f[1] = __uint_as_float(w.x & 0xffff0000u); f[2] = __uint_as_float(w.y << 16); f[3] = __uint_as_float(w.y & 0xffff0000u);
    f[4] = __uint_as_float(w.z << 16); f[5] = __uint_as_float(w.z & 0xffff0000u); f[6] = __uint_as_float(w.w << 16); f[7] = __uint_as_float(w.w & 0xffff0000u); }
__device__ __forceinline__ void ld8(const float* p, float (&f)[8]) { const f32x4 a = *(const f32x4*)p, b = *(const f32x4*)(p + 4);
    f[0] = a.x; f[1] = a.y; f[2] = a.z; f[3] = a.w; f[4] = b.x; f[5] = b.y; f[6] = b.z; f[7] = b.w; }
__device__ __forceinline__ float fexp(float x) { return __builtin_amdgcn_exp2f(x * LOG2E); }
__device__ __forceinline__ float frcp(float x) { return __builtin_amdgcn_rcpf(x); }
__device__ __forceinline__ float frsq(float x) { return __builtin_amdgcn_rsqf(x); }
__device__ __forceinline__ float flog(float x) { return __builtin_amdgcn_logf(x) * 0.6931471805599453f; }
__device__ __forceinline__ float siluf(float g) { return g * frcp(1.f + fexp(-g)); }
__device__ __forceinline__ float sigmf(float x) { return frcp(1.f + fexp(-x)); }
__device__ __forceinline__ float softplusf(float z) { return fmaxf(z, 0.f) + flog(1.f + fexp(-fabsf(z))); }
__device__ __forceinline__ float ftanh(float x) { return 1.f - 2.f * frcp(fexp(2.f * x) + 1.f); }

__device__ __forceinline__ int colmap_in(int n) {
    if (n < 1152) return n;
    if (n < 1158) return HC_FF + (n - 1152);
    if (n < 1542) return HC_FG + (n - 1158);
    if (n < 3142) { const int m = n - 1542;
        if (m < 1152) return HC_RR + m;
        if (m < 1184) return HC_WD + (m - 1152);
        if (m < 1216) return HC_AD + (m - 1184);
        return HC_RG + (m - 1216); }
    return HC_MQ + (n - 3142);
}
__device__ __forceinline__ int physmap(int L) { return (L & ~255) | (((L >> 5) & 1) << 7) | (((L >> 6) & 3) << 5) | (L & 31); }
template <int MODE>
__device__ __forceinline__ void transpose_item(const float* W, int K, int N, bf16* WT, LAS float* scr, int item, int lane) {
    const int nblk = (N + 31) / 32, kb = item / nblk, nb = item % nblk, k0 = 64 * kb, n0 = 32 * nb;
    const int nl0 = lane & 31; const bool okn = (n0 + nl0) < N;
#pragma unroll
    for (int i = 0; i < 32; ++i) { const int kk = 2 * i + (lane >> 5); scr[kk * 33 + nl0] = okn ? W[(size_t)(k0 + kk) * N + n0 + nl0] : 0.f; }
    LDS_WAIT(); asm volatile("" ::: "memory");
    const int c = lane & 7;
#pragma unroll
    for (int j = 0; j < 4; ++j) { const int nl = (lane >> 3) + 8 * j, n = n0 + nl; const LAS float* s = scr + (8 * c) * 33 + nl;
        v4u o; o.x = pk2(s[0 * 33], s[1 * 33]); o.y = pk2(s[2 * 33], s[3 * 33]); o.z = pk2(s[4 * 33], s[5 * 33]); o.w = pk2(s[6 * 33], s[7 * 33]);
        if (n < N) { const int row = (MODE == 0) ? physmap(colmap_in(n)) : n; *(v4u*)(WT + (size_t)row * K + k0 + 8 * c) = o; } }
    LDS_WAIT(); asm volatile("" ::: "memory");
}
__device__ __forceinline__ void rms_row_to_bf16(const float* xrow, const float* g, bf16* orow, int lane) {
    const f32x4* xr = (const f32x4*)xrow + lane; const f32x4* gr = (const f32x4*)g + lane;
    f32x4 v[4]; float s = 0.f;
#pragma unroll
    for (int j = 0; j < 4; ++j) { v[j] = xr[64 * j]; s += (v[j].x * v[j].x + v[j].y * v[j].y) + (v[j].z * v[j].z + v[j].w * v[j].w); }
    const float rstd = frsq(wave_sum(s) * (1.f / DM) + NORM_EPS);
    unsigned long long* o8 = (unsigned long long*)orow + lane;
#pragma unroll
    for (int j = 0; j < 4; ++j) { const f32x4 gg = gr[64 * j]; const f32x4 y = v[j] * rstd * gg;
        o8[64 * j] = (unsigned long long)pk2(y.x, y.y) | ((unsigned long long)pk2(y.z, y.w) << 32); }
}
__device__ __forceinline__ void p0_prologue(const Ctx& F, const Args& a) {
    LAS float* scr = (LAS float*)(F.lds + RING_OFF + F.wave * 16384);
    const int gw = F.vcu * NWAVES + F.wave, NGW = F.G * NWAVES;
    bf16* WinT = (bf16*)(a.ws + WS_WIN); bf16* WoutT = (bf16*)(a.ws + WS_WOUT); bf16* WmemT = (bf16*)(a.ws + WS_WMEM);
    constexpr int I_IN = (DM / 64) * ((NIN + 31) / 32), I_OUT = (DM / 64) * (DM / 32), I_MEM = (DM / 64) * (512 / 32);
    for (int it = gw; it < I_IN + I_OUT + I_MEM; it += NGW) {
        int r = it;
        if (r < I_IN) { transpose_item<0>(a.in[I_WIN], DM, NIN, WinT, scr, r, F.lane); continue; } r -= I_IN;
        if (r < I_OUT) { transpose_item<1>(a.in[I_WOUT], DM, DM, WoutT, scr, r, F.lane); continue; } r -= I_OUT;
        transpose_item<1>(a.in[I_WMKV], DM, 512, WmemT, scr, r, F.lane);
    }
    for (int r = NIN + gw; r < NP; r += NGW) { v4u z = {0u, 0u, 0u, 0u}; v4u* p = (v4u*)(WinT + (size_t)physmap(r) * DM); p[F.lane] = z; p[F.lane + 64] = z; }
    bf16* XN = (bf16*)(a.ws + WS_XN); bf16* MEMN = (bf16*)(a.ws + WS_MEMN);
    for (int m0 = 2 * gw; m0 < MT + BATCH * NMEM; m0 += 2 * NGW) {
        const float* xr = (m0 < MP) ? a.in[I_XP] + (size_t)m0 * DM : (m0 < MT) ? a.in[I_XS] + (size_t)(m0 - MP) * DM : a.in[I_MEMP] + (size_t)(m0 - MT) * DM;
        const f32x4* gr = (const f32x4*)((m0 < MT) ? a.in[I_NG] : a.in[I_MNG]) + F.lane;
        unsigned long long* o8 = (unsigned long long*)((m0 < MT) ? XN + (size_t)m0 * DM : MEMN + (size_t)(m0 - MT) * DM) + F.lane;
        f32x4 v0[4], v1[4]; float s0 = 0.f, s1 = 0.f;
#pragma unroll
        for (int j = 0; j < 4; ++j) { v0[j] = __builtin_nontemporal_load((const f32x4*)xr + F.lane + 64 * j); v1[j] = __builtin_nontemporal_load((const f32x4*)xr + 256 + F.lane + 64 * j); }
#pragma unroll
        for (int j = 0; j < 4; ++j) { s0 += (v0[j].x * v0[j].x + v0[j].y * v0[j].y) + (v0[j].z * v0[j].z + v0[j].w * v0[j].w); s1 += (v1[j].x * v1[j].x + v1[j].y * v1[j].y) + (v1[j].z * v1[j].z + v1[j].w * v1[j].w); }
        s0 = wave_sum(s0); s1 = wave_sum(s1);
        const float r0 = frsq(s0 * (1.f / DM) + NORM_EPS), r1 = frsq(s1 * (1.f / DM) + NORM_EPS);
#pragma unroll
        for (int j = 0; j < 4; ++j) { const f32x4 gg = gr[64 * j]; const f32x4 y0 = v0[j] * r0 * gg, y1 = v1[j] * r1 * gg;
            o8[64 * j] = (unsigned long long)pk2(y0.x, y0.y) | ((unsigned long long)pk2(y0.z, y0.w) << 32);
            o8[256 + 64 * j] = (unsigned long long)pk2(y1.x, y1.y) | ((unsigned long long)pk2(y1.z, y1.w) << 32); }
    }
}

template <int CTRL, int ROWMASK> __device__ __forceinline__ float dpp_z(float v) { return __int_as_float(__builtin_amdgcn_update_dpp(0, __float_as_int(v), CTRL, ROWMASK, 0xF, false)); }
__device__ __forceinline__ float wave_incl_scan(float v, int lane) {
    (void)lane;
    v += dpp_z<0x111, 0xF>(v); v += dpp_z<0x112, 0xF>(v); v += dpp_z<0x114, 0xF>(v); v += dpp_z<0x118, 0xF>(v);
    v += dpp_z<0x142, 0xA>(v); v += dpp_z<0x143, 0xC>(v);
    return v;
}
constexpr int NBLK_PREP = MT / 256 + BATCH * NMEM / 64;
__device__ __forceinline__ void prep_block_task(LAS unsigned char* lds, const Args& a, int blk, int tid, int lane, int wave) {
    bf16* H = (bf16*)(a.ws + WS_H); bf16* MKV = (bf16*)(a.ws + WS_MKV); float* out = a.out;
    LAS float* LF = (LAS float*)lds;
    const int l8 = (lane & 7) * 8;
    __syncthreads();
    if (blk < MT / 256) {
#pragma unroll
        for (int k = 0; k < 3; ++k) {
            const int idx = tid + 512 * k, rl = idx / 6, hd = idx - 6 * rl, m = blk * 256 + rl;
            const float z = bf2f(H[(size_t)m * NP + HC_FF + hd]) + a.in[I_FBF][hd]; const float lf = -softplusf(-z);
            float* ol = (m < MP) ? out + O_FLP + (size_t)m * 6 : out + O_FLS + (size_t)(m - MP) * 6;
            ol[hd] = lf; LF[rl * 8 + hd] = lf;
        }
        __syncthreads();
        if (blk < MP / 256 && wave < 6) {
#pragma unroll
            for (int sb = 0; sb < 4; ++sb) {
                const int t64 = blk * 4 + sb, b = t64 / (SEQ / 64), kb = t64 % (SEQ / 64);
                const float incl = wave_incl_scan(LF[(sb * 64 + lane) * 8 + wave], lane);
                ((float*)(a.ws + WS_NCKP))[(size_t)(b * 6 + wave) * SEQ + kb * 64 + lane] = incl;
                if (lane == 63) ((float*)(a.ws + WS_NCKS))[(b * 6 + wave) * 64 + kb] = incl;
            }
        }
    } else {
        float gk[8]; ld8(a.in[I_MKG] + l8, gk);
#pragma unroll 2
        for (int i = 0; i < 8; ++i) {
            const int mm = (blk - MT / 256) * 64 + wave * 8 + i; bf16* kr = MKV + (size_t)mm * 512;
            if (lane < 32) {
                float k[8], v[8]; unpack8(*(const v4u*)(kr + lane * 8), k); unpack8(*(const v4u*)(kr + 256 + lane * 8), v);
                float sk = 0.f;
#pragma unroll
                for (int e = 0; e < 8; ++e) sk += k[e] * k[e];
                sk = sum8(sk); const float rk = frsq(sk * (1.f / 64.f) + NORM_EPS);
#pragma unroll
                for (int e = 0; e < 8; ++e) k[e] = k[e] * rk * gk[e];
                v4u wk; wk.x = pk2(k[0], k[1]); wk.y = pk2(k[2], k[3]); wk.z = pk2(k[4], k[5]); wk.w = pk2(k[6], k[7]);
                *(v4u*)(kr + lane * 8) = wk;
                float* okm = out + O_MKP + (size_t)mm * 256 + lane * 8; float* ovm = out + O_MVP + (size_t)mm * 256 + lane * 8;
                *(f32x4*)okm = (f32x4){k[0], k[1], k[2], k[3]}; *(f32x4*)(okm + 4) = (f32x4){k[4], k[5], k[6], k[7]};
                *(f32x4*)ovm = (f32x4){v[0], v[1], v[2], v[3]}; *(f32x4*)(ovm + 4) = (f32x4){v[4], v[5], v[6], v[7]};
            }
        }
    }
}

typedef float f32x16 __attribute__((ext_vector_type(16)));
typedef unsigned u32x2 __attribute__((ext_vector_type(2)));
__device__ __forceinline__ int crow(int r, int hi) { return (r & 3) + 8 * (r >> 2) + 4 * hi; }

struct AttnP { const bf16* Q; int qpitch; const bf16* K; int kpitch; const bf16* V; int vpitch; const float* nck; const float* bt; const float* gq; const float* gk; const bf16* Gt; int gpitch; bf16* O; int opitch; int nt; int q0; int causal; };
constexpr int AT_KS = 0, AT_VT = 9216, AT_NK = 18432, AT_BUF = 18688, AT_PS = 2 * AT_BUF, AT_AL = AT_PS + 8 * 4608;
constexpr int NQ_AT = 768 + 512;
struct AttnPf { float btv, nq0; };
__device__ __forceinline__ void attn_prefetch(AttnPf& pf, const Args& a, int tk, int lane) {
    pf.btv = 0.f; pf.nq0 = 0.f;
    if (tk < 768) { const int qb = 15 - (tk & 15), bh = tk >> 4;
        pf.btv = (lane < 4 * (qb + 1)) ? ((const float*)(a.ws + WS_NCKS))[(size_t)bh * 64 + lane] : 0.f;
        pf.nq0 = ((const float*)(a.ws + WS_NCKP))[(size_t)bh * SEQ + qb * 256]; }
}
constexpr int A6_SLOTB = 8192, A6_K = 0, A6_V = 3 * A6_SLOTB, A6_WS = 6 * A6_SLOTB, A6_OST = A6_WS + 8 * 256, A6_NK = A6_OST + 8 * 8192, A6_END = A6_NK + 3 * 2048;
static_assert(A6_END <= RING_BYTES, "attention LDS map");
typedef short s16x4 __attribute__((ext_vector_type(4)));
typedef LAS const char* lds_cptr;
#define A6_SBAR() __builtin_amdgcn_sched_barrier(0)
#define A6_PIN(x) asm volatile("" : "+v"(x))
#define A6_MFMA(a, b, c) __builtin_amdgcn_mfma_f32_32x32x16_bf16(a, b, c, 0, 0, 0)
#define A6_WAIT_BAR(N) asm volatile("s_waitcnt vmcnt(" #N ") lgkmcnt(0)\n\ts_barrier" ::: "memory")
__device__ __forceinline__ void a6_glds16(const void* g, unsigned lds_base) {
    unsigned sv; asm volatile("s_mov_b32 %0, m0\n\ts_mov_b32 m0, %2\n\ts_nop 0\n\tglobal_load_lds_dwordx4 %1, off\n\ts_mov_b32 m0, %0" : "=&s"(sv) : "v"(g), "s"(lds_base) : "memory"); }
__device__ __forceinline__ void a6_glds4(const void* g, unsigned lds_base) {
    unsigned sv; asm volatile("s_mov_b32 %0, m0\n\ts_mov_b32 m0, %2\n\ts_nop 0\n\tglobal_load_lds_dword %1, off\n\ts_mov_b32 m0, %0" : "=&s"(sv) : "v"(g), "s"(lds_base) : "memory"); }
__device__ __forceinline__ void a6_kload2(bf16x8* kf, lds_cptr kp, int d0) { kf[2 * d0] = *(LAS const bf16x8*)(kp + d0 * 2048); kf[2 * d0 + 1] = *(LAS const bf16x8*)(kp + d0 * 2048 + 512); }
__device__ __forceinline__ s16x4 a6_vtr(lds_cptr p) { return __builtin_bit_cast(s16x4, __builtin_amdgcn_ds_read_tr16_b64_v4i16((LAS s16x4*)p)); }
#define A6_MX3(a, b, c) __builtin_fmaxf(__builtin_fmaxf((a), (b)), (c))
__device__ __forceinline__ float a6_rowmax(const f32x16& p0, const f32x16& p1) {
    float a = A6_MX3(p0[0], p0[1], p1[0]), b = A6_MX3(p0[2], p0[3], p1[1]); a = A6_MX3(a, p1[2], p1[3]);
#pragma unroll
    for (int r = 4; r < 16; r += 4) { a = A6_MX3(a, p0[r], p0[r + 1]); b = A6_MX3(b, p0[r + 2], p0[r + 3]); a = A6_MX3(a, p1[r], p1[r + 1]); b = A6_MX3(b, p1[r + 2], p1[r + 3]); }
    float m = __builtin_fmaxf(a, b); auto rr = __builtin_amdgcn_permlane32_swap(__float_as_uint(m), __float_as_uint(m), false, false);
    return __builtin_fmaxf(__uint_as_float(rr[0]), __uint_as_float(rr[1])); }
__device__ __forceinline__ void a6_cmask(f32x16& p0, f32x16& p1, int jb, int qrel, int hi) {
    const int qk = qrel - 64 * jb - 4 * hi;
#pragma unroll
    for (int r = 0; r < 16; ++r) { const int kc = (r & 3) + 8 * (r >> 2); if (kc > qk) p0[r] = -INFINITY; if (kc + 32 > qk) p1[r] = -INFINITY; } }

template <bool BIAS, bool CAUSAL>
__device__ __forceinline__ void attn64_unit(LAS unsigned char* lds, const bf16* Qw, int qpitch, const bf16* K, int kpitch, const bf16* V, int vpitch, const float* nck, float pre, int t0, float cq0, float mhat0,
                                            int NT, const bf16* Gw, int gpitch, bf16* Ow, int opitch, const Args& a, AttnPf& pfn, volatile LAS unsigned* nextw, int& nx, int tid, int lane, int wid) {
    asm volatile("" : "+v"(lane));
    const int r32 = lane & 31, hi = lane >> 5;
    const unsigned lds0 = (unsigned)(size_t)lds; LAS float* wsf = (LAS float*)(lds + A6_WS) + wid * 64; LAS float* wsfh = wsf + 4 * hi;
    const bf16* ksrc = K + (size_t)lane * kpitch + wid * 8;
    const bf16* vsrc = V + (size_t)(16 * (wid & 3) + (lane >> 2)) * vpitch + (wid >> 2) * 32 + (lane & 3) * 8;
    const float* nsrc = nck + lane;
    const unsigned kdst = lds0 + A6_K + wid * 1024, vdst = lds0 + A6_V + wid * 1024, ndst = lds0 + A6_NK + wid * 256;
#define DMA_K(t, slot) do { a6_glds16(ksrc + (size_t)(t) * 64 * kpitch, (unsigned)__builtin_amdgcn_readfirstlane(kdst + (slot))); \
                            if (BIAS) a6_glds4(nsrc + (t) * 64, (unsigned)__builtin_amdgcn_readfirstlane(ndst + ((slot) >> 2))); } while (0)
#define DMA_V(t, slot) a6_glds16(vsrc + (size_t)(t) * 64 * vpitch, (unsigned)__builtin_amdgcn_readfirstlane(vdst + (slot)))
    const lds_cptr vp0 = (lds_cptr)lds + A6_V + ((lane >> 4) & 1) * 32 + (lane & 3) * 8 + (4 * hi + ((lane & 15) >> 2)) * 64;
    const lds_cptr kp0 = (lds_cptr)lds + A6_K + hi * 1024 + r32 * 16;
    const lds_cptr np0 = (lds_cptr)lds + A6_NK + wid * 256 + hi * 16;
    bf16x8 qr[4];
#pragma unroll
    for (int d0 = 0; d0 < 4; ++d0) qr[d0] = *reinterpret_cast<const bf16x8*>(&Qw[(size_t)r32 * qpitch + d0 * 16 + hi * 8]);
    float mhat = mhat0, l_reg = 0.f; asm volatile("" : "+v"(mhat));
    DMA_K(0, 0); DMA_V(0, 0); DMA_K(1, A6_SLOTB); DMA_K(2, 2 * A6_SLOTB);
    f32x16 o[2]; o[0] = f32x16{}; o[1] = f32x16{};
    const int qrel = wid * 32 + r32; bool resc = false;
    f32x16 pA0, pA1, pB0, pB1; bf16x8 kf[8]; s16x4 vlo[8], vhi[8]; v4u pw0, pw1, pw2, pw3;
    int sl_prev = 0, sl_cur = 0, sl_next = A6_SLOTB;
#define ROT() do { sl_prev = sl_cur; sl_cur = sl_next; sl_next = (sl_next == 2 * A6_SLOTB) ? 0 : sl_next + A6_SLOTB; } while (0)
#define CTV(tt) (BIAS ? (cq0 - __int_as_float(__builtin_amdgcn_readlane(__float_as_int(pre), t0 + (tt)))) * LOG2E - mhat : -mhat)
#define BIASF(y, ct) (BIAS ? __builtin_fmaf((y), -LOG2E, (ct)) : (ct))
#define NKRD(P0, P1, slot) do { if (BIAS) { _Pragma("unroll") for (int g_ = 0; g_ < 4; ++g_) { const f32x4 a0_ = *(LAS const f32x4*)(np0 + ((slot) >> 2) + g_ * 32), a1_ = *(LAS const f32x4*)(np0 + ((slot) >> 2) + 128 + g_ * 32); \
        P0[4 * g_] = a0_.x; P0[4 * g_ + 1] = a0_.y; P0[4 * g_ + 2] = a0_.z; P0[4 * g_ + 3] = a0_.w; P1[4 * g_] = a1_.x; P1[4 * g_ + 1] = a1_.y; P1[4 * g_ + 2] = a1_.z; P1[4 * g_ + 3] = a1_.w; } } } while (0)
#define EX(v) __builtin_amdgcn_exp2f(v)
#define RESC() do { if (resc) { _Pragma("unroll") for (int d_ = 0; d_ < 2; ++d_) _Pragma("unroll") for (int r = 0; r < 16; ++r) o[d_][r] *= wsfh[(r & 3) + 8 * (r >> 2)]; } } while (0)
#define DECIDE(C0, C1, WITH_L) do { const float rm_ = a6_rowmax(C0, C1); resc = false; \
      if (__builtin_expect(__any(rm_ > 8.f), 0)) { const float dl_ = __builtin_fmaxf(rm_, 0.f); mhat += dl_; \
          _Pragma("unroll") for (int r = 0; r < 16; ++r) { C0[r] -= dl_; C1[r] -= dl_; } \
          if (WITH_L) { const float f_ = __builtin_amdgcn_exp2f(-dl_); l_reg *= f_; if (hi == 0) wsf[r32] = f_; resc = true; } } } while (0)
    if (BIAS) { A6_WAIT_BAR(5); } else { A6_WAIT_BAR(3); }
    nx = (int)*nextw; if (nx < NQ_AT) attn_prefetch(pfn, a, nx, lane);
    NKRD(pA0, pA1, 0);
    { const float ct = CTV(0);
#pragma unroll
      for (int r = 0; r < 16; ++r) { pA0[r] = BIASF(pA0[r], ct); pA1[r] = BIASF(pA1[r], ct); } }
    _Pragma("unroll") for (int d0 = 0; d0 < 4; ++d0) a6_kload2(kf, kp0, d0);
    pA0 = A6_MFMA(kf[0], qr[0], pA0); pA1 = A6_MFMA(kf[1], qr[0], pA1); pA0 = A6_MFMA(kf[2], qr[1], pA0); pA1 = A6_MFMA(kf[3], qr[1], pA1);
    pA0 = A6_MFMA(kf[4], qr[2], pA0); pA1 = A6_MFMA(kf[5], qr[2], pA1); pA0 = A6_MFMA(kf[6], qr[3], pA0); pA1 = A6_MFMA(kf[7], qr[3], pA1);
    if (CAUSAL && NT == 4) a6_cmask(pA0, pA1, 0, qrel, hi);
    DECIDE(pA0, pA1, false);
#pragma unroll
    for (int r = 0; r < 16; ++r) { pA0[r] = EX(pA0[r]); pA1[r] = EX(pA1[r]); }
    A6_WAIT_BAR(0);
    DMA_K(3, 0); DMA_V(1, A6_SLOTB); ROT();
    _Pragma("unroll") for (int d0 = 0; d0 < 4; ++d0) a6_kload2(kf, kp0 + sl_cur, d0);
    NKRD(pB0, pB1, sl_cur);
    { const float ct = CTV(1);
#pragma unroll
      for (int r = 0; r < 16; ++r) { pB0[r] = BIASF(pB0[r], ct); pB1[r] = BIASF(pB1[r], ct); } }
    if (BIAS) { A6_WAIT_BAR(3); } else { A6_WAIT_BAR(2); }
#define PKW(P, i) pk2(P[i], P[i + 1])
#define PAF(k) __builtin_bit_cast(bf16x8, pw##k)
#define VFR(i) (bf16x8){vlo[i][0], vlo[i][1], vlo[i][2], vlo[i][3], vhi[i][0], vhi[i][1], vhi[i][2], vhi[i][3]}
#define VRD(i) do { vlo[i] = a6_vtr(vp_ + (((i) >> 2) * 4096 + ((i) & 3) * 1024)); vhi[i] = a6_vtr(vp_ + (((i) >> 2) * 4096 + ((i) & 3) * 1024 + 512)); } while (0)
#define KRD(G, d0) do { if (G) { a6_kload2(kf, kp0 + sl_next, d0); A6_SBAR(); } } while (0)
#define GAPA(MF, a0, a1, a2, a3, W0, W1, PW) do { MF; sacc += a0; sacc += a1; sacc += a2; sacc += a3; W0; W1; A6_PIN(PW); A6_PIN(sacc); A6_SBAR(); } while (0)
#define GAPB(MF, X, i, G, Y) do { MF; X[i] = EX(X[i]); X[i + 1] = EX(X[i + 1]); X[i + 2] = EX(X[i + 2]); X[i + 3] = EX(X[i + 3]); \
        if (G) { Y[i] = BIASF(Y[i], ctn); Y[i + 1] = BIASF(Y[i + 1], ctn); Y[i + 2] = BIASF(Y[i + 2], ctn); Y[i + 3] = BIASF(Y[i + 3], ctn); A6_PIN(Y); } A6_PIN(X); A6_SBAR(); } while (0)
#define STEP(C0, C1, P0, P1, t, MASK, GK, GV, GL) do { A6_SBAR(); \
    const lds_cptr vp_ = vp0 + sl_prev; \
    VRD(0); A6_SBAR(); float sacc = P0[0] + P0[1]; \
                       GAPA(C0 = A6_MFMA(kf[0], qr[0], C0), P0[2], P0[3], P0[4], P0[5],     pw0[0] = PKW(P0, 0),  pw0[1] = PKW(P0, 2),  pw0); \
    VRD(4); A6_SBAR(); GAPA(C1 = A6_MFMA(kf[1], qr[0], C1), P0[6], P0[7], P0[8], P0[9],     pw0[2] = PKW(P0, 4),  pw0[3] = PKW(P0, 6),  pw0); \
    VRD(1); A6_SBAR(); GAPA(C0 = A6_MFMA(kf[2], qr[1], C0), P0[10], P0[11], P0[12], P0[13], pw1[0] = PKW(P0, 8),  pw1[1] = PKW(P0, 10), pw1); \
    VRD(5); A6_SBAR(); GAPA(C1 = A6_MFMA(kf[3], qr[1], C1), P0[14], P0[15], P1[0], P1[1],   pw1[2] = PKW(P0, 12), pw1[3] = PKW(P0, 14), pw1); \
    VRD(2); A6_SBAR(); GAPA(C0 = A6_MFMA(kf[4], qr[2], C0), P1[2], P1[3], P1[4], P1[5],     pw2[0] = PKW(P1, 0),  pw2[1] = PKW(P1, 2),  pw2); \
    VRD(6); A6_SBAR(); GAPA(C1 = A6_MFMA(kf[5], qr[2], C1), P1[6], P1[7], P1[8], P1[9],     pw2[2] = PKW(P1, 4),  pw2[3] = PKW(P1, 6),  pw2); \
    VRD(3); A6_SBAR(); GAPA(C0 = A6_MFMA(kf[6], qr[3], C0), P1[10], P1[11], P1[12], P1[13], pw3[0] = PKW(P1, 8),  pw3[1] = PKW(P1, 10), pw3); \
    VRD(7); A6_SBAR(); GAPA(C1 = A6_MFMA(kf[7], qr[3], C1), P1[14], P1[15], 0.f, 0.f,       pw3[2] = PKW(P1, 12), pw3[3] = PKW(P1, 14), pw3); \
    l_reg += sacc; \
    if (GK) DMA_K((t) + 3, sl_cur); if (GV) DMA_V((t) + 1, sl_next); \
    if (GL) NKRD(P0, P1, sl_next);                                                       \
    if (MASK && CAUSAL) a6_cmask(C0, C1, (t) - (NT - 4), qrel, hi); \
    DECIDE(C0, C1, true); \
    const float ctn = CTV((t) + 1); A6_SBAR(); \
    GAPB(o[0] = A6_MFMA(PAF(0), VFR(0), o[0]), C0, 0, GL, P0);              GAPB(o[1] = A6_MFMA(PAF(0), VFR(4), o[1]), C0, 4, GL, P0); \
    KRD(GL, 0); GAPB(o[0] = A6_MFMA(PAF(1), VFR(1), o[0]), C0, 8, GL, P0);  KRD(GL, 1); GAPB(o[1] = A6_MFMA(PAF(1), VFR(5), o[1]), C0, 12, GL, P0); \
    KRD(GL, 2); GAPB(o[0] = A6_MFMA(PAF(2), VFR(2), o[0]), C1, 0, GL, P1);  KRD(GL, 3); GAPB(o[1] = A6_MFMA(PAF(2), VFR(6), o[1]), C1, 4, GL, P1); \
    GAPB(o[0] = A6_MFMA(PAF(3), VFR(3), o[0]), C1, 8, GL, P1);              GAPB(o[1] = A6_MFMA(PAF(3), VFR(7), o[1]), C1, 12, GL, P1); \
    } while (0)
#define STEADYW() do { if (BIAS) { A6_WAIT_BAR(3); } else { A6_WAIT_BAR(2); } } while (0)
    int t = 1;
    for (; t + 5 < NT; t += 2) {
        STEP(pB0, pB1, pA0, pA1, t, false, true, true, true);     STEADYW(); RESC(); ROT();
        STEP(pA0, pA1, pB0, pB1, t + 1, false, true, true, true); STEADYW(); RESC(); ROT();
    }
#define ENDW(tt) do { if ((tt) + 3 < NT) { STEADYW(); } else if ((tt) + 2 < NT) { A6_WAIT_BAR(1); } else { A6_WAIT_BAR(0); } } while (0)
    for (; t + 1 < NT; t += 2) {
        STEP(pB0, pB1, pA0, pA1, t, true, (t + 3 < NT), (t + 1 < NT), (t + 1 < NT));         ENDW(t);     RESC(); ROT();
        STEP(pA0, pA1, pB0, pB1, t + 1, true, (t + 4 < NT), (t + 2 < NT), (t + 2 < NT));     ENDW(t + 1); RESC(); ROT();
    }
    const int erow = lane >> 3, ech = lane & 7;
    v4u gt[4];
#pragma unroll
    for (int i = 0; i < 4; ++i) gt[i] = *(const v4u*)(Gw + (size_t)(i * 8 + erow) * gpitch + ech * 8);
    STEP(pB0, pB1, pA0, pA1, NT - 1, true, false, false, false); RESC();
    { float sacc = pB0[0] + pB0[1];
#pragma unroll
      for (int r = 2; r < 16; ++r) sacc += pB0[r];
#pragma unroll
      for (int r = 0; r < 16; ++r) sacc += pB1[r];
      l_reg += sacc;
      pw0 = (v4u){PKW(pB0, 0), PKW(pB0, 2), PKW(pB0, 4), PKW(pB0, 6)}; pw1 = (v4u){PKW(pB0, 8), PKW(pB0, 10), PKW(pB0, 12), PKW(pB0, 14)};
      pw2 = (v4u){PKW(pB1, 0), PKW(pB1, 2), PKW(pB1, 4), PKW(pB1, 6)}; pw3 = (v4u){PKW(pB1, 8), PKW(pB1, 10), PKW(pB1, 12), PKW(pB1, 14)};
      const lds_cptr vp_ = vp0 + sl_cur; _Pragma("unroll") for (int i = 0; i < 8; ++i) VRD(i);
      o[0] = A6_MFMA(PAF(0), VFR(0), o[0]); o[1] = A6_MFMA(PAF(0), VFR(4), o[1]); o[0] = A6_MFMA(PAF(1), VFR(1), o[0]); o[1] = A6_MFMA(PAF(1), VFR(5), o[1]);
      o[0] = A6_MFMA(PAF(2), VFR(2), o[0]); o[1] = A6_MFMA(PAF(2), VFR(6), o[1]); o[0] = A6_MFMA(PAF(3), VFR(3), o[0]); o[1] = A6_MFMA(PAF(3), VFR(7), o[1]); }
    { auto rr = __builtin_amdgcn_permlane32_swap(__float_as_uint(l_reg), __float_as_uint(l_reg), false, false); l_reg = __uint_as_float(rr[0]) + __uint_as_float(rr[1]); }
    if (hi == 0) wsf[32 + r32] = l_reg;
    asm volatile("s_waitcnt lgkmcnt(0)" ::: "memory"); __builtin_amdgcn_wave_barrier();
    LAS float* stg = (LAS float*)(lds + A6_OST) + wid * 2048; LAS float* stgh = stg + 4 * hi * 64 + r32;
#pragma unroll
    for (int r = 0; r < 16; ++r) { const int oc = (r & 3) + 8 * (r >> 2); const float rl = __builtin_amdgcn_rcpf(wsfh[32 + oc]);
        stgh[oc * 64] = o[0][r] * rl; stgh[oc * 64 + 32] = o[1][r] * rl; }
    asm volatile("s_waitcnt lgkmcnt(0)" ::: "memory"); __builtin_amdgcn_wave_barrier();
#pragma unroll
    for (int i = 0; i < 4; ++i) { const int row = i * 8 + erow;
        const f32x4 x0 = *(LAS const f32x4*)(stg + row * 64 + ech * 8), x1 = *(LAS const f32x4*)(stg + row * 64 + ech * 8 + 4); const v4u g = gt[i]; v4u w;
        w.x = pk2(x0.x * siluf(__uint_as_float(g.x << 16)), x0.y * siluf(__uint_as_float(g.x & 0xffff0000u)));
        w.y = pk2(x0.z * siluf(__uint_as_float(g.y << 16)), x0.w * siluf(__uint_as_float(g.y & 0xffff0000u)));
        w.z = pk2(x1.x * siluf(__uint_as_float(g.z << 16)), x1.y * siluf(__uint_as_float(g.z & 0xffff0000u)));
        w.w = pk2(x1.z * siluf(__uint_as_float(g.w << 16)), x1.w * siluf(__uint_as_float(g.w & 0xffff0000u)));
        *(v4u*)(Ow + (size_t)row * opitch + ech * 8) = w; }
    asm volatile("s_waitcnt lgkmcnt(0)\n\ts_barrier" ::: "memory");
#undef DMA_K
#undef DMA_V
#undef ROT
#undef CTV
#undef BIASF
#undef NKRD
#undef EX
#undef RESC
#undef DECIDE
#undef PKW
#undef PAF
#undef VFR
#undef VRD
#undef KRD
#undef ENDW
#undef STEADYW
#undef GAPA
#undef GAPB
#undef STEP
}

template <bool FOX>
__device__ __forceinline__ void attn_unit(LAS unsigned char* lds, const AttnP& p, const Args& a, const AttnPf& pf, AttnPf& pfn, volatile LAS unsigned* nextw, int& nx, float Bb, float Bm, int tid, int lane, int wave) {
    const int r32 = lane & 31;
    const bf16* Qw = p.Q + (size_t)(wave * 32) * p.qpitch; const bf16* Gw = p.Gt + (size_t)(wave * 32) * p.gpitch; bf16* Ow = p.O + (size_t)(wave * 32) * p.opitch;
    if constexpr (FOX) {
        const float btv = pf.btv; const float incl = wave_incl_scan(btv, lane); const float pre = incl - btv;
        const float cq0 = __int_as_float(__builtin_amdgcn_readlane(__float_as_int(pre), p.q0 >> 6)) + pf.nq0;
        int t0 = 0;
#if FOX_SKIP
        const bool skip = (lane < (p.q0 >> 6)) && ((cq0 - incl) * LOG2E + 2.f * Bb < -150.f);
        t0 = __builtin_popcountll(__ballot(skip)) & ~1;
#endif
        const int qi = p.q0 + wave * 32 + r32;
        const float ci = __int_as_float(__builtin_amdgcn_readlane(__float_as_int(pre), (p.q0 >> 6) + (wave >> 1))) + p.nck[qi];
        const float mhat0 = (cq0 - ci) * LOG2E - fmaxf(Bb - 60.f, 0.f);
        attn64_unit<true, true>(lds, Qw, p.qpitch, p.K + (size_t)t0 * 64 * p.kpitch, p.kpitch, p.V + (size_t)t0 * 64 * p.vpitch, p.vpitch, p.nck + t0 * 64, pre, t0, cq0, mhat0, p.nt - t0,
                                Gw, p.gpitch, Ow, p.opitch, a, pfn, nextw, nx, tid, lane, wave);
    } else {
        attn64_unit<false, false>(lds, Qw, p.qpitch, p.K, p.kpitch, p.V, p.vpitch, nullptr, 0.f, 0, 0.f, -fmaxf(Bm - 60.f, 0.f), p.nt, Gw, p.gpitch, Ow, p.opitch, a, pfn, nextw, nx, tid, lane, wave);
    }
}

struct SmallP { const bf16* Q; int qpitch; const float* Kc; int kpitch; const float* Vc; int vpitch; int P; const float* lfp; const float* lfn; const bf16* Kn; const bf16* Vn; int npitch; const bf16* Gt; int gpitch; bf16* O; int opitch; };
__device__ __forceinline__ bf16x8 cvt8(const f32x4 a, const f32x4 b) { v4u w; w.x = pk2(a.x, a.y); w.y = pk2(a.z, a.w); w.z = pk2(b.x, b.y); w.w = pk2(b.z, b.w); return __builtin_bit_cast(bf16x8, w); }
constexpr int SA_M = 0, SA_L = 512, SA_O = 1024, SA_NCK = 33792;
__device__ __forceinline__ void sample_attn(LAS unsigned char* lds, const SmallP& p, float Bskip, int tid, int lane, int wave) {
    const int r32 = lane & 31, hi = lane >> 5, qrow = r32 & 15;
    bf16x8 qr[4];
    { const bf16* qp = p.Q + (size_t)qrow * p.qpitch;
#pragma unroll
      for (int d0 = 0; d0 < 4; ++d0) qr[d0] = *(const bf16x8*)(qp + 16 * d0 + 8 * hi); }
    f32x16 o0, o1;
#pragma unroll
    for (int r = 0; r < 16; ++r) { o0[r] = 0.f; o1[r] = 0.f; }
    float m_run = -INFINITY, l_run = 0.f;
    const int npast = p.P / 64, nt = npast + (p.Kn ? 1 : 0);
    LAS float* NCK = (LAS float*)(lds + SA_NCK);
    if (p.lfp) {
        LAS float* WTOT = (LAS float*)(lds + SA_NCK + 4608);
        __syncthreads();
        const float x0 = p.lfp[(size_t)(2 * tid) * 6], x1 = p.lfp[(size_t)(2 * tid + 1) * 6];
        const float incl = wave_incl_scan(x0 + x1, lane);
        if (lane == 63) WTOT[wave] = incl;
        __syncthreads();
        float before = 0.f, total = 0.f;
#pragma unroll
        for (int w = 0; w < 8; ++w) { const float tv = WTOT[w]; total += tv; before += (w < wave) ? tv : 0.f; }
        const float s1 = total - (before + incl);
        NCK[2 * tid + 1] = s1 * LOG2E; NCK[2 * tid] = (s1 + x1) * LOG2E;
        if (tid < 64) { float cum = 0.f; for (int i = 0; i <= tid && i < 16; ++i) cum += p.lfn[(size_t)i * 6]; NCK[1024 + tid] = (tid < 16) ? -cum * LOG2E : 0.f; }
        __syncthreads();
    }
    for (int t = wave; t < nt; t += 8) {
        const bool isnew = (t >= npast);
#if FOX_SKIP
        if (p.lfp && !isnew && NCK[t * 64 + 63] + 2.f * Bskip < -150.f) continue;
#endif
        f32x16 c0, c1;
        if (p.lfp) {
#pragma unroll
            for (int g = 0; g < 4; ++g) { const f32x4 a0 = *(const LAS f32x4*)(NCK + t * 64 + 8 * g + 4 * hi), a1 = *(const LAS f32x4*)(NCK + t * 64 + 32 + 8 * g + 4 * hi);
                c0[4 * g] = a0.x; c0[4 * g + 1] = a0.y; c0[4 * g + 2] = a0.z; c0[4 * g + 3] = a0.w; c1[4 * g] = a1.x; c1[4 * g + 1] = a1.y; c1[4 * g + 2] = a1.z; c1[4 * g + 3] = a1.w; }
        } else {
#pragma unroll
            for (int r = 0; r < 16; ++r) { c0[r] = 0.f; c1[r] = 0.f; }
        }
        if (!isnew) {
            const float* k0p = p.Kc + (size_t)(t * 64 + r32) * p.kpitch + 8 * hi; const float* k1p = k0p + (size_t)32 * p.kpitch;
#pragma unroll
            for (int d0 = 0; d0 < 4; ++d0) {
                const bf16x8 k0 = cvt8(*(const f32x4*)(k0p + 16 * d0), *(const f32x4*)(k0p + 16 * d0 + 4));
                const bf16x8 k1 = cvt8(*(const f32x4*)(k1p + 16 * d0), *(const f32x4*)(k1p + 16 * d0 + 4));
                c0 = __builtin_amdgcn_mfma_f32_32x32x16_bf16(k0, qr[d0], c0, 0, 0, 0);
                c1 = __builtin_amdgcn_mfma_f32_32x32x16_bf16(k1, qr[d0], c1, 0, 0, 0);
            }
        } else {
            const bf16* k0p = p.Kn + (size_t)(r32 & 15) * p.npitch + 8 * hi;
#pragma unroll
            for (int d0 = 0; d0 < 4; ++d0) {
                const bf16x8 k0 = *(const bf16x8*)(k0p + 16 * d0);
                c0 = __builtin_amdgcn_mfma_f32_32x32x16_bf16(k0, qr[d0], c0, 0, 0, 0);
            }
#pragma unroll
            for (int r = 0; r < 16; ++r) { const int kv = 4 * hi + (r & 3) + 8 * (r >> 2); if (kv > qrow) c0[r] = -INFINITY; c1[r] = -INFINITY; }
        }
        float mx = fmaxf(c0[0], c1[0]);
#pragma unroll
        for (int r = 1; r < 16; ++r) mx = fmaxf(mx, fmaxf(c0[r], c1[r]));
        { XHALF32(mx, a_, b_); mx = fmaxf(a_, b_); }
        const float mn = fmaxf(m_run, mx);
        const float alpha = __builtin_amdgcn_exp2f(m_run - mn);
        m_run = mn;
        float sum = 0.f;
#pragma unroll
        for (int r = 0; r < 16; ++r) { c0[r] = __builtin_amdgcn_exp2f(c0[r] - mn); c1[r] = __builtin_amdgcn_exp2f(c1[r] - mn); sum += c0[r] + c1[r]; }
        l_run = l_run * alpha + sum;
#pragma unroll
        for (int r = 0; r < 8; ++r) { const float al = __shfl(alpha, crow(r, hi)); o0[r] *= al; o1[r] *= al; }
#pragma unroll
        for (int blk = 0; blk < 2; ++blk) {
            if (isnew && blk == 1) break;
#pragma unroll
            for (int s = 0; s < 2; ++s) {
                v4u pw;
                if (blk == 0) { pw.x = pk2(c0[8 * s], c0[8 * s + 1]); pw.y = pk2(c0[8 * s + 2], c0[8 * s + 3]); pw.z = pk2(c0[8 * s + 4], c0[8 * s + 5]); pw.w = pk2(c0[8 * s + 6], c0[8 * s + 7]); }
                else          { pw.x = pk2(c1[8 * s], c1[8 * s + 1]); pw.y = pk2(c1[8 * s + 2], c1[8 * s + 3]); pw.z = pk2(c1[8 * s + 4], c1[8 * s + 5]); pw.w = pk2(c1[8 * s + 6], c1[8 * s + 7]); }
                const bf16x8 pa = __builtin_bit_cast(bf16x8, pw);
                float va[8], vb[8];
#pragma unroll
                for (int j = 0; j < 8; ++j) { const int kvl = 32 * blk + 16 * s + 8 * (j >> 2) + 4 * hi + (j & 3);
                    if (!isnew) { const float* vp = p.Vc + (size_t)(t * 64 + kvl) * p.vpitch; va[j] = vp[r32]; vb[j] = vp[32 + r32]; }
                    else { const bf16* vp = p.Vn + (size_t)(kvl & 15) * p.npitch; va[j] = bf2f(vp[r32]); vb[j] = bf2f(vp[32 + r32]); } }
                const bf16x8 v0 = cvt8((f32x4){va[0], va[1], va[2], va[3]}, (f32x4){va[4], va[5], va[6], va[7]});
                const bf16x8 v1 = cvt8((f32x4){vb[0], vb[1], vb[2], vb[3]}, (f32x4){vb[4], vb[5], vb[6], vb[7]});
                o0 = __builtin_amdgcn_mfma_f32_32x32x16_bf16(pa, v0, o0, 0, 0, 0);
                o1 = __builtin_amdgcn_mfma_f32_32x32x16_bf16(pa, v1, o1, 0, 0, 0);
            }
        }
    }
    l_run = xsum32(l_run);
    LAS float* MW = (LAS float*)(lds + SA_M); LAS float* LW = (LAS float*)(lds + SA_L); LAS float* OW = (LAS float*)(lds + SA_O);
    __syncthreads();
    if (lane < 16) { MW[wave * 16 + lane] = m_run; LW[wave * 16 + lane] = l_run; }
#pragma unroll
    for (int r = 0; r < 8; ++r) { const int q = crow(r, hi); OW[(wave * 16 + q) * 64 + r32] = o0[r]; OW[(wave * 16 + q) * 64 + 32 + r32] = o1[r]; }
    __syncthreads();
    { const int q = tid >> 5, d = tid & 31;
      float M = MW[q];
#pragma unroll
      for (int w = 1; w < 8; ++w) M = fmaxf(M, MW[w * 16 + q]);
      float L = 0.f, a0 = 0.f, a1 = 0.f;
#pragma unroll
      for (int w = 0; w < 8; ++w) { const float f = __builtin_amdgcn_exp2f(MW[w * 16 + q] - M); L += f * LW[w * 16 + q]; a0 += f * OW[(w * 16 + q) * 64 + d]; a1 += f * OW[(w * 16 + q) * 64 + 32 + d]; }
      const float g0 = bf2f(p.Gt[(size_t)q * p.gpitch + d]), g1 = bf2f(p.Gt[(size_t)q * p.gpitch + 32 + d]);
      p.O[(size_t)q * p.opitch + d] = (bf16)f2bf(a0 / L * siluf(g0)); p.O[(size_t)q * p.opitch + 32 + d] = (bf16)f2bf(a1 / L * siluf(g1)); }
}

constexpr int RW_R = 0, RW_W = 16384, RW_KT = 32768, RW_V = 49152, RW_KK = 65536, RW_KA = 81920, RW_G = 98304, RW_X = 114688;
struct RwkvP { const bf16* Hs; bf16* Os; int T; int h; const float* s0; const float* prev0; float* s_out; float* sh_out; };
__device__ __forceinline__ void rwkv_task(LAS unsigned char* lds, const Args& a, const RwkvP& p, int tid) {
    LAS float* AR = (LAS float*)(lds + RW_R); LAS float* AW = (LAS float*)(lds + RW_W); LAS float* AKT = (LAS float*)(lds + RW_KT); LAS float* AV = (LAS float*)(lds + RW_V);
    LAS float* AKK = (LAS float*)(lds + RW_KK); LAS float* AKA = (LAS float*)(lds + RW_KA); LAS float* AG = (LAS float*)(lds + RW_G); LAS float* AX = (LAS float*)(lds + RW_X);
    const int tt = tid >> 3, e8 = (tid & 7) * 8, h = p.h;
    const float* mu = a.in[I_MU];
    float S[8];
    if (p.s0) {
#pragma unroll
        for (int e = 0; e < 8; ++e) S[e] = p.s0[tt * 64 + e8 + e];
    } else {
#pragma unroll
        for (int e = 0; e < 8; ++e) S[e] = 0.f;
    }
    static_assert(DECS <= 16, "rwkv_task stages the LoRA weights in rows 16.. of AR / AW");
    LAS float* WL = AR + 16 * 64; LAS float* AL = AW + 16 * 64;
    { const int j = tid >> 4, c4 = (tid & 15) * 4;
      *(LAS f32x4*)(WL + j * 64 + c4) = *(const f32x4*)(a.in[I_WUP] + j * 384 + h * 64 + c4); *(LAS f32x4*)(AL + j * 64 + c4) = *(const f32x4*)(a.in[I_AUP] + j * 384 + h * 64 + c4); }
    for (int c0 = 0; c0 < p.T; c0 += 64) {
        const int n = (p.T - c0) < 64 ? (p.T - c0) : 64;
        const bool act = tt < n; const int trow = c0 + tt;
        const bf16* cur = p.Hs + (size_t)trow * NP; const bf16* prv = cur - NP; const bool first = (trow == 0);
        if (act) {
#pragma unroll
            for (int e = 0; e < 8; ++e) { const int col = e8 + e; const float c = bf2f(cur[HC_WD + col]);
                const float pv = first ? (p.prev0 ? p.prev0[1152 + col] : 0.f) : bf2f(prv[HC_WD + col]);
                const float xs = c + (pv - c) * mu[1152 + col];
                AX[tt * 64 + col] = (col < 32) ? ftanh(xs) : xs; }
        }
        __syncthreads();
        if (act) {
            float lw[8], la[8];
            { const f32x4 w0a = *(const f32x4*)(a.in[I_W0] + h * 64 + e8), w0b = *(const f32x4*)(a.in[I_W0] + h * 64 + e8 + 4);
              const f32x4 a0a = *(const f32x4*)(a.in[I_A0] + h * 64 + e8), a0b = *(const f32x4*)(a.in[I_A0] + h * 64 + e8 + 4);
              lw[0] = w0a.x; lw[1] = w0a.y; lw[2] = w0a.z; lw[3] = w0a.w; lw[4] = w0b.x; lw[5] = w0b.y; lw[6] = w0b.z; lw[7] = w0b.w;
              la[0] = a0a.x; la[1] = a0a.y; la[2] = a0a.z; la[3] = a0a.w; la[4] = a0b.x; la[5] = a0b.y; la[6] = a0b.z; la[7] = a0b.w; }
#pragma unroll 4
            for (int j = 0; j < 32; ++j) {
                const float tw = AX[tt * 64 + j], ta = AX[tt * 64 + 32 + j];
                const f32x4 u0 = *(const LAS f32x4*)(WL + j * 64 + e8), u1 = *(const LAS f32x4*)(WL + j * 64 + e8 + 4);
                const f32x4 p0 = *(const LAS f32x4*)(AL + j * 64 + e8), p1 = *(const LAS f32x4*)(AL + j * 64 + e8 + 4);
                lw[0] += tw * u0.x; lw[1] += tw * u0.y; lw[2] += tw * u0.z; lw[3] += tw * u0.w; lw[4] += tw * u1.x; lw[5] += tw * u1.y; lw[6] += tw * u1.z; lw[7] += tw * u1.w;
                la[0] += ta * p0.x; la[1] += ta * p0.y; la[2] += ta * p0.z; la[3] += ta * p0.w; la[4] += ta * p1.x; la[5] += ta * p1.y; la[6] += ta * p1.z; la[7] += ta * p1.w;
            }
            float kk[8], aa[8]; float ss = 0.f;
            const int c8 = h * 64 + e8;
            float rs[8], ks[8], vs[8], gs[8];
            { float cu[8], pv[8], mm[8];
#define RW_SHIFT(dst, HC, MUOFF) do { unpack8(*(const v4u*)(cur + (HC) + c8), cu); \
                if (first) { if (p.prev0) ld8(p.prev0 + (MUOFF) + c8, pv); else { _Pragma("unroll") for (int e = 0; e < 8; ++e) pv[e] = 0.f; } } \
                else unpack8(*(const v4u*)(prv + (HC) + c8), pv); \
                ld8(mu + (MUOFF) + c8, mm); \
                _Pragma("unroll") for (int e = 0; e < 8; ++e) dst[e] = cu[e] + (pv[e] - cu[e]) * mm[e]; } while (0)
              RW_SHIFT(rs, HC_RR, 0); RW_SHIFT(ks, HC_RK, 384); RW_SHIFT(vs, HC_RV, 768); RW_SHIFT(gs, HC_RG, 1216);
#undef RW_SHIFT
            }
            float kkw[8], kaw[8];
            ld8(a.in[I_KK] + c8, kkw); ld8(a.in[I_KA] + c8, kaw);
#pragma unroll
            for (int e = 0; e < 8; ++e) { const int d = e8 + e;
                const float wraw = -softplusf(-lw[e]) - 0.5f; const float dec = fexp(-fexp(wraw));
                const float av = sigmf(la[e]);
                kk[e] = ks[e] * kkw[e]; ss += kk[e] * kk[e]; aa[e] = av;
                AR[tt * 64 + d] = rs[e]; AW[tt * 64 + d] = dec; AKT[tt * 64 + d] = ks[e] * (1.f + (av - 1.f) * kaw[e]); AV[tt * 64 + d] = vs[e]; AG[tt * 64 + d] = gs[e];
            }
            ss = sum8(ss); const float rn = frsq(fmaxf(ss, 1e-24f));
#pragma unroll
            for (int e = 0; e < 8; ++e) { const float k2 = kk[e] * rn; AKK[tt * 64 + e8 + e] = k2; AKA[tt * 64 + e8 + e] = k2 * aa[e]; }
        }
        __syncthreads();
        for (int t = 0; t < n; ++t) {
            const f32x4 k0 = *(const LAS f32x4*)(AKK + t * 64 + e8), k1 = *(const LAS f32x4*)(AKK + t * 64 + e8 + 4);
            const f32x4 w0 = *(const LAS f32x4*)(AW + t * 64 + e8), w1 = *(const LAS f32x4*)(AW + t * 64 + e8 + 4);
            const f32x4 b0 = *(const LAS f32x4*)(AKA + t * 64 + e8), b1 = *(const LAS f32x4*)(AKA + t * 64 + e8 + 4);
            const f32x4 x0 = *(const LAS f32x4*)(AKT + t * 64 + e8), x1 = *(const LAS f32x4*)(AKT + t * 64 + e8 + 4);
            const f32x4 r0 = *(const LAS f32x4*)(AR + t * 64 + e8), r1 = *(const LAS f32x4*)(AR + t * 64 + e8 + 4);
            const float vv = AV[t * 64 + tt];
            float sa = S[0] * k0.x + S[1] * k0.y + S[2] * k0.z + S[3] * k0.w + S[4] * k1.x + S[5] * k1.y + S[6] * k1.z + S[7] * k1.w;
            sa = -sum8(sa);
            S[0] = S[0] * w0.x + sa * b0.x + vv * x0.x; S[1] = S[1] * w0.y + sa * b0.y + vv * x0.y; S[2] = S[2] * w0.z + sa * b0.z + vv * x0.z; S[3] = S[3] * w0.w + sa * b0.w + vv * x0.w;
            S[4] = S[4] * w1.x + sa * b1.x + vv * x1.x; S[5] = S[5] * w1.y + sa * b1.y + vv * x1.y; S[6] = S[6] * w1.z + sa * b1.z + vv * x1.z; S[7] = S[7] * w1.w + sa * b1.w + vv * x1.w;
            float y = S[0] * r0.x + S[1] * r0.y + S[2] * r0.z + S[3] * r0.w + S[4] * r1.x + S[5] * r1.y + S[6] * r1.z + S[7] * r1.w;
            y = sum8(y);
            if ((tid & 7) == 0) AX[t * 64 + tt] = y;
        }
        __syncthreads();
        {
            float y[8], sm = 0.f, bn = 0.f;
#pragma unroll
            for (int e = 0; e < 8; ++e) { y[e] = AX[tt * 64 + e8 + e]; sm += y[e]; bn += AR[tt * 64 + e8 + e] * AKT[tt * 64 + e8 + e] * a.in[I_RK][h * 64 + e8 + e]; }
            sm = sum8(sm) * (1.f / 64.f); bn = sum8(bn);
            float var = 0.f;
#pragma unroll
            for (int e = 0; e < 8; ++e) { const float d = y[e] - sm; var += d * d; }
            var = sum8(var) * (1.f / 64.f);
            const float rstd = frsq(var + GN_EPS);
            if (act) {
                v4u o; unsigned w[4];
#pragma unroll
                for (int e = 0; e < 8; e += 2) { const int c = h * 64 + e8 + e;
                    const float o0 = ((y[e] - sm) * rstd * a.in[I_GNW][c] + a.in[I_GNB][c] + bn * AV[tt * 64 + e8 + e]) * siluf(AG[tt * 64 + e8 + e]);
                    const float o1 = ((y[e + 1] - sm) * rstd * a.in[I_GNW][c + 1] + a.in[I_GNB][c + 1] + bn * AV[tt * 64 + e8 + e + 1]) * siluf(AG[tt * 64 + e8 + e + 1]);
                    w[e >> 1] = pk2(o0, o1); }
                o.x = w[0]; o.y = w[1]; o.z = w[2]; o.w = w[3];
                *(v4u*)(p.Os + (size_t)trow * DM + 384 + h * 64 + e8) = o;
            }
        }
        __syncthreads();
    }
#pragma unroll
    for (int e = 0; e < 8; ++e) p.s_out[tt * 64 + e8 + e] = S[e];
    if (p.sh_out) { const bf16* last = p.Hs + (size_t)(p.T - 1) * NP;
        for (int m = tid; m < 1600; m += 512) { const int c = (m < 1152) ? HC_RR + m : (m < 1184) ? HC_WD + (m - 1152) : (m < 1216) ? HC_AD + (m - 1184) : HC_RG + (m - 1216);
            p.sh_out[m] = bf2f(last[c]); } }
}


constexpr int NCH = SEQ / 64;
constexpr int NTASK_RWC = BATCH * 6 * NCH;
constexpr size_t WS_QE = 344 * MiB;
constexpr size_t WS_YL = WS_QE + (size_t)NTASK_RWC * 8192;
constexpr size_t WS_PT = WS_YL + (size_t)NTASK_RWC * 8192;
constexpr size_t WS_SC = WS_PT + (size_t)NTASK_RWC * 8192;
constexpr size_t WS_SL = WS_SC + (size_t)NTASK_RWC * 8192;
constexpr size_t WS_BON = WS_SL + (size_t)NTASK_RWC * 16384;
constexpr size_t WS_END2 = WS_BON + (size_t)NTASK_RWC * 256;
static_assert(WS_END2 <= 512 * MiB, "d_ws map (chunked RWKV)");

constexpr int LC_AX = 0, LC_G = 16384, LC_AT = 32768, LC_M0 = 49152, LC_MS = 9216, LC_GAM = LC_M0 + 10 * LC_MS;
#define LC_M(i) (LC_M0 + (i) * LC_MS)
typedef float f32x4v __attribute__((ext_vector_type(4)));

template <bool XS = false, bool YS = false>
__device__ __forceinline__ void mm_nt(f32x4 (&acc)[2], const LAS unsigned char* X, const LAS unsigned char* Y, int bi, int bj0, int fr, int fq) {
#pragma unroll
    for (int ks = 0; ks < 2; ++ks) {
        const int rx = 16 * bi + fr;
        const bf16x8 a = *(const LAS bf16x8*)(X + rx * 144 + 16 * ((4 * ks + fq) ^ (XS ? ((rx >> 3) & 7) : 0)));
#pragma unroll
        for (int n = 0; n < 2; ++n) {
            const int ry = 16 * (bj0 + n) + fr;
            const bf16x8 b = *(const LAS bf16x8*)(Y + ry * 144 + 16 * ((4 * ks + fq) ^ (YS ? ((ry >> 3) & 7) : 0)));
            acc[n] = __builtin_amdgcn_mfma_f32_16x16x32_bf16(a, b, acc[n], 0, 0, 0);
        }
    }
}
#define ACC_ZERO(a) do { a[0] = (f32x4){0.f, 0.f, 0.f, 0.f}; a[1] = (f32x4){0.f, 0.f, 0.f, 0.f}; } while (0)
__device__ __forceinline__ void st_bf16_tile(LAS unsigned char* M, const f32x4 (&acc)[2], int bi, int bj0, int fr, int fq) {
#pragma unroll
    for (int n = 0; n < 2; ++n)
#pragma unroll
        for (int rg = 0; rg < 4; ++rg) *(LAS unsigned short*)(M + (16 * bi + 4 * fq + rg) * 144 + (16 * (bj0 + n) + fr) * 2) = (unsigned short)f2bf(acc[n][rg]);
}
__device__ __forceinline__ void copy_tile_bf16(bf16* dst, const LAS unsigned char* M, int tid) {
    const int row = tid >> 3, pc = tid & 7;
    *(v4u*)(dst + row * 64 + pc * 8) = *(const LAS v4u*)(M + row * 144 + pc * 16);
}

struct RwcP { const bf16* Hs; int h; int c0; size_t task; };
constexpr int RWC_Q0 = MT / 64 + BATCH * NMEM / 64;
struct RwcIn { v4u wdc, wdp, rc, rp, kc, kp, vc, vp; f32x4 wu, au; };
__device__ __forceinline__ void rwkv_local_load(RwcIn& in, const Args& a, const RwcP& p, int tid) {
    const int tt = tid >> 3, e8 = (tid & 7) * 8, c8 = p.h * 64 + e8; const int trow = p.c0 + tt;
    const bf16* cur = p.Hs + (size_t)trow * NP; const bf16* prv = (trow == 0) ? cur : cur - NP;
    in.wdc = *(const v4u*)(cur + HC_WD + e8); in.wdp = *(const v4u*)(prv + HC_WD + e8);
    in.rc = *(const v4u*)(cur + HC_RR + c8); in.rp = *(const v4u*)(prv + HC_RR + c8);
    in.kc = *(const v4u*)(cur + HC_RK + c8); in.kp = *(const v4u*)(prv + HC_RK + c8);
    in.vc = *(const v4u*)(cur + HC_RV + c8); in.vp = *(const v4u*)(prv + HC_RV + c8);
    const int d = tid & 63, jg = tid >> 6; const float* wp = a.in[I_WUP] + (4 * jg) * 384 + p.h * 64 + d; const float* ap = a.in[I_AUP] + (4 * jg) * 384 + p.h * 64 + d;
    in.wu = (f32x4){wp[0], wp[384], wp[768], wp[1152]}; in.au = (f32x4){ap[0], ap[384], ap[768], ap[1152]};
}
__device__ __forceinline__ void rwkv_local_task(LAS unsigned char* lds, const Args& a, const RwcP& p, const RwcIn& in, RwcIn& nxt, volatile LAS unsigned* nextw, int& nx, bool& has_next, int tid, int lane, int wave) {
    asm volatile("" : "+v"(tid), "+v"(lane));
    LAS float* AX = (LAS float*)(lds + LC_AX); LAS float* G = (LAS float*)(lds + LC_G); LAS float* AT = (LAS float*)(lds + LC_AT); LAS float* GAM = (LAS float*)(lds + LC_GAM);
    const int tt = tid >> 3, e8 = (tid & 7) * 8, h = p.h, c8 = h * 64 + e8;
    const float* mu = a.in[I_MU];
    const int trow = p.c0 + tt; const bool first = (trow == 0);
    {
        { const int d = tid & 63, jg = tid >> 6; u32x2 w2, a2; w2.x = pk2(in.wu.x, in.wu.y); w2.y = pk2(in.wu.z, in.wu.w); a2.x = pk2(in.au.x, in.au.y); a2.y = pk2(in.au.z, in.au.w);
          *(LAS u32x2*)(lds + LC_AT + d * 80 + 8 * jg) = w2; *(LAS u32x2*)(lds + LC_AT + 5120 + d * 80 + 8 * jg) = a2; }
        float cu[8], pv[8], mm[8];
        unpack8(in.wdc, cu); unpack8(in.wdp, pv);
        if (first) { _Pragma("unroll") for (int e = 0; e < 8; ++e) pv[e] = 0.f; }
        ld8(mu + 1152 + e8, mm);
        float xs[8];
#pragma unroll
        for (int e = 0; e < 8; ++e) { xs[e] = cu[e] + (pv[e] - cu[e]) * mm[e]; if (e8 < 32) xs[e] = ftanh(xs[e]); }
        v4u w_; w_.x = pk2(xs[0], xs[1]); w_.y = pk2(xs[2], xs[3]); w_.z = pk2(xs[4], xs[5]); w_.w = pk2(xs[6], xs[7]);
        *(LAS v4u*)(lds + LC_AX + (e8 < 32 ? 0 : 5120) + tt * 80 + (e8 & 31) * 2) = w_;
    }
    __syncthreads();
    {
        const int bi_ = wave >> 1, bj_ = 2 * (wave & 1), fr_ = lane & 15, fq_ = lane >> 4;
        const bf16x8 xw = *(const LAS bf16x8*)(lds + LC_AX + (16 * bi_ + fr_) * 80 + 16 * fq_), xa = *(const LAS bf16x8*)(lds + LC_AX + 5120 + (16 * bi_ + fr_) * 80 + 16 * fq_);
        LAS float* LAO = (LAS float*)(lds + LC_M(8));
#pragma unroll
        for (int n = 0; n < 2; ++n) {
            const bf16x8 bw = *(const LAS bf16x8*)(lds + LC_AT + (16 * (bj_ + n) + fr_) * 80 + 16 * fq_), ba = *(const LAS bf16x8*)(lds + LC_AT + 5120 + (16 * (bj_ + n) + fr_) * 80 + 16 * fq_);
            f32x4 cw = {0.f, 0.f, 0.f, 0.f}, ca = {0.f, 0.f, 0.f, 0.f};
            cw = __builtin_amdgcn_mfma_f32_16x16x32_bf16(xw, bw, cw, 0, 0, 0); ca = __builtin_amdgcn_mfma_f32_16x16x32_bf16(xa, ba, ca, 0, 0, 0);
#pragma unroll
            for (int rg = 0; rg < 4; ++rg) { G[(16 * bi_ + 4 * fq_ + rg) * 64 + 16 * (bj_ + n) + fr_] = cw[rg]; LAO[(16 * bi_ + 4 * fq_ + rg) * 64 + 16 * (bj_ + n) + fr_] = ca[rg]; }
        }
    }
    __syncthreads();
    float rs[8], ks[8], vs[8], kk[8], be[8], lwv[8];
    {
        float lw[8], la[8];
        { float t8[8]; ld8(a.in[I_W0] + c8, lw); ld8(a.in[I_A0] + c8, la);
          const f32x4 g0 = *(const LAS f32x4*)(G + tt * 64 + e8), g1 = *(const LAS f32x4*)(G + tt * 64 + e8 + 4);
          const f32x4 h0 = *(const LAS f32x4*)((LAS float*)(lds + LC_M(8)) + tt * 64 + e8), h1 = *(const LAS f32x4*)((LAS float*)(lds + LC_M(8)) + tt * 64 + e8 + 4);
          lw[0] += g0.x; lw[1] += g0.y; lw[2] += g0.z; lw[3] += g0.w; lw[4] += g1.x; lw[5] += g1.y; lw[6] += g1.z; lw[7] += g1.w;
          la[0] += h0.x; la[1] += h0.y; la[2] += h0.z; la[3] += h0.w; la[4] += h1.x; la[5] += h1.y; la[6] += h1.z; la[7] += h1.w; (void)t8; }
        { float cu[8], pv[8], mm[8];
#define RW_SHIFT(dst, CW, PW, MUOFF) do { unpack8(CW, cu); unpack8(PW, pv); \
            if (first) { _Pragma("unroll") for (int e = 0; e < 8; ++e) pv[e] = 0.f; } \
            ld8(mu + (MUOFF) + c8, mm); \
            _Pragma("unroll") for (int e = 0; e < 8; ++e) dst[e] = cu[e] + (pv[e] - cu[e]) * mm[e]; } while (0)
          RW_SHIFT(rs, in.rc, in.rp, 0); RW_SHIFT(ks, in.kc, in.kp, 384); RW_SHIFT(vs, in.vc, in.vp, 768);
#undef RW_SHIFT
        }
        float kkw[8], kaw[8], rkw[8]; ld8(a.in[I_KK] + c8, kkw); ld8(a.in[I_KA] + c8, kaw); ld8(a.in[I_RK] + c8, rkw);
        float ss = 0.f, bn = 0.f;
#pragma unroll
        for (int e = 0; e < 8; ++e) {
            const float wraw = -softplusf(-lw[e]) - 0.5f; lwv[e] = -fexp(wraw);
            const float av = sigmf(la[e]);
            kk[e] = ks[e] * kkw[e]; ss += kk[e] * kk[e]; be[e] = av;
            ks[e] = ks[e] * (1.f + (av - 1.f) * kaw[e]);
            bn += rs[e] * ks[e] * rkw[e];
        }
        ss = sum8(ss); bn = sum8(bn); const float rn = frsq(fmaxf(ss, 1e-24f));
#pragma unroll
        for (int e = 0; e < 8; ++e) { kk[e] *= rn; be[e] *= kk[e]; }
        if ((tid & 7) == 0) ((float*)(a.ws + WS_BON))[p.task * 64 + tt] = bn;
        *(LAS f32x4*)(G + tt * 64 + e8) = (f32x4){lwv[0], lwv[1], lwv[2], lwv[3]}; *(LAS f32x4*)(G + tt * 64 + e8 + 4) = (f32x4){lwv[4], lwv[5], lwv[6], lwv[7]};
    }
    nx = (int)*nextw; has_next = (nx >= RWC_Q0) && (nx < RWC_Q0 + NTASK_RWC);
    if (has_next) { const int t2 = NTASK_RWC - 1 - (nx - RWC_Q0), bh2 = t2 / NCH;     const RwcP pn{(const bf16*)(a.ws + WS_H) + (size_t)(bh2 / 6) * SEQ * NP, bh2 % 6, (t2 % NCH) * 64, (size_t)t2}; rwkv_local_load(nxt, a, pn, tid); }
    __syncthreads();
    { const int d = tid & 63, sg = tid >> 6; float loc[8]; float run = 0.f;
#pragma unroll
      for (int i = 0; i < 8; ++i) { run += G[(8 * sg + i) * 64 + d]; loc[i] = run; }
      AX[sg * 64 + d] = run;
      __syncthreads();
      float pre = 0.f;
#pragma unroll
      for (int j = 0; j < 8; ++j) { const float sv = AX[j * 64 + d]; pre += (j < sg) ? sv : 0.f; }
#pragma unroll
      for (int i = 0; i < 8; ++i) G[(8 * sg + i) * 64 + d] = pre + loc[i];
    }
    __syncthreads();
    {
        float g[8], gm[8], g63[8];
        { const f32x4 x0 = *(const LAS f32x4*)(G + tt * 64 + e8), x1 = *(const LAS f32x4*)(G + tt * 64 + e8 + 4);
          g[0] = x0.x; g[1] = x0.y; g[2] = x0.z; g[3] = x0.w; g[4] = x1.x; g[5] = x1.y; g[6] = x1.z; g[7] = x1.w; }
        { const f32x4 x0 = *(const LAS f32x4*)(G + 63 * 64 + e8), x1 = *(const LAS f32x4*)(G + 63 * 64 + e8 + 4);
          g63[0] = x0.x; g63[1] = x0.y; g63[2] = x0.z; g63[3] = x0.w; g63[4] = x1.x; g63[5] = x1.y; g63[6] = x1.z; g63[7] = x1.w; }
#pragma unroll
        for (int e = 0; e < 8; ++e) gm[e] = g[e] - lwv[e];
        float at[8], qt[8], bh[8], kh[8], bb[8], kb[8];
#pragma unroll
        for (int e = 0; e < 8; ++e) { const float e1 = fexp(gm[e]), e2 = fexp(g[e]), e3 = fexp(-g[e]), e4 = fexp(g63[e] - g[e]);
            at[e] = -kk[e] * e1; qt[e] = rs[e] * e2; bh[e] = be[e] * e3; kh[e] = ks[e] * e3; bb[e] = be[e] * e4; kb[e] = ks[e] * e4; }
        *(LAS f32x4*)(AT + tt * 64 + e8) = (f32x4){at[0], at[1], at[2], at[3]}; *(LAS f32x4*)(AT + tt * 64 + e8 + 4) = (f32x4){at[4], at[5], at[6], at[7]};
#define ST8(i, arr) do { v4u w_; w_.x = pk2(arr[0], arr[1]); w_.y = pk2(arr[2], arr[3]); w_.z = pk2(arr[4], arr[5]); w_.w = pk2(arr[6], arr[7]); *(LAS v4u*)(lds + LC_M(i) + tt * 144 + e8 * 2) = w_; } while (0)
        ST8(0, at); ST8(1, qt); ST8(2, bh); ST8(3, kh);
#undef ST8
#pragma unroll
        for (int e = 0; e < 8; ++e) {
            const int sw_ = (e8 + e) * 144 + 16 * ((tt >> 3) ^ (tid & 7)) + (tt & 7) * 2;
            *(LAS unsigned short*)(lds + LC_M(4) + sw_) = (unsigned short)f2bf(bb[e]);
            *(LAS unsigned short*)(lds + LC_M(5) + sw_) = (unsigned short)f2bf(kb[e]);
            *(LAS unsigned short*)(lds + LC_M(6) + sw_) = (unsigned short)f2bf(vs[e]);
        }
        if (tt == 63) {
#pragma unroll
            for (int e = 0; e < 8; ++e) GAM[e8 + e] = fexp(g63[e]);
        }
    }
    __syncthreads();
    const int bi = wave >> 1, bj0 = 2 * (wave & 1), fr = lane & 15, fq = lane >> 4;
    {
        f32x4 cab[2], cak[2], cqb[2], cqk[2]; ACC_ZERO(cab); ACC_ZERO(cak); ACC_ZERO(cqb); ACC_ZERO(cqk);
        mm_nt(cab, lds + LC_M(0), lds + LC_M(2), bi, bj0, fr, fq); mm_nt(cak, lds + LC_M(0), lds + LC_M(3), bi, bj0, fr, fq);
        mm_nt(cqb, lds + LC_M(1), lds + LC_M(2), bi, bj0, fr, fq); mm_nt(cqk, lds + LC_M(1), lds + LC_M(3), bi, bj0, fr, fq);
#pragma unroll
        for (int n = 0; n < 2; ++n)
#pragma unroll
            for (int rg = 0; rg < 4; ++rg) { const int t = 16 * bi + 4 * fq + rg, s = 16 * (bj0 + n) + fr;
                cab[n][rg] = (s < t) ? cab[n][rg] : 0.f;
                AX[s * 64 + ((((t >> 2) ^ (s & 7)) << 2) | (t & 3))] = cab[n][rg];
                *(LAS unsigned short*)(lds + LC_M(7) + t * 144 + s * 2) = (unsigned short)f2bf((s < t) ? cak[n][rg] : 0.f);
                *(LAS unsigned short*)(lds + LC_M(8) + t * 144 + s * 2) = (unsigned short)f2bf((s <= t) ? cqb[n][rg] : 0.f);
                *(LAS unsigned short*)(lds + LC_M(9) + t * 144 + s * 2) = (unsigned short)f2bf((s <= t) ? cqk[n][rg] : 0.f); }
        __syncthreads();
        st_bf16_tile(lds + LC_M(0), cab, bi, bj0, fr, fq);
        { const v4u z = {0u, 0u, 0u, 0u};
          *(LAS v4u*)(lds + LC_M(2) + tid * 16) = z; *(LAS v4u*)(lds + LC_M(3) + tid * 16) = z;
          if (tid < 64) { *(LAS v4u*)(lds + LC_M(2) + 8192 + tid * 16) = z; *(LAS v4u*)(lds + LC_M(3) + 8192 + tid * 16) = z; } }
    }
    {
        f32x4 c[2]; ACC_ZERO(c); mm_nt<false, true>(c, lds + LC_M(7), lds + LC_M(6), bi, bj0, fr, fq);
#pragma unroll
        for (int n = 0; n < 2; ++n)
#pragma unroll
            for (int rg = 0; rg < 4; ++rg) G[(16 * bi + 4 * fq + rg) * 64 + 16 * (bj0 + n) + fr] = c[n][rg];
    }
    __syncthreads();
    {
        LAS float* R = (tid < 64) ? AT : G; const int col = tid & 63;
        LAS unsigned char* XT = lds + ((tid < 64) ? LC_M(2) : LC_M(3)) + col * 144;
#pragma unroll
        for (int b4 = 0; b4 < 4; ++b4) {
            if (b4 > 0) {
                f32x4 acc = {0.f, 0.f, 0.f, 0.f};
                const LAS unsigned char* Yb = lds + ((wave < 4) ? LC_M(2) : LC_M(3)) + (16 * (wave & 3) + fr) * 144;
#pragma unroll
                for (int ks = 0; ks < (b4 + 1) / 2; ++ks) {
                    const bf16x8 av = *(const LAS bf16x8*)(lds + LC_M(0) + (16 * b4 + fr) * 144 + 64 * ks + 16 * fq);
                    const bf16x8 bv = *(const LAS bf16x8*)(Yb + 64 * ks + 16 * fq);
                    acc = __builtin_amdgcn_mfma_f32_16x16x32_bf16(av, bv, acc, 0, 0, 0);
                }
                LAS float* Rw = ((wave < 4) ? AT : G) + 16 * (wave & 3) + fr;
#pragma unroll
                for (int rg = 0; rg < 4; ++rg) Rw[(16 * b4 + 4 * fq + rg) * 64] += acc[rg];
                __syncthreads();
            }
            if (tid < 128) {
                float r[16];
#pragma unroll
                for (int i = 0; i < 16; ++i) r[i] = R[(16 * b4 + i) * 64 + col];
#pragma unroll
                for (int j = 0; j < 15; ++j) {
#pragma unroll
                    for (int i4 = (j + 1) / 4; i4 < 4; ++i4) { const f32x4 a4 = *(const LAS f32x4*)(AX + (16 * b4 + j) * 64 + (((4 * b4 + i4) ^ (j & 7)) << 2));
                        if (4 * i4 > j) r[4 * i4] += a4.x * r[j]; if (4 * i4 + 1 > j) r[4 * i4 + 1] += a4.y * r[j]; if (4 * i4 + 2 > j) r[4 * i4 + 2] += a4.z * r[j]; if (4 * i4 + 3 > j) r[4 * i4 + 3] += a4.w * r[j]; }
                }
                v4u w0, w1; w0.x = pk2(r[0], r[1]); w0.y = pk2(r[2], r[3]); w0.z = pk2(r[4], r[5]); w0.w = pk2(r[6], r[7]);
                w1.x = pk2(r[8], r[9]); w1.y = pk2(r[10], r[11]); w1.z = pk2(r[12], r[13]); w1.w = pk2(r[14], r[15]);
                *(LAS v4u*)(XT + 32 * b4) = w0; *(LAS v4u*)(XT + 32 * b4 + 16) = w1;
            }
            __syncthreads();
        }
    }
    {
        const LAS unsigned char* WT = lds + LC_M(2); const LAS unsigned char* WUT = lds + LC_M(3);
        f32x4 c[2];
#pragma unroll
        for (int n = 0; n < 2; ++n)
#pragma unroll
            for (int rg = 0; rg < 4; ++rg) c[n][rg] = bf2f(*(const LAS unsigned short*)(lds + LC_M(1) + (16 * bi + 4 * fq + rg) * 144 + (16 * (bj0 + n) + fr) * 2));
        mm_nt(c, lds + LC_M(8), WT, bi, bj0, fr, fq);
        st_bf16_tile(lds + LC_G, c, bi, bj0, fr, fq);
        ACC_ZERO(c); mm_nt(c, lds + LC_M(8), WUT, bi, bj0, fr, fq); mm_nt<false, true>(c, lds + LC_M(9), lds + LC_M(6), bi, bj0, fr, fq);
        st_bf16_tile(lds + LC_AT, c, bi, bj0, fr, fq);
        ACC_ZERO(c); mm_nt<true, false>(c, lds + LC_M(4), WT, bi, bj0, fr, fq);
#pragma unroll
        for (int n = 0; n < 2; ++n)
#pragma unroll
            for (int rg = 0; rg < 4; ++rg) { const int kp = 16 * bi + 4 * fq + rg, k = 16 * (bj0 + n) + fr; if (kp == k) c[n][rg] += GAM[k]; }
        st_bf16_tile(lds + LC_M(0), c, bi, bj0, fr, fq);
        ACC_ZERO(c); mm_nt<false, true>(c, WUT, lds + LC_M(4), bi, bj0, fr, fq); mm_nt<true, true>(c, lds + LC_M(6), lds + LC_M(5), bi, bj0, fr, fq);
#pragma unroll
        for (int n = 0; n < 2; ++n)
#pragma unroll
            for (int rg = 0; rg < 4; ++rg) AX[(16 * bi + 4 * fq + rg) * 64 + 16 * (bj0 + n) + fr] = c[n][rg];
    }
    __syncthreads();
    copy_tile_bf16((bf16*)(a.ws + WS_QE) + p.task * 4096, lds + LC_G, tid);
    copy_tile_bf16((bf16*)(a.ws + WS_YL) + p.task * 4096, lds + LC_AT, tid);
    copy_tile_bf16((bf16*)(a.ws + WS_PT) + p.task * 4096, lds + LC_M(0), tid);
    { float* sl = (float*)(a.ws + WS_SL) + p.task * 4096; *(f32x4*)(sl + tid * 4) = *(const LAS f32x4*)(AX + tid * 4); *(f32x4*)(sl + 2048 + tid * 4) = *(const LAS f32x4*)(AX + 2048 + tid * 4); }
    __syncthreads();
}

constexpr int CH_S = 0, CH_P = 9216;
__device__ __forceinline__ void rwkv_chain_task(LAS unsigned char* lds, const Args& a, int bh, int tid, int lane, int wave) {
    const int bi = wave >> 1, bj0 = 2 * (wave & 1), fr = lane & 15, fq = lane >> 4;
    const bf16* PT = (const bf16*)(a.ws + WS_PT) + (size_t)bh * NCH * 4096; const float* SL = (const float*)(a.ws + WS_SL) + (size_t)bh * NCH * 4096;
    bf16* SC = (bf16*)(a.ws + WS_SC) + (size_t)bh * NCH * 4096;
    f32x4 s[2]; ACC_ZERO(s);
    const int row = tid >> 3, pc = tid & 7;
    v4u preg = *(const v4u*)(PT + row * 64 + pc * 8);
    for (int c = 0; c < NCH; ++c) {
        __syncthreads();
        st_bf16_tile(lds + CH_S, s, bi, bj0, fr, fq);
        *(LAS v4u*)(lds + CH_P + row * 144 + pc * 16) = preg;
        __syncthreads();
        copy_tile_bf16(SC + (size_t)c * 4096, lds + CH_S, tid);
        if (c + 1 < NCH) preg = *(const v4u*)(PT + (size_t)(c + 1) * 4096 + row * 64 + pc * 8);
        f32x4 n_[2];
#pragma unroll
        for (int n = 0; n < 2; ++n)
#pragma unroll
            for (int rg = 0; rg < 4; ++rg) n_[n][rg] = SL[(size_t)c * 4096 + (16 * bi + 4 * fq + rg) * 64 + 16 * (bj0 + n) + fr];
        mm_nt(n_, lds + CH_S, lds + CH_P, bi, bj0, fr, fq);
        s[0] = n_[0]; s[1] = n_[1];
    }
    float* so = a.out + O_RSP + (size_t)bh * 4096;
#pragma unroll
    for (int n = 0; n < 2; ++n)
#pragma unroll
        for (int rg = 0; rg < 4; ++rg) so[(16 * bi + 4 * fq + rg) * 64 + 16 * (bj0 + n) + fr] = s[n][rg];
}

constexpr int YT_Q = 0, YT_S = 9216, YT_Y = 18432;
struct RwoIn { v4u qe, sc, vc, vp, gc, gp; unsigned short yl[8]; float bn; };
__device__ __forceinline__ void rwkv_out_load(RwoIn& in, const Args& a, const RwcP& p, int tid, int lane, int wave) {
    const int bi = wave >> 1, bj0 = 2 * (wave & 1), fr = lane & 15, fq = lane >> 4, row = tid >> 3, pc = tid & 7;
    in.qe = *(const v4u*)((const bf16*)(a.ws + WS_QE) + p.task * 4096 + row * 64 + pc * 8);
    in.sc = *(const v4u*)((const bf16*)(a.ws + WS_SC) + p.task * 4096 + row * 64 + pc * 8);
    const bf16* yl = (const bf16*)(a.ws + WS_YL) + p.task * 4096;
#pragma unroll
    for (int n = 0; n < 2; ++n)
#pragma unroll
        for (int rg = 0; rg < 4; ++rg) in.yl[4 * n + rg] = yl[(16 * bi + 4 * fq + rg) * 64 + 16 * (bj0 + n) + fr];
    const int tt = tid >> 3, e8 = (tid & 7) * 8, c8 = p.h * 64 + e8, trow = p.c0 + tt;
    const bf16* cur = p.Hs + (size_t)trow * NP; const bf16* prv = (trow == 0) ? cur : cur - NP;
    in.vc = *(const v4u*)(cur + HC_RV + c8); in.vp = *(const v4u*)(prv + HC_RV + c8); in.gc = *(const v4u*)(cur + HC_RG + c8); in.gp = *(const v4u*)(prv + HC_RG + c8);
    in.bn = ((const float*)(a.ws + WS_BON))[p.task * 64 + tt];
}
__device__ __forceinline__ void rwkv_out_task(LAS unsigned char* lds, const Args& a, const RwcP& p, const RwoIn& in, RwoIn& nxt, volatile LAS unsigned* nextw, int& nx, bool& has_next, bf16* Ob, int tid, int lane, int wave) {
    const int bi = wave >> 1, bj0 = 2 * (wave & 1), fr = lane & 15, fq = lane >> 4, row = tid >> 3, pc = tid & 7, h = p.h;
    LAS float* Y = (LAS float*)(lds + YT_Y);
    __syncthreads();
    *(LAS v4u*)(lds + YT_Q + row * 144 + pc * 16) = in.qe;
    *(LAS v4u*)(lds + YT_S + row * 144 + pc * 16) = in.sc;
    f32x4 c[2];
#pragma unroll
    for (int n = 0; n < 2; ++n)
#pragma unroll
        for (int rg = 0; rg < 4; ++rg) c[n][rg] = bf2f(in.yl[4 * n + rg]);
    __syncthreads();
    nx = (int)*nextw; has_next = nx < NTASK_RWC;
    if (has_next) { const int bh2 = nx / NCH; const RwcP pn{(const bf16*)(a.ws + WS_H) + (size_t)(bh2 / 6) * SEQ * NP, bh2 % 6, (nx % NCH) * 64, (size_t)nx}; rwkv_out_load(nxt, a, pn, tid, lane, wave); }
    mm_nt(c, lds + YT_Q, lds + YT_S, bi, bj0, fr, fq);
#pragma unroll
    for (int n = 0; n < 2; ++n)
#pragma unroll
        for (int rg = 0; rg < 4; ++rg) Y[(16 * bi + 4 * fq + rg) * 64 + 16 * (bj0 + n) + fr] = c[n][rg];
    __syncthreads();
    {
        const int tt = tid >> 3, e8 = (tid & 7) * 8, c8 = h * 64 + e8; const int trow = p.c0 + tt; const bool first = (trow == 0);
        const float* mu = a.in[I_MU];
        float y[8], sm = 0.f;
#pragma unroll
        for (int e = 0; e < 8; ++e) { y[e] = Y[tt * 64 + e8 + e]; sm += y[e]; }
        sm = sum8(sm) * (1.f / 64.f);
        float var = 0.f;
#pragma unroll
        for (int e = 0; e < 8; ++e) { const float d = y[e] - sm; var += d * d; }
        var = sum8(var) * (1.f / 64.f);
        const float rstd = frsq(var + GN_EPS);
        const float bn = in.bn;
        float vs[8], gs[8], cu[8], pv[8], mm[8], gw[8], gb[8];
        unpack8(in.vc, cu); unpack8(in.vp, pv); if (first) { _Pragma("unroll") for (int e = 0; e < 8; ++e) pv[e] = 0.f; }
        ld8(mu + 768 + c8, mm);
#pragma unroll
        for (int e = 0; e < 8; ++e) vs[e] = cu[e] + (pv[e] - cu[e]) * mm[e];
        unpack8(in.gc, cu); unpack8(in.gp, pv); if (first) { _Pragma("unroll") for (int e = 0; e < 8; ++e) pv[e] = 0.f; }
        ld8(mu + 1216 + c8, mm);
#pragma unroll
        for (int e = 0; e < 8; ++e) gs[e] = cu[e] + (pv[e] - cu[e]) * mm[e];
        ld8(a.in[I_GNW] + c8, gw); ld8(a.in[I_GNB] + c8, gb);
        float o[8];
#pragma unroll
        for (int e = 0; e < 8; ++e) o[e] = ((y[e] - sm) * rstd * gw[e] + gb[e] + bn * vs[e]) * siluf(gs[e]);
        v4u w_; w_.x = pk2(o[0], o[1]); w_.y = pk2(o[2], o[3]); w_.z = pk2(o[4], o[5]); w_.w = pk2(o[6], o[7]);
        *(v4u*)(Ob + ((size_t)(p.task / (6 * NCH)) * SEQ + trow) * DM + 384 + c8) = w_;
    }
}
constexpr int NQ_RW = 48 + 192, NQ_SM = 192 + 128;
__device__ __forceinline__ int q_next(const Ctx& F, int qi) {
    __syncthreads();
    if (F.tid == 0) F.MISC[0] = __hip_atomic_fetch_add(F.ctl + CW_Q + 64 * qi, 1u, __ATOMIC_RELAXED, __HIP_MEMORY_SCOPE_AGENT);
    __syncthreads();
    return (int)F.MISC[0];
}
template <bool FOX>
__device__ __forceinline__ void attn_queue(const Ctx& F, const Args& a, int qi, float Bb, float Bm) {
    bf16* H = (bf16*)(a.ws + WS_H); bf16* Ob = (bf16*)(a.ws + WS_XN); bf16* MKV = (bf16*)(a.ws + WS_MKV);
    const float* NCKP = (const float*)(a.ws + WS_NCKP); const float* NCKS = (const float*)(a.ws + WS_NCKS);
    LAS unsigned char* lds = F.lds + RING_OFF;
    constexpr int BASE = FOX ? 0 : 768, CNT = FOX ? 768 : 512;
    int tk = q_next(F, qi);
    if (tk >= CNT) return;
    tk += BASE;
    AttnPf pf, pfn; attn_prefetch(pf, a, tk, F.lane);
    for (;;) {
        if (F.tid == 0) { const unsigned r = __hip_atomic_fetch_add(F.ctl + CW_Q + 64 * qi, 1u, __ATOMIC_RELAXED, __HIP_MEMORY_SCOPE_AGENT); F.MISC[2] = (r < (unsigned)CNT) ? BASE + r : (unsigned)NQ_AT; }
        AttnP p;
        if constexpr (FOX) { const int u = tk, qb = 15 - (u & 15), bh = u >> 4, b = bh / 6, h = bh % 6; const size_t r0 = (size_t)b * SEQ + qb * 256;
            p = AttnP{H + r0 * NP + HC_FQ + h * 64, NP, H + (size_t)b * SEQ * NP + HC_FK + h * 64, NP, H + (size_t)b * SEQ * NP + HC_FV + h * 64, NP, NCKP + (size_t)bh * SEQ, NCKS + (size_t)bh * 64, a.in[I_FQG], a.in[I_FKG],
                      H + r0 * NP + HC_FG + h * 64, NP, Ob + r0 * DM + h * 64, DM, 4 * (qb + 1), qb * 256, 1};
        } else { const int u = tk - 768, b = u / 64, h = (u / 16) % 4, qb = u % 16; const size_t r0 = (size_t)b * SEQ + qb * 256;
            p = AttnP{H + r0 * NP + HC_MQ + h * 64, NP, MKV + (size_t)b * NMEM * 512 + h * 64, 512, MKV + (size_t)b * NMEM * 512 + 256 + h * 64, 512, nullptr, nullptr, nullptr, nullptr,
                      H + r0 * NP + HC_MG + h * 64, NP, Ob + r0 * DM + 768 + h * 64, DM, 4, 0, 0}; }
        int nx;
        attn_unit<FOX>(lds, p, a, pf, pfn, F.MISC + 2, nx, Bb, Bm, F.tid, F.lane, F.wave);
        if (nx >= NQ_AT) break;
        tk = nx; pf = pfn;
    }
}
__device__ __forceinline__ void p4_mixer(const Ctx& F, const Args& a, int qoff = 0) {
    bf16* H = (bf16*)(a.ws + WS_H); bf16* Ob = (bf16*)(a.ws + WS_XN); bf16* MKV = (bf16*)(a.ws + WS_MKV);
    const float* NCKP = (const float*)(a.ws + WS_NCKP); const float* NCKS = (const float*)(a.ws + WS_NCKS);
    LAS unsigned char* lds = F.lds + RING_OFF;
    for (;;) {
        const int tk = q_next(F, 0 + qoff); if (tk >= NQ_RW) break;
        RwkvP p;
        if (tk < 48) { rwkv_chain_task(lds, a, tk, F.tid, F.lane, F.wave);
            if (tk % 6 == 0) { const bf16* last = H + ((size_t)(tk / 6) * SEQ + SEQ - 1) * NP; float* sh = a.out + O_RHP + (size_t)(tk / 6) * 1600;
                for (int m = F.tid; m < 1600; m += 512) { const int c = (m < 1152) ? HC_RR + m : (m < 1184) ? HC_WD + (m - 1152) : (m < 1216) ? HC_AD + (m - 1184) : HC_RG + (m - 1216); sh[m] = bf2f(last[c]); } }
            continue; }
        { const int u = tk - 48, b = u / 6, h = u % 6;
            p = RwkvP{H + (size_t)(MP + b * DECS) * NP, Ob + (size_t)(MP + b * DECS) * DM, DECS, h, a.in[I_SRW] + (size_t)u * 4096, a.in[I_SSH] + (size_t)b * 1600,
                      a.out + O_RSS + (size_t)u * 4096, (h == 0) ? a.out + O_RHS + (size_t)b * 1600 : nullptr}; }
        rwkv_task(lds, a, p, F.tid);
    }
    float Bm, Bbs = 0.f;
    {
        float Bb = 0.f;
#if FOX_SKIP
        { const float gqm = wave_max(fabsf(a.in[I_FQG][F.lane])), gkm = wave_max(fabsf(a.in[I_FKG][F.lane])); Bb = 8.0f * gqm * gkm * LOG2E * 1.02f; }
#endif
        { const float gqm = wave_max(fabsf(a.in[I_MQG][F.lane])), gkm = wave_max(fabsf(a.in[I_MKG][F.lane])); Bm = __int_as_float(__builtin_amdgcn_readfirstlane(__float_as_int(8.0f * gqm * gkm * LOG2E * 1.02f))); }
#if !FOX_SKIP
        { const float gqm = wave_max(fabsf(a.in[I_FQG][F.lane])), gkm = wave_max(fabsf(a.in[I_FKG][F.lane])); Bb = 8.0f * gqm * gkm * LOG2E * 1.02f; }
#endif
        Bbs = __int_as_float(__builtin_amdgcn_readfirstlane(__float_as_int(Bb)));
        attn_queue<true>(F, a, 1 + qoff, Bb, Bm);
    }
    for (;;) {
        const int tk = q_next(F, 2 + qoff); if (tk >= NQ_SM) break;
        SmallP p;
        if (tk < 192) { const int u = tk, b = u / 6, h = u % 6; const size_t r0 = (size_t)MP + b * DECS;
            p = SmallP{H + r0 * NP + HC_FQ + h * 64, NP, a.in[I_CFK] + ((size_t)b * PAST * 6 + h) * 64, 384, a.in[I_CFV] + ((size_t)b * PAST * 6 + h) * 64, 384, PAST, a.in[I_CFL] + (size_t)b * PAST * 6 + h, a.out + O_FLS + (size_t)b * DECS * 6 + h,
                       H + r0 * NP + HC_FK + h * 64, H + r0 * NP + HC_FV + h * 64, NP, H + r0 * NP + HC_FG + h * 64, NP, Ob + r0 * DM + h * 64, DM};
        } else { const int u = tk - 192, b = u / 4, h = u % 4; const size_t r0 = (size_t)MP + b * DECS;
            p = SmallP{H + r0 * NP + HC_MQ + h * 64, NP, a.in[I_CMK] + ((size_t)b * NMEM * 4 + h) * 64, 256, a.in[I_CMV] + ((size_t)b * NMEM * 4 + h) * 64, 256, NMEM, nullptr, nullptr,
                       nullptr, nullptr, NP, H + r0 * NP + HC_MG + h * 64, NP, Ob + r0 * DM + 768 + h * 64, DM}; }
        sample_attn(lds, p, Bbs, F.tid, F.lane, F.wave);
    }
    {
        attn_queue<false>(F, a, 21 + qoff, 0.f, Bm);
    }
}

__device__ __forceinline__ void p3b_rwkv_local(const Ctx& F, const Args& a, int qoff = 0) {
    const bf16* H = (const bf16*)(a.ws + WS_H); LAS unsigned char* lds = F.lds + RING_OFF;
    {
        int blk = q_next(F, 3 + qoff), par = 0;
        while (blk < NBLK_PREP) {
            if (F.tid == 0) F.MISC[2 + par] = __hip_atomic_fetch_add(F.ctl + CW_Q + 64 * (3 + qoff), 1u, __ATOMIC_RELAXED, __HIP_MEMORY_SCOPE_AGENT);
            prep_block_task(lds, a, (blk < MT / 256) ? MT / 256 - 1 - blk : blk, F.tid, F.lane, F.wave);
            blk = (int)F.MISC[2 + par]; par ^= 1;
        }
        __syncthreads();
    }
    int cur = RWC_Q0 + q_next(F, 4 + 5 + qoff);
    if (cur >= RWC_Q0 + NTASK_RWC) return;
    RwcIn in, nxt;
    { const int tk = NTASK_RWC - 1 - (cur - RWC_Q0), bh = tk / NCH; const RwcP p{H + (size_t)(bh / 6) * SEQ * NP, bh % 6, (tk % NCH) * 64, (size_t)tk}; rwkv_local_load(in, a, p, F.tid); }
    for (;;) {
        if (F.tid == 0) F.MISC[2] = RWC_Q0 + __hip_atomic_fetch_add(F.ctl + CW_Q + 64 * (4 + 5 + qoff), 1u, __ATOMIC_RELAXED, __HIP_MEMORY_SCOPE_AGENT);
        int nx; bool has_next = false;
        const int tk = NTASK_RWC - 1 - (cur - RWC_Q0), bh = tk / NCH; const RwcP p{H + (size_t)(bh / 6) * SEQ * NP, bh % 6, (tk % NCH) * 64, (size_t)tk};
        rwkv_local_task(lds, a, p, in, nxt, F.MISC + 2, nx, has_next, F.tid, F.lane, F.wave);
        if (!has_next) break;
        cur = nx; in = nxt;
    }
}
__device__ __forceinline__ void p5_rwkv_out(const Ctx& F, const Args& a, int qoff = 0) {
    const bf16* H = (const bf16*)(a.ws + WS_H); bf16* Ob = (bf16*)(a.ws + WS_XN); LAS unsigned char* lds = F.lds + RING_OFF;
    int cur = q_next(F, 4 + qoff);
    if (cur >= NTASK_RWC) return;
    RwoIn in, nxt;
    { const int bh = cur / NCH; const RwcP p{H + (size_t)(bh / 6) * SEQ * NP, bh % 6, (cur % NCH) * 64, (size_t)cur}; rwkv_out_load(in, a, p, F.tid, F.lane, F.wave); }
    for (;;) {
        if (F.tid == 0) F.MISC[2] = __hip_atomic_fetch_add(F.ctl + CW_Q + 64 * (4 + qoff), 1u, __ATOMIC_RELAXED, __HIP_MEMORY_SCOPE_AGENT);
        int nx; bool has_next = false;
        const int bh = cur / NCH; const RwcP p{H + (size_t)(bh / 6) * SEQ * NP, bh % 6, (cur % NCH) * 64, (size_t)cur};
        rwkv_out_task(lds, a, p, in, nxt, F.MISC + 2, nx, has_next, Ob, F.tid, F.lane, F.wave);
        if (!has_next) break;
        cur = nx; in = nxt;
    }
}


struct EpiRes {
    static constexpr bool PERM = true, AFTER_DRAIN = false;
    const float* xp; const float* xs; float* yp; float* ys;
    __device__ __forceinline__ void operator()(const pg8::f32x4 (&acc)[2][2][4][2], const pg8::Unit& u, int wr, int wc, int fr, int fq) const {
        const int row0 = u.pm * 256 + wr * 64 + fr, col0 = u.pn * 256 + wc * 32 + 8 * fq;
        const bool samp = u.pm >= (MP / 256);
        const float* xb = samp ? xs - (size_t)MP * DM : xp; float* yb = samp ? ys - (size_t)MP * DM : yp;
#pragma unroll
        for (int ai = 0; ai < 2; ++ai)
#pragma unroll
            for (int m = 0; m < 4; ++m) { const size_t ro = (size_t)(row0 + ai * 128 + m * 16) * DM + col0;
#pragma unroll
                for (int bj = 0; bj < 2; ++bj) {
                    const pg8::f32x4 x0 = *(const pg8::f32x4*)(xb + ro + bj * 128), x1 = *(const pg8::f32x4*)(xb + ro + bj * 128 + 4);
                    *(pg8::f32x4*)(yb + ro + bj * 128) = acc[ai][bj][m][0] + x0; *(pg8::f32x4*)(yb + ro + bj * 128 + 4) = acc[ai][bj][m][1] + x1; } }
    }
};

struct EpiIn {
    static constexpr bool PERM = true, AFTER_DRAIN = false;
    bf16* H; float* out; const float* gq; const float* gk; const float* gm;
    __device__ __forceinline__ void operator()(const pg8::f32x4 (&acc)[2][2][4][2], const pg8::Unit& u, int wr, int wc, int fr, int fq) const {
        const int hh = 4 * u.pn + wc, row0 = u.pm * 256 + wr * 64 + fr, lcol = hh * 64 + 8 * fq;
        const int kind = (hh < 6) ? 1 : (hh < 12) ? 2 : (hh < 18) ? 3 : (hh >= 48 && hh < 52) ? 4 : 0;
        float g[2][8];
#define EPI_LOADG(GP, SC) do { _Pragma("unroll") for (int bj = 0; bj < 2; ++bj) { const pg8::f32x4 a0 = *(const pg8::f32x4*)((GP) + 32 * bj + 8 * fq), a1 = *(const pg8::f32x4*)((GP) + 32 * bj + 8 * fq + 4); \
            g[bj][0] = a0.x * (SC); g[bj][1] = a0.y * (SC); g[bj][2] = a0.z * (SC); g[bj][3] = a0.w * (SC); g[bj][4] = a1.x * (SC); g[bj][5] = a1.y * (SC); g[bj][6] = a1.z * (SC); g[bj][7] = a1.w * (SC); } } while (0)
        if (kind == 1) EPI_LOADG(gq, C2); else if (kind == 2) EPI_LOADG(gk, 1.f); else if (kind == 4) EPI_LOADG(gm, C2);
        else { _Pragma("unroll") for (int bj = 0; bj < 2; ++bj) _Pragma("unroll") for (int j = 0; j < 8; ++j) g[bj][j] = 1.f; }
#undef EPI_LOADG
#pragma unroll
        for (int ai = 0; ai < 2; ++ai)
#pragma unroll
            for (int m = 0; m < 4; ++m) { const int row = row0 + ai * 128 + m * 16;
                float v[2][8];
#pragma unroll
                for (int bj = 0; bj < 2; ++bj) { v[bj][0] = acc[ai][bj][m][0].x; v[bj][1] = acc[ai][bj][m][0].y; v[bj][2] = acc[ai][bj][m][0].z; v[bj][3] = acc[ai][bj][m][0].w;
                                                 v[bj][4] = acc[ai][bj][m][1].x; v[bj][5] = acc[ai][bj][m][1].y; v[bj][6] = acc[ai][bj][m][1].z; v[bj][7] = acc[ai][bj][m][1].w; }
                if (kind == 1 || kind == 2 || kind == 4) {
                    float ss = 0.f;
#pragma unroll
                    for (int bj = 0; bj < 2; ++bj)
#pragma unroll
                        for (int j = 0; j < 8; ++j) ss += v[bj][j] * v[bj][j];
                    ss = xsum32(xsum16(ss));
                    const float r = frsq(ss * (1.f / 64.f) + NORM_EPS);
#pragma unroll
                    for (int bj = 0; bj < 2; ++bj)
#pragma unroll
                        for (int j = 0; j < 8; ++j) v[bj][j] = v[bj][j] * r * g[bj][j];
                }
                bf16* hp = H + (size_t)row * NP + lcol;
#pragma unroll
                for (int bj = 0; bj < 2; ++bj) { v4u w; w.x = pk2(v[bj][0], v[bj][1]); w.y = pk2(v[bj][2], v[bj][3]); w.z = pk2(v[bj][4], v[bj][5]); w.w = pk2(v[bj][6], v[bj][7]); *(v4u*)(hp + 32 * bj) = w; }
                if (kind == 2 || kind == 3) {
                    float* op;
                    if (kind == 2) op = ((row < MP) ? out + O_FKP + (size_t)row * 384 : out + O_FKS + (size_t)(row - MP) * 384) + (hh - 6) * 64;
                    else           op = ((row < MP) ? out + O_FVP + (size_t)row * 384 : out + O_FVS + (size_t)(row - MP) * 384) + (hh - 12) * 64;
#pragma unroll
                    for (int bj = 0; bj < 2; ++bj) { *(pg8::f32x4*)(op + 32 * bj + 8 * fq) = (pg8::f32x4){v[bj][0], v[bj][1], v[bj][2], v[bj][3]}; *(pg8::f32x4*)(op + 32 * bj + 8 * fq + 4) = (pg8::f32x4){v[bj][4], v[bj][5], v[bj][6], v[bj][7]}; }
                }
            }
    }
};

struct OneUnit { int pm, pn;
    __device__ __forceinline__ bool next(int i, pg8::Unit& u) const { if (i > 0) return false; u.pm = pm; u.pn = pn; return true; }
    __device__ __forceinline__ void a_ready(const pg8::Unit&) const {}
    __device__ __forceinline__ void done(const pg8::Unit&) const {} };
__global__ void __launch_bounds__(NWAVES * 64, 2) fwd_kernel(Args args) {
    extern __shared__ __attribute__((aligned(16))) unsigned char lds[];
    Ctx F;
    F.lds = (LAS unsigned char*)lds;
    F.MISC = (volatile LAS unsigned*)(F.lds + MISC_OFF);
    F.tid = threadIdx.x; F.lane = F.tid & 63; F.wave = __builtin_amdgcn_readfirstlane(F.tid >> 6);
    F.G = gridDim.x; { const int bx = blockIdx.x; F.vcu = (F.G % 8 == 0) ? (bx % 8) * (F.G / 8) + bx / 8 : bx; }
    F.ctl = (gu32*)(args.ws + WS_CTL);
    for (int u = F.tid; u < (LDS_BYTES - LDSCTL_OFF) / 4; u += NWAVES * 64) ((LAS unsigned*)(F.lds + LDSCTL_OFF))[u] = 0u;
    __syncthreads();
    XcdBarrier bar; bar.bar = (unsigned*)(F.ctl + CW_BAR); bar.x = 0; bar.st = nullptr;
#if MK_ONE_LAUNCH
    bar = xcd_barrier_post((unsigned*)(F.ctl + CW_BAR), F.MISC + 8);
#define GRID_BAR() xcd_barrier(bar)
#else
#define GRID_BAR() do {} while (0)
#endif
    const int lo = args.ph_lo, hi = args.ph_hi;
#define IN(k) (lo <= (k) && (k) < hi)
#define BOTH(k) (IN(k) && IN((k) + 1))
    bf16* H = (bf16*)(args.ws + WS_H);
    if (IN(0)) { p0_prologue(F, args); if (BOTH(0)) GRID_BAR(); }
    if (IN(1)) {
        { pg8::Gemm g{(const bf16*)(args.ws + WS_XN), (const bf16*)(args.ws + WS_WIN), MT, NP, DM}; pg8::StaticOrder S; S.init(MT, NP, F.G, (int)blockIdx.x);
          EpiIn E{H, args.out, args.in[I_FQG], args.in[I_FKG], args.in[I_MQG]};
          pg8::gemm_phase<EpiIn, pg8::StaticOrder, PG8_ALIGN, PG8_SP2>(F.lds + RING_OFF, g, S, E); }
        { pg8::Gemm g{(const bf16*)(args.ws + WS_MEMN), (const bf16*)(args.ws + WS_WMEM), BATCH * NMEM, 512, DM}; pg8::StaticOrder S; S.init(BATCH * NMEM, 512, F.G, (int)((blockIdx.x + 16u) % (unsigned)F.G))    ;
          pg8::EpiBf16<0> E{(bf16*)(args.ws + WS_MKV), 512, nullptr, 0, 0, 1.f};
          pg8::gemm_phase<pg8::EpiBf16<0>, pg8::StaticOrder, PG8_ALIGN, PG8_SP2>(F.lds + RING_OFF, g, S, E); }
        if (IN(1) && IN(3)) GRID_BAR();
    }
    if (IN(3)) { p3b_rwkv_local(F, args); if (BOTH(3)) GRID_BAR(); }
    if (IN(4)) { p4_mixer(F, args); if (BOTH(4)) GRID_BAR(); }
    if (IN(5)) {
        if (F.vcu < 8) {
            pg8::Gemm g{(const bf16*)(args.ws + WS_XN), (const bf16*)(args.ws + WS_WOUT), MT, DM, DM}; OneUnit S{MP / 256 + (F.vcu >> 2), F.vcu & 3};
            EpiRes E{args.in[I_XP], args.in[I_XS], args.out + O_YP, args.out + O_YS};
            pg8::gemm_phase<EpiRes, OneUnit, PG8_ALIGN, PG8_SP2>(F.lds + RING_OFF, g, S, E);
        }
        p5_rwkv_out(F, args); if (BOTH(5)) GRID_BAR(); }
    if (IN(6)) {
        pg8::Gemm g{(const bf16*)(args.ws + WS_XN), (const bf16*)(args.ws + WS_WOUT), MP, DM, DM}; pg8::StaticOrder S; S.init(MP, DM, F.G, (int)blockIdx.x);
        EpiRes E{args.in[I_XP], args.in[I_XS], args.out + O_YP, args.out + O_YS};
        pg8::gemm_phase<EpiRes, pg8::StaticOrder, PG8_ALIGN, PG8_SP2>(F.lds + RING_OFF, g, S, E);
    }
#undef IN
#undef BOTH
}

extern "C" void kernel_launch(void* const* d_in, const int* in_sizes, int n_in, void* d_out, int out_size, void* d_ws, size_t ws_size, hipStream_t stream) {
    static int grid = 0;
    if (grid == 0) {
        if (n_in != 30 || out_size != (int)O_END || ws_size < WS_END2) { fprintf(stderr, "kernel_launch: unexpected shapes (n_in %d out %d ws %zu)\n", n_in, out_size, ws_size); grid = -1; return; }
        int dev = 0, cus = 0;
        if (hipGetDevice(&dev) != hipSuccess || hipDeviceGetAttribute(&cus, hipDeviceAttributeMultiprocessorCount, dev) != hipSuccess) { grid = -1; return; }
        if (hipFuncSetAttribute((const void*)fwd_kernel, hipFuncAttributeMaxDynamicSharedMemorySize, LDS_BYTES) != hipSuccess) { fprintf(stderr, "kernel_launch: hipFuncSetAttribute failed\n"); grid = -1; return; }
        (void)hipGetLastError();
        grid = cus;
    }
    if (grid < 0) return;
    (void)hipMemsetAsync((char*)d_ws + WS_CTL, 0, CTL_ZERO_BYTES, stream);
    Args a{};
    for (int i = 0; i < 30; ++i) a.in[i] = (const float*)d_in[i];
    a.out = (float*)d_out; a.ws = (unsigned char*)d_ws; a.pad = PROBE_PAD;
#if MK_ONE_LAUNCH
    a.ph_lo = 0; a.ph_hi = N_PHASES; a.li = 0;
    hipLaunchKernelGGL(fwd_kernel, dim3(grid), dim3(NWAVES * 64), LDS_BYTES, stream, a);
#else
    for (int li = 0; li < N_PHASES; ++li) { a.ph_lo = li; a.ph_hi = li + 1; a.li = li;
        hipLaunchKernelGGL(fwd_kernel, dim3(grid), dim3(NWAVES * 64), LDS_BYTES, stream, a); }
#endif
}
```
